# Optimizing an MI355X kernel written in HIP

```python
import math
import jax, jax.numpy as jnp
from jax import lax
import numpy as np

D_MODEL = 1024
BATCH = 8
SEQ = 2048
DEPTH = 2

N_MIXERS = 2
HEAD_DIM = 64
GRID_W = 64
N_MEM = 256
MEM_HEADS = 4
A_Q_HEADS = 12
A_KV_HEADS = 4
A_GROUP = A_Q_HEADS // A_KV_HEADS
Q_BLOCK = 128
AXIAL_THETA = 10000.0
B_HEADS = 8
DILATED_PATTERNS = ((128, 1), (512, 4), (2048, 16))
N_PATTERNS = len(DILATED_PATTERNS)
PARTIAL_ROT_DIMS = HEAD_DIM // 4
PARTIAL_THETA = 500000.0
N_EXPERTS = 16
N_EXPERT_GROUPS = 4
EXPERTS_PER_GROUP = N_EXPERTS // N_EXPERT_GROUPS
TOP_K = 2
D_EXPERT = 512
ALPHA = (2 * DEPTH) ** 0.25
BETA = (8 * DEPTH) ** -0.25
NORM_EPS = 1e-6
NEG_BIG = -1e30
N_A_LAYERS = (DEPTH + 1) // 2
N_B_LAYERS = DEPTH // 2
A_IN = (A_Q_HEADS + 2 * A_KV_HEADS + MEM_HEADS) * HEAD_DIM
A_OUT = (A_Q_HEADS + MEM_HEADS) * HEAD_DIM
B_IN = (3 * N_PATTERNS * B_HEADS + MEM_HEADS) * HEAD_DIM
B_OUT = (B_HEADS + MEM_HEADS) * HEAD_DIM

kernel_name = 'hybrid_gqa_dilated_moe_encoder'

F32 = jnp.float32


def layer_norm(x, g, b):
    xf = x.astype(F32)
    mu = jnp.mean(xf, -1, keepdims=True)
    var = jnp.mean(jnp.square(xf - mu), -1, keepdims=True)
    return ((xf - mu) * lax.rsqrt(var + NORM_EPS) * g.astype(F32) + b.astype(F32)).astype(x.dtype)


def rms_norm(x, g):
    xf = x.astype(F32)
    return (xf * lax.rsqrt(jnp.mean(xf * xf, -1, keepdims=True) + NORM_EPS) * g.astype(F32)).astype(x.dtype)


def rope_freqs(n, theta):
    return 1.0 / (theta ** (jnp.arange(0, n, 2, dtype=F32) / n))


def rotate(x, ang):
    cos = jnp.cos(ang)[:, None, :]
    sin = jnp.sin(ang)[:, None, :]
    xf = x.astype(F32)
    x1, x2 = jnp.split(xf, 2, axis=-1)
    return jnp.concatenate([x1 * cos - x2 * sin, x2 * cos + x1 * sin], -1).astype(x.dtype)


def axial_rope(x, seq_len):
    rows = seq_len // GRID_W
    row = jnp.repeat(jnp.arange(rows), GRID_W).astype(F32)
    col = jnp.tile(jnp.arange(GRID_W), rows).astype(F32)
    half = HEAD_DIM // 2
    inv = rope_freqs(half, AXIAL_THETA)
    return jnp.concatenate([rotate(x[..., :half], row[:, None] * inv),
                            rotate(x[..., half:], col[:, None] * inv)], -1)


def partial_rope(x, seq_len):
    pos = jnp.arange(seq_len, dtype=F32)
    ang = pos[:, None] * rope_freqs(PARTIAL_ROT_DIMS, PARTIAL_THETA)
    return jnp.concatenate([rotate(x[..., :PARTIAL_ROT_DIMS], ang), x[..., PARTIAL_ROT_DIMS:]], -1)


def gqa_block_attention(q, k, v):
    b, s = q.shape[:2]
    nq = s // Q_BLOCK
    scale = HEAD_DIM ** -0.5
    qb = q.reshape(b, nq, Q_BLOCK, A_KV_HEADS, A_GROUP, HEAD_DIM).transpose(1, 0, 2, 3, 4, 5)

    def block(qblk):
        sc = jnp.einsum('bqkgd,bskd->bkgqs', qblk, k, preferred_element_type=F32) * scale
        p = jax.nn.softmax(sc, axis=-1).astype(v.dtype)
        return jnp.einsum('bkgqs,bskd->bqkgd', p, v)

    o = lax.map(block, qb)
    return o.transpose(1, 0, 2, 3, 4, 5).reshape(b, s, A_Q_HEADS * HEAD_DIM)


def dilated_band_attention(q, k, v, dilation, n_side):
    b, s, h, hd = q.shape
    L = s // dilation
    P = n_side
    nb = -(-L // P)
    Lp = nb * P
    r = b * dilation

    def to_residue(t):
        return t.reshape(b, L, dilation, h, hd).transpose(0, 2, 1, 3, 4).reshape(r, L, h, hd)

    qr, kr, vr = to_residue(q), to_residue(k), to_residue(v)
    qr = jnp.pad(qr, ((0, 0), (0, Lp - L), (0, 0), (0, 0)))
    pad_kv = ((0, 0), (P, Lp - L + P), (0, 0), (0, 0))
    kr = jnp.pad(kr, pad_kv)
    vr = jnp.pad(vr, pad_kv)

    def windows(t):
        tb = t.reshape(r, nb + 2, P, h, hd)
        return jnp.concatenate([tb[:, :-2], tb[:, 1:-1], tb[:, 2:]], axis=2)

    kw, vw = windows(kr), windows(vr)
    qb = qr.reshape(r, nb, P, h, hd)
    qpos = jnp.arange(nb)[:, None] * P + jnp.arange(P)[None, :]
    kpos = (jnp.arange(nb)[:, None] - 1) * P + jnp.arange(3 * P)[None, :]
    dist = qpos[:, :, None] - kpos[:, None, :]
    valid = (jnp.abs(dist) <= n_side) & (kpos[:, None, :] >= 0) & (kpos[:, None, :] < L)
    sc = jnp.einsum('rnqhd,rnkhd->rnhqk', qb, kw, preferred_element_type=F32) * (HEAD_DIM ** -0.5)
    sc = jnp.where(valid[None, :, None], sc, NEG_BIG)
    lse = jax.nn.logsumexp(sc, axis=-1)
    p = jnp.exp(sc - lse[..., None]).astype(v.dtype)
    o = jnp.einsum('rnhqk,rnkhd->rnqhd', p, vw).reshape(r, Lp, h, hd)[:, :L]
    o = o.reshape(b, dilation, L, h, hd).transpose(0, 2, 1, 3, 4).reshape(b, s, h, hd)
    lse = lse.transpose(0, 1, 3, 2).reshape(r, Lp, h)[:, :L]
    lse = lse.reshape(b, dilation, L, h).transpose(0, 2, 1, 3).reshape(b, s, h)
    return o, lse


def dilated_mixture(q, k, v):
    b, s = q.shape[:2]
    outs, lses = [], []
    for g, (window, dilation) in enumerate(DILATED_PATTERNS):
        o, l = dilated_band_attention(q[:, :, g], k[:, :, g], v[:, :, g], dilation, (window // 2) // dilation)
        outs.append(o)
        lses.append(l)
    wts = jax.nn.softmax(jnp.stack(lses, 0), axis=0)
    o = jnp.einsum('gbsh,gbshd->bshd', wts, jnp.stack(outs, 0).astype(F32))
    return o.astype(q.dtype).reshape(b, s, B_HEADS * HEAD_DIM)


def memory_attention(q, mk, mv):
    b, s = q.shape[:2]
    sc = jnp.einsum('bshd,bmhd->bhsm', q, mk, preferred_element_type=F32) * (HEAD_DIM ** -0.5)
    p = jax.nn.softmax(sc, axis=-1).astype(mv.dtype)
    return jnp.einsum('bhsm,bmhd->bshd', p, mv).reshape(b, s, MEM_HEADS * HEAD_DIM)


def grouped_moe(x, router_w, router_b, w_gate, w_up, w_down):
    b, s, d = x.shape
    xt = x.reshape(b * s, d)
    aff = jax.nn.sigmoid(jnp.dot(xt, router_w, preferred_element_type=F32))
    sel = aff + router_b.astype(F32)
    grp_score = lax.top_k(sel.reshape(-1, N_EXPERT_GROUPS, EXPERTS_PER_GROUP), TOP_K)[0].sum(-1)
    best = jnp.argmax(grp_score, axis=-1)
    in_grp = (jnp.arange(N_EXPERTS) // EXPERTS_PER_GROUP)[None, :] == best[:, None]
    _, idx = lax.top_k(jnp.where(in_grp, sel, -jnp.inf), TOP_K)
    w = jnp.take_along_axis(aff, idx, axis=-1)
    w = w / jnp.sum(w, -1, keepdims=True)
    gates = jnp.sum(jax.nn.one_hot(idx, N_EXPERTS, dtype=F32) * w[..., None], axis=1)

    def expert_step(acc, p):
        wg, wu, wd, g = p
        hdn = jax.nn.silu(xt @ wg) * (xt @ wu)
        return acc + g[:, None] * (hdn @ wd).astype(F32), None

    acc, _ = lax.scan(expert_step, jnp.zeros((b * s, d), F32), (w_gate, w_up, w_down, gates.T))
    return acc.astype(x.dtype).reshape(b, s, d)


def setup_inputs(seed: int = 0) -> dict:
    key = jax.random.key(seed)
    ks = jax.random.split(key, 20)
    hd = HEAD_DIM
    nrm = jax.random.normal
    x = nrm(ks[0], (BATCH, SEQ, D_MODEL), F32)
    mem = nrm(ks[1], (BATCH, N_MEM, D_MODEL), F32)
    mkv_scale = jnp.concatenate([jnp.ones((MEM_HEADS * hd,), F32), jnp.full((MEM_HEADS * hd,), BETA, F32)])
    w_mem_kv = nrm(ks[2], (D_MODEL, 2 * MEM_HEADS * hd), F32) * D_MODEL ** -0.5 * mkv_scale
    router_w = nrm(ks[3], (D_MODEL, N_EXPERTS), F32) * D_MODEL ** -0.5
    router_b = nrm(ks[4], (N_EXPERTS,), F32) * 0.01
    a_scale = jnp.concatenate([jnp.ones(((A_Q_HEADS + A_KV_HEADS) * hd,), F32),
                               jnp.full((A_KV_HEADS * hd,), BETA, F32),
                               jnp.ones((MEM_HEADS * hd,), F32)])
    a_w_in = nrm(ks[5], (N_A_LAYERS, D_MODEL, A_IN), F32) * D_MODEL ** -0.5 * a_scale
    a_w_out = nrm(ks[6], (N_A_LAYERS, A_OUT, D_MODEL), F32) * A_OUT ** -0.5 * BETA
    a_q_norm = 1.0 + 0.02 * nrm(ks[7], (N_A_LAYERS, hd), F32)
    a_k_norm = 1.0 + 0.02 * nrm(ks[8], (N_A_LAYERS, hd), F32)
    b_scale = jnp.concatenate([jnp.ones((2 * N_PATTERNS * B_HEADS * hd,), F32),
                               jnp.full((N_PATTERNS * B_HEADS * hd,), BETA, F32),
                               jnp.ones((MEM_HEADS * hd,), F32)])
    b_w_in = nrm(ks[9], (N_B_LAYERS, D_MODEL, B_IN), F32) * D_MODEL ** -0.5 * b_scale
    b_w_out = nrm(ks[10], (N_B_LAYERS, B_OUT, D_MODEL), F32) * B_OUT ** -0.5 * BETA
    ln1_g = 1.0 + 0.02 * nrm(ks[11], (DEPTH, D_MODEL), F32)
    ln1_b = 0.02 * nrm(ks[12], (DEPTH, D_MODEL), F32)
    ln2_g = 1.0 + 0.02 * nrm(ks[13], (DEPTH, D_MODEL), F32)
    ln2_b = 0.02 * nrm(ks[14], (DEPTH, D_MODEL), F32)
    w_gate = nrm(ks[15], (DEPTH, N_EXPERTS, D_MODEL, D_EXPERT), F32) * D_MODEL ** -0.5
    w_up = nrm(ks[16], (DEPTH, N_EXPERTS, D_MODEL, D_EXPERT), F32) * D_MODEL ** -0.5
    w_down = nrm(ks[17], (DEPTH, N_EXPERTS, D_EXPERT, D_MODEL), F32) * D_EXPERT ** -0.5 * BETA
    return {'x': x, 'mem': mem, 'w_mem_kv': w_mem_kv, 'router_w': router_w, 'router_b': router_b,
            'a_w_in': a_w_in, 'a_w_out': a_w_out, 'a_q_norm': a_q_norm, 'a_k_norm': a_k_norm,
            'b_w_in': b_w_in, 'b_w_out': b_w_out,
            'ln1_g': ln1_g, 'ln1_b': ln1_b, 'ln2_g': ln2_g, 'ln2_b': ln2_b,
            'w_gate': w_gate, 'w_up': w_up, 'w_down': w_down}


def reference(x, mem, w_mem_kv, router_w, router_b, a_w_in, a_w_out, a_q_norm, a_k_norm,
              b_w_in, b_w_out, ln1_g, ln1_b, ln2_g, ln2_b, w_gate, w_up, w_down):
    b, s, _ = x.shape
    hd = HEAD_DIM
    mkv = jnp.einsum('bmd,de->bme', mem, w_mem_kv)
    mem_k, mem_v = jnp.split(mkv, 2, axis=-1)
    mem_k = mem_k.reshape(b, N_MEM, MEM_HEADS, hd)
    mem_v = mem_v.reshape(b, N_MEM, MEM_HEADS, hd)
    a_split = [A_Q_HEADS * hd, (A_Q_HEADS + A_KV_HEADS) * hd, (A_Q_HEADS + 2 * A_KV_HEADS) * hd]
    nb_cols = N_PATTERNS * B_HEADS * hd
    b_split = [nb_cols, 2 * nb_cols, 3 * nb_cols]
    for i in range(DEPTH):
        j = i // N_MIXERS
        if i % N_MIXERS == 0:
            proj = x @ a_w_in[j]
            qa, ka, va, qm = jnp.split(proj, a_split, axis=-1)
            qa = axial_rope(rms_norm(qa.reshape(b, s, A_Q_HEADS, hd), a_q_norm[j]), s)
            ka = axial_rope(rms_norm(ka.reshape(b, s, A_KV_HEADS, hd), a_k_norm[j]), s)
            va = va.reshape(b, s, A_KV_HEADS, hd)
            mix = gqa_block_attention(qa, ka, va)
            w_out = a_w_out[j]
        else:
            proj = x @ b_w_in[j]
            qb, kb, vb, qm = jnp.split(proj, b_split, axis=-1)
            qb = partial_rope(qb.reshape(b, s, N_PATTERNS * B_HEADS, hd), s).reshape(b, s, N_PATTERNS, B_HEADS, hd)
            kb = partial_rope(kb.reshape(b, s, N_PATTERNS * B_HEADS, hd), s).reshape(b, s, N_PATTERNS, B_HEADS, hd)
            vb = vb.reshape(b, s, N_PATTERNS, B_HEADS, hd)
            mix = dilated_mixture(qb, kb, vb)
            w_out = b_w_out[j]
        memo = memory_attention(qm.reshape(b, s, MEM_HEADS, hd), mem_k, mem_v)
        attn = jnp.concatenate([mix, memo], axis=-1) @ w_out
        x = layer_norm(ALPHA * x + attn, ln1_g[i], ln1_b[i])
        ffn = grouped_moe(x, router_w, router_b, w_gate[i], w_up[i], w_down[i])
        x = layer_norm(ALPHA * x + ffn, ln2_g[i], ln2_b[i])
    return x
```

```cpp
#include <hip/hip_runtime.h>
#include <cstdio>
#include <cstdint>

#ifndef MK_ONE_LAUNCH
#define MK_ONE_LAUNCH 0
#endif

#define GAS __attribute__((address_space(1)))
#define LAS __attribute__((address_space(3)))
#define CAS __attribute__((address_space(4)))
typedef unsigned short bf16_t;
typedef short bf16x8 __attribute__((ext_vector_type(8)));
typedef short s16x4 __attribute__((ext_vector_type(4)));
typedef float f32x4 __attribute__((ext_vector_type(4)));
typedef float f32x2 __attribute__((ext_vector_type(2)));
typedef float f32x16 __attribute__((ext_vector_type(16)));
typedef unsigned u32x4 __attribute__((ext_vector_type(4)));
typedef unsigned u32x2 __attribute__((ext_vector_type(2)));
typedef GAS unsigned gu32;

constexpr int NTOK = 16384, DM = 1024, SEQ = 2048, NB = 8, NMEM = 256, HD = 64;
constexpr int A_IN = 1536, B_IN = 4864, NEXP = 16, DEXP = 512;
constexpr float ALPHA = 1.4142135623730951f;
constexpr float NORM_EPS = 1e-6f;
constexpr float C2 = 0.125f * 1.4426950408889634f;
constexpr int RCAP = 16384;

constexpr size_t MiB = 1u << 20;
constexpr size_t WS_CTL = 0, CTL_ZERO_BYTES = 1 * MiB;
constexpr size_t WS_TAB = 1 * MiB;
constexpr size_t WS_ROWMAP = 2 * MiB;
constexpr size_t WS_ROWW = 3 * MiB;
constexpr size_t WS_WMKV = 4 * MiB;
constexpr size_t WS_WAIN = 5 * MiB;
constexpr size_t WS_WAOUT = 8 * MiB;
constexpr size_t WS_WBIN = 10 * MiB;
constexpr size_t WS_WBOUT = 20 * MiB;
constexpr size_t WS_WGU = 22 * MiB;
constexpr size_t WS_WD = 54 * MiB;
constexpr size_t WS_MEMB = 70 * MiB;
constexpr size_t WS_MKV = 74 * MiB;
constexpr size_t WS_XB = 76 * MiB;
constexpr size_t WS_ATT = 108 * MiB;
constexpr size_t WS_BIG = 140 * MiB;
constexpr size_t WS_H = WS_BIG, WS_Y = WS_BIG + 36 * MiB;
constexpr size_t WS_LSE = 292 * MiB;
constexpr size_t WS_END = 294 * MiB;
constexpr int TB_ROWC = 0, TB_ROWS = 512, TB_COLC = 1024, TB_COLS = 2048, TB_PC = 4096, TB_PS = 4096 + 16384;
constexpr int CW_TMO = 0;
constexpr int CW_BAR = 4096;
constexpr int CW_CNT = 16384;

constexpr int RING_OFF = 0, RING_BYTES = 131072;
constexpr int LDSCTL_OFF = RING_BYTES, MISC_OFF = LDSCTL_OFF + 320, SCHED_OFF = LDSCTL_OFF + 512;
constexpr int LDS_BYTES = 147456;
constexpr int NWAVES = 8;

#define RLX_AGENT __ATOMIC_RELAXED, __HIP_MEMORY_SCOPE_AGENT
#define LDS_WAIT() asm volatile("s_waitcnt lgkmcnt(0)" ::: "memory")
#define VM_WAIT() asm volatile("s_waitcnt vmcnt(0)" ::: "memory")
__device__ __forceinline__ unsigned f2bf(float f) { unsigned u = __builtin_bit_cast(unsigned, f); return (u + 0x7fffu + ((u >> 16) & 1u)) >> 16; }
__device__ __forceinline__ unsigned pk2(float lo, float hi) { return f2bf(lo) | (f2bf(hi) << 16); }
__device__ __forceinline__ float bf2f(unsigned short b) { return __builtin_bit_cast(float, (unsigned)b << 16); }
__device__ __forceinline__ float bflo(unsigned w) { return __builtin_bit_cast(float, w << 16); }
__device__ __forceinline__ float bfhi(unsigned w) { return __builtin_bit_cast(float, w & 0xffff0000u); }
__device__ __forceinline__ unsigned cvt_pk_bf16(float lo, float hi) { unsigned r; asm volatile("v_cvt_pk_bf16_f32 %0, %1, %2" : "=v"(r) : "v"(lo), "v"(hi)); return r; }
__device__ __forceinline__ float wave_sum(float v) {
#pragma unroll
    for (int o = 1; o < 64; o <<= 1) v += __shfl_xor(v, o);
    return v;
}

#define XB_TMO      128
#define XB_XCNT(j)  (256  + 64 * (j))
#define XB_XSUB(j)  (1280 + 64 * (j))
#define XB_XGEN(j)  (2304 + 64 * (j))
#define XB_TOP      3328
#define XB_TOPGEN   3392
#define XCD_BAR_WORDS 3456
#define XB_SPIN_CAP (1u << 20)
__device__ __forceinline__ unsigned xb_ld(unsigned* p)              { return __hip_atomic_load(p, __ATOMIC_RELAXED, __HIP_MEMORY_SCOPE_AGENT); }
__device__ __forceinline__ unsigned xb_add(unsigned* p, unsigned v) { return __hip_atomic_fetch_add(p, v, __ATOMIC_RELAXED, __HIP_MEMORY_SCOPE_AGENT); }
__device__ __forceinline__ unsigned xb_xcc_id() { return (unsigned)__builtin_amdgcn_s_getreg((3 << 11) | 20) & 0xFu; }
#define XB_SPIN(cond, bar) do { unsigned _sp = 0; while (cond) { __builtin_amdgcn_s_sleep(1); \
    if ((++_sp & 255u) == 0u) { if (xb_ld(&(bar)[XB_TMO])) break; if (_sp > XB_SPIN_CAP) { atomicAdd(&(bar)[XB_TMO], 1u); break; } } } } while (0)
struct XcdBarrier { unsigned* bar; unsigned x; volatile LAS unsigned* st; };
__device__ __forceinline__ XcdBarrier xcd_barrier_post(unsigned* bar, volatile LAS unsigned* st) {
    XcdBarrier b; b.bar = bar; b.x = xb_xcc_id(); b.st = st;
    if (threadIdx.x == 0) (void)xb_add(&bar[XB_XCNT(b.x)], 1u);
    return b;
}
__device__ __forceinline__ void xcd_barrier_complete(unsigned* bar, unsigned x, unsigned& nloc, unsigned& nx) {
    const unsigned G = gridDim.x * gridDim.y * gridDim.z;
    unsigned sum, cnt, mine, sp = 0u;
    for (;;) {
        sum = 0u; cnt = 0u; mine = 0u;
#pragma unroll
        for (unsigned j = 0; j < 16; ++j) { const unsigned c = xb_ld(&bar[XB_XCNT(j)]); sum += c; cnt += (c > 0u) ? 1u : 0u; mine = (j == x) ? c : mine; }
        if (sum == G) break;
        __builtin_amdgcn_s_sleep(1);
        if ((++sp & 255u) == 0u) { if (xb_ld(&bar[XB_TMO])) break; if (sp > XB_SPIN_CAP) { atomicAdd(&bar[XB_TMO], 1u); break; } }
    }
    nloc = mine > 0u ? mine : 1u; nx = cnt > 0u ? cnt : 1u;
}
__device__ __forceinline__ void xcd_barrier(const XcdBarrier& b) {
    asm volatile("s_waitcnt vmcnt(0)" ::: "memory");
    __syncthreads();
    if (threadIdx.x == 0) {
        unsigned* bar = b.bar;
        __builtin_amdgcn_s_waitcnt(0);
        unsigned nloc = b.st[0], nx = b.st[1];
        if (nloc == 0u) { xcd_barrier_complete(bar, b.x, nloc, nx); b.st[0] = nloc; b.st[1] = nx; }
        const unsigned old = xb_add(&bar[XB_XSUB(b.x)], 1u);
        const unsigned gen = old / nloc;
        if (old + 1u == (gen + 1u) * nloc) {
            __builtin_amdgcn_fence(__ATOMIC_RELEASE, "agent");
            asm volatile("s_waitcnt vmcnt(0)" ::: "memory");
            const unsigned og = xb_add(&bar[XB_TOP], 1u);
            const unsigned tg = og / nx;
            if (og + 1u == (tg + 1u) * nx) xb_add(&bar[XB_TOPGEN], 1u);
            else XB_SPIN(xb_ld(&bar[XB_TOPGEN]) == tg, bar);
            __builtin_amdgcn_fence(__ATOMIC_ACQUIRE, "agent");
            xb_add(&bar[XB_XGEN(b.x)], 1u);
            asm volatile("s_waitcnt vmcnt(0)" ::: "memory");
        } else {
            XB_SPIN(xb_ld(&bar[XB_XGEN(b.x)]) == gen, bar);
            __builtin_amdgcn_fence(__ATOMIC_ACQUIRE, "agent");
            asm volatile("s_waitcnt vmcnt(0)" ::: "memory");
        }
    }
    __syncthreads();
}

namespace pg8 {
constexpr int BM = 256, BK = 64, HALF = 128, HTB = HALF * BK * 2, STAGE_BYTES = 8 * HTB, NXCD = 8, WGM = 8;
__host__ __device__ __forceinline__ int lds_byte(int r, int c) { const int st = (r >> 4) * 2 + (c >> 5), rr = r & 15, cc = c & 31, ob = rr * 64 + cc * 2; return st * 1024 + (ob ^ (((ob >> 9) & 1) << 5)); }
__host__ __device__ __forceinline__ void stage_rc(int b, int& R, int& C) { const int st = b / 1024, sb = b % 1024, swz = sb ^ (((sb >> 9) & 1) << 5); R = (st >> 1) * 16 + swz / 64; C = (st & 1) * 32 + (swz % 64) / 2; }
__host__ __device__ __forceinline__ int perm32(int rho) { const int n = rho >> 4, i = rho & 15; return 8 * (i >> 2) + 4 * n + (i & 3); }

struct Unit { int pm, pn, e, ti, nv; };

template <class Epi, class Sched, bool GATHER, int K>
__device__ __forceinline__ void gemm_phase(LAS unsigned char* lds, const Sched& S, const Epi& E, const int tid) {
    const int wid = __builtin_amdgcn_readfirstlane(tid >> 6), lane = tid & 63, wr = wid >> 2, wc = wid & 3, fr = lane & 15, fq = lane >> 4;
    const int nt = K / BK;
    unsigned voffA[2], voffB[2]; int RA[2], CA[2];
#pragma unroll
    for (int i = 0; i < 2; ++i) { int R, C; stage_rc(tid * 16 + i * 8192, R, C); const int Rb = Epi::PERM ? ((R & ~31) + perm32(R & 31)) : R;
        RA[i] = R; CA[i] = C; voffA[i] = (unsigned)(R * K + C) * 2u; voffB[i] = (unsigned)(Rb * K + C) * 2u; }
    const size_t kstep = (size_t)(BK * 2);
    const size_t hstep = (size_t)HALF * K * 2;
    const unsigned ldsw = (unsigned)wid * 1024u;
    const int aoff = lds_byte(wr * 64 + fr, fq * 8), boff = lds_byte(wc * 32 + fr, fq * 8);
    unsigned gA[2][2], ngA[2][2];
#define PG8_SA(b, h) (((b) * 2 + (h)) * HTB)
#define PG8_SB(b, h) ((4 + (b) * 2 + (h)) * HTB)
#define PG8_STAGE(bufoff, gbase, voff) do { _Pragma("unroll") for (int _i = 0; _i < 2; ++_i) \
        __builtin_amdgcn_global_load_lds((const unsigned*)((const char*)(gbase) + (voff)[_i]), (LAS unsigned*)(lds + (bufoff) + ldsw + _i * 8192), 16, 0, 0); } while (0)
#define PG8_STAGE_A(bufoff, gptr, H, NX) do { _Pragma("unroll") for (int _i = 0; _i < 2; ++_i) { \
        const unsigned _vo = GATHER ? ((NX) ? ngA[H][_i] : gA[H][_i]) : voffA[_i]; \
        const char* _gp = GATHER ? (const char*)(gptr) : (const char*)(gptr) + (H) * hstep; \
        __builtin_amdgcn_global_load_lds((const unsigned*)(_gp + _vo), (LAS unsigned*)(lds + (bufoff) + ldsw + _i * 8192), 16, 0, 0); } } while (0)
#define PG8_LDA(dst, b, h) do { _Pragma("unroll") for (int m = 0; m < 4; ++m) _Pragma("unroll") for (int k = 0; k < 2; ++k) dst[m][k] = *(const LAS bf16x8*)(lds + PG8_SA(b, h) + aoff + m * 2048 + k * 1024); } while (0)
#define PG8_LDB(dst, b, h) do { _Pragma("unroll") for (int n = 0; n < 2; ++n) _Pragma("unroll") for (int k = 0; k < 2; ++k) dst[n][k] = *(const LAS bf16x8*)(lds + PG8_SB(b, h) + boff + n * 2048 + k * 1024); } while (0)
#define PG8_MMA(ai, bj, At, Bt) do { __builtin_amdgcn_s_setprio(1); _Pragma("unroll") for (int m = 0; m < 4; ++m) _Pragma("unroll") for (int n = 0; n < 2; ++n) _Pragma("unroll") for (int k = 0; k < 2; ++k) \
        acc[ai][bj][m][n] = __builtin_amdgcn_mfma_f32_16x16x32_bf16(Bt[n][k], At[m][k], acc[ai][bj][m][n], 0, 0, 0); __builtin_amdgcn_s_setprio(0); } while (0)
#define PG8_WAIT_V(n) asm volatile("s_waitcnt vmcnt(" #n ")" ::: "memory")
#define PG8_WAIT_L(n) asm volatile("s_waitcnt lgkmcnt(" #n ")" ::: "memory")
#define PG8_BAR __builtin_amdgcn_s_barrier()
#define PG8_SCHED __builtin_amdgcn_sched_barrier(0)
#define PG8_GLOAD(dst, u) do { if constexpr (GATHER) { const int* _rm = S.rows(u); \
        _Pragma("unroll") for (int _h = 0; _h < 2; ++_h) _Pragma("unroll") for (int _i = 0; _i < 2; ++_i) { const int _r = _h * HALF + RA[_i]; \
            const int _tok = (_r < (u).nv) ? (_rm[_r] >> 1) : 0; dst[_h][_i] = (unsigned)(_tok * K + CA[_i]) * 2u; } \
        asm volatile("s_waitcnt vmcnt(0)" : "+v"(dst[0][0]), "+v"(dst[0][1]), "+v"(dst[1][0]), "+v"(dst[1][1]) :: "memory"); } } while (0)
    Unit cur, nxt; int ui = 0;
    if (!S.next(0, cur)) return;
    f32x4 acc[2][2][4][2];
#pragma unroll
    for (int a = 0; a < 2; ++a)
#pragma unroll
        for (int b = 0; b < 2; ++b)
#pragma unroll
            for (int m = 0; m < 4; ++m)
#pragma unroll
                for (int n = 0; n < 2; ++n) acc[a][b][m][n] = (f32x4){0.f, 0.f, 0.f, 0.f};
    bf16x8 At[4][2], B0[2][2], B1[2][2];
    const char* cA = S.a_base(cur); const char* cB = S.b_base(cur);
    PG8_GLOAD(gA, cur);
    PG8_STAGE(PG8_SB(0, 0), cB, voffB); PG8_STAGE(PG8_SB(0, 1), cB + hstep, voffB); PG8_STAGE_A(PG8_SA(0, 0), cA, 0, false); PG8_STAGE_A(PG8_SA(0, 1), cA, 1, false);
    if (wr == 1) PG8_BAR;
    PG8_WAIT_V(2); PG8_BAR;
    PG8_STAGE(PG8_SB(1, 0), cB + kstep, voffB); PG8_STAGE_A(PG8_SA(1, 0), cA + kstep, 0, false); PG8_STAGE(PG8_SB(1, 1), cB + hstep + kstep, voffB);
    PG8_WAIT_V(6); PG8_BAR;
    for (;;) {
        const bool has_next = S.next(ui + 1, nxt);
        const char* nA = has_next ? S.a_base(nxt) : cA; const char* nB = has_next ? S.b_base(nxt) : cB;
        if constexpr (GATHER) {
            if (has_next) { PG8_GLOAD(ngA, nxt); }
            else {
#pragma unroll
                for (int _h = 0; _h < 2; ++_h)
#pragma unroll
                    for (int _i = 0; _i < 2; ++_i) ngA[_h][_i] = gA[_h][_i]; }
        }
        for (int t = 0; t < nt; t += 2) {
            const bool last = (t == nt - 2);
            const char* a1 = cA + (size_t)(t + 1) * kstep;
            const char* a2 = last ? nA : cA + (size_t)(t + 2) * kstep; const char* b2 = last ? nB : cB + (size_t)(t + 2) * kstep;
            const char* a3 = a2 + kstep; const char* b3 = b2 + kstep;
            PG8_LDB(B0, 0, 0); PG8_LDB(B1, 0, 1); PG8_SCHED; PG8_LDA(At, 0, 0); PG8_STAGE_A(PG8_SA(1, 1), a1, 1, false);
            PG8_WAIT_V(8); PG8_WAIT_L(0); PG8_BAR; PG8_MMA(0, 0, At, B0); PG8_MMA(0, 1, At, B1); PG8_BAR; PG8_SCHED;
            PG8_LDA(At, 0, 1); PG8_STAGE(PG8_SB(0, 0), b2, voffB); PG8_STAGE(PG8_SB(0, 1), b2 + hstep, voffB); PG8_STAGE_A(PG8_SA(0, 0), a2, 0, last);
            PG8_WAIT_V(8); PG8_WAIT_L(0); PG8_BAR; PG8_MMA(1, 0, At, B0); PG8_MMA(1, 1, At, B1); PG8_BAR; PG8_SCHED;
            PG8_LDB(B0, 1, 0); PG8_LDB(B1, 1, 1); PG8_SCHED; PG8_LDA(At, 1, 0); PG8_STAGE_A(PG8_SA(0, 1), a2, 1, last);
            PG8_WAIT_V(8); PG8_WAIT_L(0); PG8_BAR; PG8_MMA(0, 0, At, B0); PG8_MMA(0, 1, At, B1); PG8_BAR; PG8_SCHED;
            PG8_LDA(At, 1, 1); PG8_STAGE(PG8_SB(1, 0), b3, voffB); PG8_STAGE(PG8_SB(1, 1), b3 + hstep, voffB); PG8_STAGE_A(PG8_SA(1, 0), a3, 0, last);
            PG8_WAIT_V(8); PG8_WAIT_L(0); PG8_BAR; PG8_MMA(1, 0, At, B0); PG8_MMA(1, 1, At, B1); PG8_BAR; PG8_SCHED;
        }
        if (wr == 0) PG8_BAR;
        E(acc, cur, wr, wc, fr, fq);
        if (!has_next) break;
#pragma unroll
        for (int a = 0; a < 2; ++a)
#pragma unroll
            for (int b = 0; b < 2; ++b)
#pragma unroll
                for (int m = 0; m < 4; ++m)
#pragma unroll
                    for (int n = 0; n < 2; ++n) acc[a][b][m][n] = (f32x4){0.f, 0.f, 0.f, 0.f};
        cur = nxt; cA = nA; cB = nB; ++ui;
        if constexpr (GATHER) {
#pragma unroll
            for (int _h = 0; _h < 2; ++_h)
#pragma unroll
                for (int _i = 0; _i < 2; ++_i) gA[_h][_i] = ngA[_h][_i]; }
        if (wr == 1) PG8_BAR;
    }
    PG8_WAIT_V(0);
    PG8_BAR;
#undef PG8_SA
#undef PG8_SB
#undef PG8_STAGE
#undef PG8_STAGE_A
#undef PG8_LDA
#undef PG8_LDB
#undef PG8_MMA
#undef PG8_WAIT_V
#undef PG8_WAIT_L
#undef PG8_BAR
#undef PG8_SCHED
#undef PG8_GLOAD
}

struct DenseSched {
    const char *A0, *B0, *A1, *B1; int K; int nM, nN, nwg, G, c, nM1, nwg1;
    __device__ __forceinline__ void init(const void* a0, const void* b0, int M, int N, int K_, const void* a1, const void* b1, int M1, int N1, int G_, int c_) {
        A0 = (const char*)a0; B0 = (const char*)b0; A1 = (const char*)a1; B1 = (const char*)b1; K = K_; nM = M / BM; nN = N / BM; nwg = nM * nN; G = G_; c = c_;
        nM1 = M1 / BM > 0 ? M1 / BM : 1; nwg1 = (M1 / BM) * (N1 / BM); }
    __device__ __forceinline__ bool next(int i, Unit& u) const {
        const int L = i * G + c; if (L >= nwg + nwg1) return false;
        u.ti = 0; u.nv = BM;
        if (L < nwg) {
            int wgid = L; { const int q = nwg / NXCD, r = nwg % NXCD, xcd = wgid % NXCD, off = wgid / NXCD; wgid = (xcd < r ? xcd * (q + 1) : r * (q + 1) + (xcd - r) * q) + off; }
            const int nig = WGM * nN, gid = wgid / nig, fm = gid * WGM, gsz = (nM - fm) < WGM ? (nM - fm) : WGM;
            u.pm = fm + ((wgid % nig) % gsz); u.pn = (wgid % nig) / gsz; u.e = 0;
        } else { const int l = L - nwg; u.pm = l % nM1; u.pn = l / nM1; u.e = 1; }
        return true;
    }
    __device__ __forceinline__ const char* a_base(const Unit& u) const { return (u.e ? A1 : A0) + (size_t)u.pm * BM * K * 2; }
    __device__ __forceinline__ const char* b_base(const Unit& u) const { return (u.e ? B1 : B0) + (size_t)u.pn * BM * K * 2; }
    __device__ __forceinline__ const int* rows(const Unit&) const { return nullptr; }
};
struct MoeSched {
    const char* A; const char* Bt; int K; size_t bstride; const LAS int* tpre; const int* rowmap; int G, c; bool gather;
    __device__ __forceinline__ bool next(int i, Unit& u) const {
        const int L = i * G + c; const int tot = tpre[16]; if (L >= tot * 4) return false;
        const int rt = L >> 2; int e = 0;
#pragma unroll
        for (int k = 1; k < 16; ++k) e += (rt >= tpre[k]) ? 1 : 0;
        const int ti = rt - tpre[e]; const int rem = tpre[32 + e] - ti * BM;
        u.pn = L & 3; u.pm = __builtin_amdgcn_readfirstlane(rt); u.e = __builtin_amdgcn_readfirstlane(e); u.ti = __builtin_amdgcn_readfirstlane(ti); u.nv = __builtin_amdgcn_readfirstlane(rem < BM ? rem : BM);
        return true;
    }
    __device__ __forceinline__ const char* a_base(const Unit& u) const { return gather ? A : A + (size_t)u.pm * BM * K * 2; }
    __device__ __forceinline__ const char* b_base(const Unit& u) const { return Bt + (size_t)u.e * bstride + (size_t)u.pn * BM * K * 2; }
    __device__ __forceinline__ const int* rows(const Unit& u) const { return rowmap + (size_t)u.e * RCAP + u.ti * BM; }
};

struct EpiProj {
    static constexpr bool PERM = true;
    bf16_t* O0; int ldc0; unsigned smask; float sc; bf16_t* O1; int ldc1;
    __device__ __forceinline__ void operator()(const f32x4 (&acc)[2][2][4][2], const Unit& u, int wr, int wc, int fr, int fq) const {
        bf16_t* O = u.e ? O1 : O0; const int ldc = u.e ? ldc1 : ldc0; const float s = (!u.e && ((smask >> u.pn) & 1u)) ? sc : 1.f;
        const int row0 = u.pm * BM + wr * 64 + fr, col0 = u.pn * BM + wc * 32 + 8 * fq;
#pragma unroll
        for (int ai = 0; ai < 2; ++ai)
#pragma unroll
            for (int m = 0; m < 4; ++m) { bf16_t* rowp = O + (size_t)(row0 + ai * HALF + m * 16) * ldc + col0;
#pragma unroll
                for (int bj = 0; bj < 2; ++bj) { const f32x4 v0 = acc[ai][bj][m][0] * s, v1 = acc[ai][bj][m][1] * s; u32x4 w;
                    w.x = cvt_pk_bf16(v0[0], v0[1]); w.y = cvt_pk_bf16(v0[2], v0[3]); w.z = cvt_pk_bf16(v1[0], v1[1]); w.w = cvt_pk_bf16(v1[2], v1[3]);
                    *(u32x4*)(rowp + bj * HALF) = w; } }
    }
};
struct EpiZ {
    static constexpr bool PERM = false;
    const float* res; float* out;
    __device__ __forceinline__ void operator()(const f32x4 (&acc)[2][2][4][2], const Unit& u, int wr, int wc, int fr, int fq) const {
        const int row0 = u.pm * BM + wr * 64 + fr, col0 = u.pn * BM + wc * 32 + 4 * fq;
#pragma unroll
        for (int ai = 0; ai < 2; ++ai)
#pragma unroll
            for (int m = 0; m < 4; ++m) { const size_t off = (size_t)(row0 + ai * HALF + m * 16) * DM + col0;
#pragma unroll
                for (int bj = 0; bj < 2; ++bj)
#pragma unroll
                    for (int n = 0; n < 2; ++n) { const f32x4 r = *(const f32x4*)(res + off + bj * HALF + n * 16); *(f32x4*)(out + off + bj * HALF + n * 16) = r * ALPHA + acc[ai][bj][m][n]; } }
    }
};
struct EpiGU {
    static constexpr bool PERM = true;
    bf16_t* H;
    __device__ __forceinline__ void operator()(const f32x4 (&acc)[2][2][4][2], const Unit& u, int wr, int wc, int fr, int fq) const {
        const int row0 = u.pm * BM + wr * 64 + fr, col0 = u.pn * HALF + wc * 32 + 8 * fq;
#pragma unroll
        for (int ai = 0; ai < 2; ++ai)
#pragma unroll
            for (int m = 0; m < 4; ++m) { float hv[8];
#pragma unroll
                for (int n = 0; n < 2; ++n)
#pragma unroll
                    for (int j = 0; j < 4; ++j) { const float g = acc[ai][0][m][n][j], uu = acc[ai][1][m][n][j];
                        hv[n * 4 + j] = g * __builtin_amdgcn_rcpf(1.f + __builtin_amdgcn_exp2f(-1.4426950408889634f * g)) * uu; }
                u32x4 w; w.x = cvt_pk_bf16(hv[0], hv[1]); w.y = cvt_pk_bf16(hv[2], hv[3]); w.z = cvt_pk_bf16(hv[4], hv[5]); w.w = cvt_pk_bf16(hv[6], hv[7]);
                *(u32x4*)(H + (size_t)(row0 + ai * HALF + m * 16) * DEXP + col0) = w; }
    }
};
struct EpiDown {
    static constexpr bool PERM = true;
    bf16_t* Y; const int* rowmap; const float* roww;
    __device__ __forceinline__ void operator()(const f32x4 (&acc)[2][2][4][2], const Unit& u, int wr, int wc, int fr, int fq) const {
        const int* rm = rowmap + (size_t)u.e * RCAP + u.ti * BM; const float* rw = roww + (size_t)u.e * RCAP + u.ti * BM;
        const int col0 = u.pn * BM + wc * 32 + 8 * fq;
#pragma unroll
        for (int ai = 0; ai < 2; ++ai)
#pragma unroll
            for (int m = 0; m < 4; ++m) { const int r = ai * HALF + wr * 64 + m * 16 + fr;
                if (r < u.nv) { const int code = rm[r]; const float s = rw[r];
                    bf16_t* rowp = Y + ((size_t)(code & 1) * NTOK + (size_t)(code >> 1)) * DM + col0;
#pragma unroll
                    for (int bj = 0; bj < 2; ++bj) { const f32x4 v0 = acc[ai][bj][m][0] * s, v1 = acc[ai][bj][m][1] * s; u32x4 w;
                        w.x = cvt_pk_bf16(v0[0], v0[1]); w.y = cvt_pk_bf16(v0[2], v0[3]); w.z = cvt_pk_bf16(v1[0], v1[1]); w.w = cvt_pk_bf16(v1[2], v1[3]);
                        *(u32x4*)(rowp + bj * HALF) = w; } } }
    }
};
}

namespace attn_body {
using bf16 = bf16_t;
constexpr int D = 64, NW = 8, QBLK = 32, QB = QBLK * NW, KVBLK = 64;
__device__ __forceinline__ int crow(int r, int hi) { return (r & 3) + 8 * (r >> 2) + 4 * hi; }
#define SBAR() __builtin_amdgcn_sched_barrier(0)
constexpr int NSLOT = 3, SLOTB = 8192;
constexpr int LDS_K = 0, LDS_V = NSLOT * SLOTB, LDS_WS = 2 * NSLOT * SLOTB, LDS_OST = LDS_WS + NW * 64 * 4, LDS_BYTES_A = LDS_OST + NW * 4096;
__device__ __forceinline__ void glds16(const void* gsrc, unsigned lds_dst) { unsigned keep;
  asm volatile("s_mov_b32 %0, m0\n\ts_mov_b32 m0, %2\n\ts_nop 0\n\tglobal_load_lds_dwordx4 %1, off\n\ts_mov_b32 m0, %0" : "=&s"(keep) : "v"(gsrc), "s"(lds_dst) : "memory"); }
__device__ __forceinline__ float max3f(float a, float b, float c) { float r; asm("v_max3_f32 %0, %1, %2, %3" : "=v"(r) : "v"(a), "v"(b), "v"(c)); return r; }
__device__ __forceinline__ float max2f(float a, float b) { float r; asm("v_max_f32_e32 %0, %1, %2" : "=v"(r) : "v"(a), "v"(b)); return r; }
__device__ __forceinline__ float fadd_s(float a, float b) { float r; asm("v_add_f32_e32 %0, %1, %2" : "=v"(r) : "v"(a), "v"(b)); return r; }
__device__ __forceinline__ float fsub_s(float a, float b) { float r; asm("v_sub_f32_e32 %0, %1, %2" : "=v"(r) : "v"(a), "v"(b)); return r; }
typedef float f32x2_t __attribute__((ext_vector_type(2))); typedef __bf16 bf16x2_t __attribute__((ext_vector_type(2)));
__device__ __forceinline__ unsigned cvtpk_s(float lo, float hi) { f32x2_t v = {lo, hi}; bf16x2_t b = __builtin_convertvector(v, bf16x2_t); return __builtin_bit_cast(unsigned, b); }
#define WAIT_BAR(N) asm volatile("s_waitcnt vmcnt(" #N ") lgkmcnt(0)\n\ts_barrier" ::: "memory")
__device__ __forceinline__ void qkt(f32x16& p0, f32x16& p1, const char* Kslot, const bf16x8* qr, const f32x16& negm, int r32, int hi) {
  const char* kb = Kslot + hi * 1024 + r32 * 16;
  #pragma unroll
  for (int d0 = 0; d0 < 4; ++d0) {
    const bf16x8 b0 = *reinterpret_cast<const bf16x8*>(kb + d0 * 2048);
    const bf16x8 b1 = *reinterpret_cast<const bf16x8*>(kb + d0 * 2048 + 512);
    if (d0 == 0) { p0 = __builtin_amdgcn_mfma_f32_32x32x16_bf16(b0, qr[0], negm, 0, 0, 0); p1 = __builtin_amdgcn_mfma_f32_32x32x16_bf16(b1, qr[0], negm, 0, 0, 0); }
    else { p0 = __builtin_amdgcn_mfma_f32_32x32x16_bf16(b0, qr[d0], p0, 0, 0, 0); p1 = __builtin_amdgcn_mfma_f32_32x32x16_bf16(b1, qr[d0], p1, 0, 0, 0); } }
}
typedef __attribute__((address_space(3))) const char* lds_cptr;
typedef short v4i16_t __attribute__((ext_vector_type(4)));
__device__ __forceinline__ void kload8(bf16x8* kf, lds_cptr kp) {
  kf[0] = *(const LAS bf16x8*)(kp);        kf[1] = *(const LAS bf16x8*)(kp + 512);
  kf[2] = *(const LAS bf16x8*)(kp + 2048); kf[3] = *(const LAS bf16x8*)(kp + 2560);
  kf[4] = *(const LAS bf16x8*)(kp + 4096); kf[5] = *(const LAS bf16x8*)(kp + 4608);
  kf[6] = *(const LAS bf16x8*)(kp + 6144); kf[7] = *(const LAS bf16x8*)(kp + 6656);
}
__device__ __forceinline__ void kload2(bf16x8* kf, lds_cptr kp, int j) { kf[2 * j] = *(const LAS bf16x8*)(kp + j * 2048); kf[2 * j + 1] = *(const LAS bf16x8*)(kp + j * 2048 + 512); }
__device__ __forceinline__ s16x4 vtr(lds_cptr p) { return __builtin_bit_cast(s16x4, __builtin_amdgcn_ds_read_tr16_b64_v4i16((LAS v4i16_t*)p)); }
__device__ __forceinline__ float rowmax(const f32x16& p0, const f32x16& p1) {
  float a = max3f(p0[0], p0[1], p1[0]), b = max3f(p0[2], p0[3], p1[1]); a = max3f(a, p1[2], p1[3]);
  #pragma unroll
  for (int r = 4; r < 16; r += 4) { a = max3f(a, p0[r], p0[r + 1]); b = max3f(b, p0[r + 2], p0[r + 3]); a = max3f(a, p1[r], p1[r + 1]); b = max3f(b, p1[r + 2], p1[r + 3]); }
  const float m = max2f(a, b);
  auto rr = __builtin_amdgcn_permlane32_swap(__float_as_uint(m), __float_as_uint(m), false, false);
  return max2f(__uint_as_float(rr[0]), __uint_as_float(rr[1]));
}
__device__ __forceinline__ void pv(f32x16* o, int vb, bf16x8 pa0, bf16x8 pa1, bf16x8 pa2, bf16x8 pa3) {
  #pragma unroll
  for (int d0 = 0; d0 < 2; ++d0) { s16x4 lo[4], hi[4];
    #pragma unroll
    for (int ks = 0; ks < 4; ++ks) {
      asm volatile("ds_read_b64_tr_b16 %0,%1 offset:%c2" : "=&v"(lo[ks]) : "v"(vb), "i"(d0 * 4096 + ks * 1024) : "memory");
      asm volatile("ds_read_b64_tr_b16 %0,%1 offset:%c2" : "=&v"(hi[ks]) : "v"(vb), "i"(d0 * 4096 + ks * 1024 + 512) : "memory"); }
    asm volatile("s_waitcnt lgkmcnt(0)" ::: "memory"); SBAR();
    #define PK(k) (bf16x8){lo[k][0], lo[k][1], lo[k][2], lo[k][3], hi[k][0], hi[k][1], hi[k][2], hi[k][3]}
    o[d0] = __builtin_amdgcn_mfma_f32_32x32x16_bf16(pa0, PK(0), o[d0], 0, 0, 0);
    o[d0] = __builtin_amdgcn_mfma_f32_32x32x16_bf16(pa1, PK(1), o[d0], 0, 0, 0);
    o[d0] = __builtin_amdgcn_mfma_f32_32x32x16_bf16(pa2, PK(2), o[d0], 0, 0, 0);
    o[d0] = __builtin_amdgcn_mfma_f32_32x32x16_bf16(pa3, PK(3), o[d0], 0, 0, 0);
    #undef PK
  }
}
template<int THRL, int QP, int KP, int VP, int OP, int NT> __device__ __forceinline__ void attn_unit(const bf16* Qb, const bf16* __restrict__ Kb, const bf16* __restrict__ Vb, bf16* Ob, const int q0, char* shm, const int tid) {
  const int lane = tid & 63, r32 = lane & 31, hi = lane >> 5; const int wid = __builtin_amdgcn_readfirstlane(tid >> 6);
  const bf16* Qw = Qb + (long)(q0 + wid * QBLK) * QP;
  const unsigned lds0 = (unsigned)(uintptr_t)shm;
  float* wsf = (float*)(shm + LDS_WS) + wid * 64;
  const bf16* ksrc = Kb + (long)lane * KP + wid * 8;
  const bf16* vsrc = Vb + (long)(16 * (wid & 3) + (lane >> 2)) * VP + (wid >> 2) * 32 + (lane & 3) * 8;
  const unsigned kdst = lds0 + LDS_K + wid * 1024, vdst = lds0 + LDS_V + wid * 1024;
  #define DMA_K(t, slot) glds16(ksrc + (long)(t) * KVBLK * KP, (unsigned)__builtin_amdgcn_readfirstlane(kdst + (slot)))
  #define DMA_V(t, slot) glds16(vsrc + (long)(t) * KVBLK * VP, (unsigned)__builtin_amdgcn_readfirstlane(vdst + (slot)))
  const int vb0 = (int)(lds0 + LDS_V) + ((lane >> 4) & 1) * 32 + (lane & 3) * 8 + (4 * hi + ((lane & 15) >> 2)) * 64;
  const char* Kbase = shm + LDS_K; bf16x8 kf[8];
  const lds_cptr shm3 = (lds_cptr)shm; const lds_cptr kp0 = shm3 + LDS_K + hi * 1024 + r32 * 16; const lds_cptr vp0 = shm3 + LDS_V + ((lane >> 4) & 1) * 32 + (lane & 3) * 8 + (4 * hi + ((lane & 15) >> 2)) * 64;
  DMA_K(0, 0); DMA_V(0, 0); DMA_K(1, SLOTB);
  bf16x8 qr[4];
  #pragma unroll
  for (int d0 = 0; d0 < 4; ++d0) qr[d0] = *reinterpret_cast<const bf16x8*>(&Qw[(long)r32 * QP + d0 * 16 + hi * 8]);
  float mhat = 0.f, l_reg = 0.f; f32x16 o[2]; o[0] = f32x16{}; o[1] = f32x16{}; float zz_ = 0.f; asm volatile("" : "+v"(zz_)); f32x16 negm; _Pragma("unroll") for (int r = 0; r < 16; ++r) negm[r] = zz_; asm volatile("" : "+v"(negm));
  bool resc = false;
  #define START(P0, P1) do { const float rm = rowmax(P0, P1); resc = false; \
    { const float dl = rm; mhat = fadd_s(mhat, dl); \
      _Pragma("unroll") for (int r = 0; r < 16; ++r) { P0[r] = fsub_s(P0[r], dl); P1[r] = fsub_s(P1[r], dl); } \
      _Pragma("unroll") for (int r = 0; r < 16; ++r) negm[r] = -mhat; asm volatile("" : "+v"(negm)); } \
    _Pragma("unroll") for (int r = 0; r < 16; ++r) P0[r] = __builtin_amdgcn_exp2f(P0[r]); } while (0)
  #define RESC() do { if (resc) { asm volatile("s_waitcnt lgkmcnt(0)" ::: "memory"); \
      _Pragma("unroll") for (int d_ = 0; d_ < 2; ++d_) _Pragma("unroll") for (int r = 0; r < 16; ++r) o[d_][r] *= wsf[crow(r, hi)]; } } while (0)
  f32x16 pA0, pA1, pB0, pB1;
  int sl_prev = 0, sl_cur = 0, sl_next = SLOTB;
  #define ROT() do { sl_prev = sl_cur; sl_cur = sl_next; sl_next = (sl_next == (NSLOT - 1) * SLOTB) ? 0 : sl_next + SLOTB; } while (0)
  DMA_K(2, 2 * SLOTB);
  WAIT_BAR(3);
  qkt(pA0, pA1, Kbase, qr, negm, r32, hi); asm volatile("s_nop 15\n\ts_nop 7" : "+v"(pA0), "+v"(pA1));
  START(pA0, pA1);
  _Pragma("unroll") for (int r = 0; r < 16; ++r) pA1[r] = __builtin_amdgcn_exp2f(pA1[r]);
  WAIT_BAR(0);
  DMA_K(3, 0); DMA_V(1, SLOTB);
  ROT();
  kload8(kf, kp0 + sl_cur);
  WAIT_BAR(2);
  s16x4 vlo[8], vhi[8]; u32x4 pw0, pw1, pw2, pw3;
  #define PKW(P, B) cvtpk_s(P[B], P[B + 1])
  #define PAF(k) __builtin_bit_cast(bf16x8, pw##k)
  #define VFR(i) (bf16x8){vlo[i][0], vlo[i][1], vlo[i][2], vlo[i][3], vhi[i][0], vhi[i][1], vhi[i][2], vhi[i][3]}
  #define PIN(x) asm volatile("" : "+v"(x))
  #define MX3(a, b, c) __builtin_fmaxf(__builtin_fmaxf((a), (b)), (c))
  #define GAPA(MF, A0, A1, A2, A3, W0, W1, PW) do { MF; sacc += A0; sacc += A1; sacc += A2; sacc += A3; PIN(sacc); W0; W1; PIN(PW); SBAR(); } while (0)
  #define EX(v) __builtin_amdgcn_exp2f(v)
  #define GAPB(MF, X, B) do { MF; X[B] = EX(X[B]); X[B + 1] = EX(X[B + 1]); X[B + 2] = EX(X[B + 2]); X[B + 3] = EX(X[B + 3]); PIN(X); SBAR(); } while (0)
  #define VRD(i) do { vlo[i] = vtr(vp_ + (((i) >> 2) * 4096 + ((i) & 3) * 1024)); vhi[i] = vtr(vp_ + (((i) >> 2) * 4096 + ((i) & 3) * 1024 + 512)); } while (0)
  #define KRD(G, j) do { if (G) { kload2(kf, kp0 + sl_next, j); SBAR(); } } while (0)
  #define STEP(C0, C1, P0, P1, t, GK, GV, GL) do { SBAR(); \
    const lds_cptr vp_ = vp0 + sl_prev; \
    VRD(0); SBAR(); float sacc = (P0[0] + P0[1]); \
    GAPA(C0 = __builtin_amdgcn_mfma_f32_32x32x16_bf16(kf[0], qr[0], negm, 0, 0, 0), P0[2], P0[3], P0[4], P0[5],     pw0[0] = PKW(P0, 0), pw0[1] = PKW(P0, 2), pw0); \
    VRD(4); SBAR(); GAPA(C1 = __builtin_amdgcn_mfma_f32_32x32x16_bf16(kf[1], qr[0], negm, 0, 0, 0), P0[6], P0[7], P0[8], P0[9],     pw0[2] = PKW(P0, 4), pw0[3] = PKW(P0, 6), pw0); \
    VRD(1); SBAR(); GAPA(C0 = __builtin_amdgcn_mfma_f32_32x32x16_bf16(kf[2], qr[1], C0, 0, 0, 0),   P0[10], P0[11], P0[12], P0[13], pw1[0] = PKW(P0, 8), pw1[1] = PKW(P0, 10), pw1); \
    VRD(5); SBAR(); GAPA(C1 = __builtin_amdgcn_mfma_f32_32x32x16_bf16(kf[3], qr[1], C1, 0, 0, 0),   P0[14], P0[15], P1[0], P1[1],   pw1[2] = PKW(P0, 12), pw1[3] = PKW(P0, 14), pw1); \
    VRD(2); SBAR(); GAPA(C0 = __builtin_amdgcn_mfma_f32_32x32x16_bf16(kf[4], qr[2], C0, 0, 0, 0),   P1[2], P1[3], P1[4], P1[5],     pw2[0] = PKW(P1, 0), pw2[1] = PKW(P1, 2), pw2); \
    VRD(6); SBAR(); GAPA(C1 = __builtin_amdgcn_mfma_f32_32x32x16_bf16(kf[5], qr[2], C1, 0, 0, 0),   P1[6], P1[7], P1[8], P1[9],     pw2[2] = PKW(P1, 4), pw2[3] = PKW(P1, 6), pw2); \
    VRD(3); SBAR(); GAPA(C0 = __builtin_amdgcn_mfma_f32_32x32x16_bf16(kf[6], qr[3], C0, 0, 0, 0),   P1[10], P1[11], P1[12], P1[13], pw3[0] = PKW(P1, 8), pw3[1] = PKW(P1, 10), pw3); \
    VRD(7); SBAR(); GAPA(C1 = __builtin_amdgcn_mfma_f32_32x32x16_bf16(kf[7], qr[3], C1, 0, 0, 0),   P1[14], P1[15], 0.f, 0.f,       pw3[2] = PKW(P1, 12), pw3[3] = PKW(P1, 14), pw3); \
    l_reg += sacc; \
    if (GK) { DMA_K((t) + 3, sl_cur); } if (GV) { DMA_V((t) + 1, sl_next); } \
    { float a = MX3(C0[0], C0[1], C1[0]), b = MX3(C0[2], C0[3], C1[1]); a = MX3(a, C1[2], C1[3]); \
      _Pragma("unroll") for (int r = 4; r < 16; r += 4) { a = MX3(a, C0[r], C0[r + 1]); b = MX3(b, C0[r + 2], C0[r + 3]); a = MX3(a, C1[r], C1[r + 1]); b = MX3(b, C1[r + 2], C1[r + 3]); } \
      float rm = __builtin_fmaxf(a, b); { auto rr = __builtin_amdgcn_permlane32_swap(__float_as_uint(rm), __float_as_uint(rm), false, false); rm = __builtin_fmaxf(__uint_as_float(rr[0]), __uint_as_float(rr[1])); } \
      resc = false; \
      if (__builtin_expect(__any(rm > (float)THRL), 0)) { const float dl = __builtin_fmaxf(rm, 0.f); mhat += dl; \
        _Pragma("unroll") for (int r = 0; r < 16; ++r) { C0[r] -= dl; C1[r] -= dl; } \
        _Pragma("unroll") for (int r = 0; r < 16; ++r) negm[r] = -mhat; asm volatile("" : "+v"(negm)); \
        const float f = __builtin_amdgcn_exp2f(-dl); l_reg *= f; if (hi == 0) wsf[r32] = f; resc = true; } } \
    SBAR(); \
    GAPB(o[0] = __builtin_amdgcn_mfma_f32_32x32x16_bf16(PAF(0), VFR(0), o[0], 0, 0, 0), C0, 0); \
    GAPB(o[1] = __builtin_amdgcn_mfma_f32_32x32x16_bf16(PAF(0), VFR(4), o[1], 0, 0, 0), C0, 4); \
    KRD(GL, 0); GAPB(o[0] = __builtin_amdgcn_mfma_f32_32x32x16_bf16(PAF(1), VFR(1), o[0], 0, 0, 0), C0, 8); \
    KRD(GL, 1); GAPB(o[1] = __builtin_amdgcn_mfma_f32_32x32x16_bf16(PAF(1), VFR(5), o[1], 0, 0, 0), C0, 12); \
    KRD(GL, 2); GAPB(o[0] = __builtin_amdgcn_mfma_f32_32x32x16_bf16(PAF(2), VFR(2), o[0], 0, 0, 0), C1, 0); \
    KRD(GL, 3); GAPB(o[1] = __builtin_amdgcn_mfma_f32_32x32x16_bf16(PAF(2), VFR(6), o[1], 0, 0, 0), C1, 4); \
    GAPB(o[0] = __builtin_amdgcn_mfma_f32_32x32x16_bf16(PAF(3), VFR(3), o[0], 0, 0, 0), C1, 8); \
    GAPB(o[1] = __builtin_amdgcn_mfma_f32_32x32x16_bf16(PAF(3), VFR(7), o[1], 0, 0, 0), C1, 12); \
    } while (0)
  int t = 1;
  for (; t + 5 < NT; t += 2) {
    STEP(pB0, pB1, pA0, pA1, t, true, true, true);     WAIT_BAR(2); RESC(); ROT();
    STEP(pA0, pA1, pB0, pB1, t + 1, true, true, true); WAIT_BAR(2); RESC(); ROT();
  }
  #define ENDW(tt) do { if ((tt) + 3 < NT) { WAIT_BAR(2); } else if ((tt) + 2 < NT) { WAIT_BAR(1); } else { WAIT_BAR(0); } } while (0)
  for (; t + 1 < NT; t += 2) {
    STEP(pB0, pB1, pA0, pA1, t, (t + 3 < NT), (t + 1 < NT), (t + 1 < NT));         ENDW(t);     RESC(); ROT();
    STEP(pA0, pA1, pB0, pB1, t + 1, (t + 4 < NT), (t + 2 < NT), (t + 2 < NT));     ENDW(t + 1); RESC(); ROT();
  }
  STEP(pB0, pB1, pA0, pA1, NT - 1, false, false, false); RESC();
  { float sacc = pB0[0] + pB0[1]; _Pragma("unroll") for (int r = 2; r < 16; ++r) sacc += pB0[r]; _Pragma("unroll") for (int r = 0; r < 16; ++r) sacc += pB1[r]; l_reg += sacc;
    pw0 = (u32x4){PKW(pB0, 0), PKW(pB0, 2), PKW(pB0, 4), PKW(pB0, 6)}; pw1 = (u32x4){PKW(pB0, 8), PKW(pB0, 10), PKW(pB0, 12), PKW(pB0, 14)}; pw2 = (u32x4){PKW(pB1, 0), PKW(pB1, 2), PKW(pB1, 4), PKW(pB1, 6)}; pw3 = (u32x4){PKW(pB1, 8), PKW(pB1, 10), PKW(pB1, 12), PKW(pB1, 14)};
    SBAR(); pv(o, vb0 + sl_cur, PAF(0), PAF(1), PAF(2), PAF(3)); }
  #undef PKW
  #undef PAF
  #undef VFR
  #undef PIN
  #undef MX3
  #undef GAPA
  #undef GAPB
  #undef EX
  #undef VRD
  #undef KRD
  #undef STEP
  #undef ENDW
  { auto rr = __builtin_amdgcn_permlane32_swap(__float_as_uint(l_reg), __float_as_uint(l_reg), false, false); l_reg = __uint_as_float(rr[0]) + __uint_as_float(rr[1]); }
  if (hi == 0) wsf[32 + r32] = l_reg; asm volatile("s_waitcnt lgkmcnt(0)" ::: "memory");
  float rli[16];
  #pragma unroll
  for (int r = 0; r < 16; ++r) rli[r] = __builtin_amdgcn_rcpf(wsf[32 + crow(r, hi)]);
  bf16* Ow = Ob + (long)(q0 + wid * QBLK) * OP;
  { bf16* stg = (bf16*)(shm + LDS_OST) + wid * 2048;
    #pragma unroll
    for (int r = 0; r < 16; ++r) { const int orow = crow(r, hi);
      #pragma unroll
      for (int d0 = 0; d0 < 2; ++d0) stg[orow * 64 + d0 * 32 + r32] = (bf16)f2bf(o[d0][r] * rli[r]); }
    asm volatile("s_waitcnt lgkmcnt(0)" ::: "memory");
    #pragma unroll
    for (int i = 0; i < 4; ++i) { const int row = i * 8 + (lane >> 3), ch = lane & 7; const u32x4 v = *(const u32x4*)(stg + row * 64 + ch * 8); *(u32x4*)(Ow + (long)row * OP + ch * 8) = v; } }
  asm volatile("s_waitcnt lgkmcnt(0)\n\ts_barrier" ::: "memory");
  #undef DMA_K
  #undef DMA_V
  #undef START
  #undef RESC
  #undef ROT
}
#undef WAIT_BAR

__device__ __forceinline__ void band_item(const bf16* P1, float* lse, int b, int g, int h, int r, int qi, int dil, int Lr, char* wlds, int lane) {
  const int r32 = lane & 31, hi = lane >> 5;
  const long pitch = B_IN;
  const int colq = (g * 8 + h) * 64, colk = 1536 + colq, colv = 3072 + colq;
  const long row0 = (long)b * SEQ;
  bf16x8 qf[4];
  { const long tq = row0 + (long)(32 * qi + r32) * dil + r; const bf16* qp = P1 + tq * pitch + colq + hi * 8;
    #pragma unroll
    for (int d0 = 0; d0 < 4; ++d0) qf[d0] = *reinterpret_cast<const bf16x8*>(qp + d0 * 16); }
  f32x16 sc[5];
  const int nblk = Lr / 32;
  #pragma unroll
  for (int s = 0; s < 5; ++s) {
    const int kb = qi - 2 + s;
    if (kb >= 0 && kb < nblk) {
      const long tk = row0 + (long)(32 * kb + r32) * dil + r; const bf16* kp = P1 + tk * pitch + colk + hi * 8;
      bf16x8 kf[4];
      #pragma unroll
      for (int d0 = 0; d0 < 4; ++d0) kf[d0] = *reinterpret_cast<const bf16x8*>(kp + d0 * 16);
      f32x16 a = f32x16{};
      #pragma unroll
      for (int d0 = 0; d0 < 4; ++d0) a = __builtin_amdgcn_mfma_f32_32x32x16_bf16(kf[d0], qf[d0], a, 0, 0, 0);
      if (s == 0) {
        #pragma unroll
        for (int rg = 0; rg < 16; ++rg) { const int j = crow(rg, hi); if (j < r32) a[rg] = -INFINITY; } }
      if (s == 4) {
        #pragma unroll
        for (int rg = 0; rg < 16; ++rg) { const int j = crow(rg, hi); if (j > r32) a[rg] = -INFINITY; } }
      sc[s] = a;
    } else {
      #pragma unroll
      for (int rg = 0; rg < 16; ++rg) sc[s][rg] = -INFINITY;
    }
  }
  float m = -INFINITY;
  #pragma unroll
  for (int s = 0; s < 5; ++s)
    #pragma unroll
    for (int rg = 0; rg < 16; ++rg) m = __builtin_fmaxf(m, sc[s][rg]);
  { auto rr = __builtin_amdgcn_permlane32_swap(__float_as_uint(m), __float_as_uint(m), false, false); m = __builtin_fmaxf(__uint_as_float(rr[0]), __uint_as_float(rr[1])); }
  float l = 0.f;
  #pragma unroll
  for (int s = 0; s < 5; ++s)
    #pragma unroll
    for (int rg = 0; rg < 16; ++rg) { const float p = __builtin_amdgcn_exp2f(sc[s][rg] - m); sc[s][rg] = p; l += p; }
  { auto rr = __builtin_amdgcn_permlane32_swap(__float_as_uint(l), __float_as_uint(l), false, false); l = __uint_as_float(rr[0]) + __uint_as_float(rr[1]); }
  f32x16 o[2]; o[0] = f32x16{}; o[1] = f32x16{};
  const lds_cptr w3 = (lds_cptr)wlds;
  const lds_cptr vrd = w3 + ((lane >> 4) & 1) * 32 + (lane & 3) * 8 + (4 * hi + ((lane & 15) >> 2)) * 64;
  #pragma unroll
  for (int s = 0; s < 5; ++s) {
    const int kb = qi - 2 + s;
    if (kb >= 0 && kb < nblk) {
      u32x4 vv[4];
      #pragma unroll
      for (int i = 0; i < 4; ++i) { const int c = i * 64 + lane, row = c >> 3, ch = c & 7; const long tv = row0 + (long)(32 * kb + row) * dil + r;
        vv[i] = *reinterpret_cast<const u32x4*>(P1 + tv * pitch + colv + ch * 8); }
      asm volatile("s_waitcnt lgkmcnt(0)" ::: "memory");
      #pragma unroll
      for (int i = 0; i < 4; ++i) { const int c = i * 64 + lane, row = c >> 3, ch = c & 7; *(LAS u32x4*)((LAS char*)wlds + (ch >> 2) * 2048 + row * 64 + (ch & 3) * 16) = vv[i]; }
      asm volatile("s_waitcnt lgkmcnt(0)" ::: "memory");
      #pragma unroll
      for (int ks = 0; ks < 2; ++ks) {
        u32x4 pw; pw[0] = cvtpk_s(sc[s][8 * ks + 0], sc[s][8 * ks + 1]); pw[1] = cvtpk_s(sc[s][8 * ks + 2], sc[s][8 * ks + 3]); pw[2] = cvtpk_s(sc[s][8 * ks + 4], sc[s][8 * ks + 5]); pw[3] = cvtpk_s(sc[s][8 * ks + 6], sc[s][8 * ks + 7]);
        const bf16x8 pa = __builtin_bit_cast(bf16x8, pw);
        #pragma unroll
        for (int d0 = 0; d0 < 2; ++d0) {
          const s16x4 lo = vtr(vrd + d0 * 2048 + ks * 1024), hh = vtr(vrd + d0 * 2048 + ks * 1024 + 512);
          const bf16x8 vf = (bf16x8){lo[0], lo[1], lo[2], lo[3], hh[0], hh[1], hh[2], hh[3]};
          o[d0] = __builtin_amdgcn_mfma_f32_32x32x16_bf16(pa, vf, o[d0], 0, 0, 0); }
      }
    }
  }
  asm volatile("s_waitcnt lgkmcnt(0)" ::: "memory");
  float* wsf = (float*)(wlds + 4096);
  if (hi == 0) { wsf[r32] = l; const long tq = row0 + (long)(32 * qi + r32) * dil + r; lse[((long)g * NTOK + tq) * 8 + h] = m + __builtin_amdgcn_logf(l); }
  asm volatile("s_waitcnt lgkmcnt(0)" ::: "memory");
  float rli[16];
  #pragma unroll
  for (int rg = 0; rg < 16; ++rg) rli[rg] = __builtin_amdgcn_rcpf(wsf[crow(rg, hi)]);
  bf16* stg = (bf16*)wlds;
  #pragma unroll
  for (int rg = 0; rg < 16; ++rg) { const int orow = crow(rg, hi);
    #pragma unroll
    for (int d0 = 0; d0 < 2; ++d0) stg[orow * 64 + d0 * 32 + r32] = (bf16)f2bf(o[d0][rg] * rli[rg]); }
  asm volatile("s_waitcnt lgkmcnt(0)" ::: "memory");
  #pragma unroll
  for (int i = 0; i < 4; ++i) { const int row = i * 8 + (lane >> 3), ch = lane & 7; const u32x4 v = *(const u32x4*)(stg + row * 64 + ch * 8);
    const long tq = row0 + (long)(32 * qi + row) * dil + r; *(u32x4*)(const_cast<bf16*>(P1) + tq * pitch + colq + ch * 8) = v; }
  asm volatile("s_waitcnt lgkmcnt(0)" ::: "memory");
}
#undef SBAR
}

struct Args { const float* in[18]; float* out; unsigned char* ws; int ph_lo, ph_hi; };
struct Frame {
    LAS unsigned char* lds; volatile LAS unsigned* MISC; gu32* ctl;
    int tid, lane, wave, vcu, G, bx;
    unsigned char* ws;
};

__device__ __forceinline__ void transpose_item(const float* W, int K, int N, bf16_t* WT, int k0, int n0, int drow0, LAS float* scr, int lane) {
#pragma unroll 8
    for (int i = 0; i < 32; ++i) { const int kk = 2 * i + (lane >> 5); scr[kk * 33 + (lane & 31)] = W[(size_t)(k0 + kk) * N + n0 + (lane & 31)]; }
    LDS_WAIT(); asm volatile("" ::: "memory");
    const int c = lane & 7;
#pragma unroll
    for (int j = 0; j < 4; ++j) { const int n = (lane >> 3) + 8 * j; const LAS float* s = scr + (8 * c) * 33 + n;
        u32x4 o; o.x = pk2(s[0 * 33], s[1 * 33]); o.y = pk2(s[2 * 33], s[3 * 33]); o.z = pk2(s[4 * 33], s[5 * 33]); o.w = pk2(s[6 * 33], s[7 * 33]);
        *(GAS u32x4*)(WT + (size_t)(drow0 + n) * K + k0 + 8 * c) = o; }
    LDS_WAIT(); asm volatile("" ::: "memory");
}
__device__ __forceinline__ void transpose_plain(const float* W, int K, int N, bf16_t* WT, int item, LAS float* scr, int lane) {
    const int nblk = N / 32, kb = item / nblk, nb = item % nblk; transpose_item(W, K, N, WT, 64 * kb, 32 * nb, 32 * nb, scr, lane);
}
__device__ __forceinline__ void moe_weight_items(Frame& F, const float* wg, const float* wu, const float* wd, int layer, LAS float* scr) {
    bf16_t* WGU = (bf16_t*)(F.ws + WS_WGU); bf16_t* WD = (bf16_t*)(F.ws + WS_WD);
    const int gw = F.vcu * NWAVES + F.wave, NGW = F.G * NWAVES;
    for (int it = gw; it < 48 * 256; it += NGW) {
        const int job = it >> 8, loc = it & 255, e = job / 3, kind = job % 3;
        if (kind < 2) { const float* W = (kind == 0 ? wg : wu) + ((size_t)layer * NEXP + e) * DM * DEXP;
            const int kb = loc >> 4, nb = loc & 15, n0 = 32 * nb; const int drow0 = 256 * (n0 >> 7) + (n0 & 127) + (kind ? 128 : 0);
            transpose_item(W, DM, DEXP, WGU + (size_t)e * 1024 * DM, 64 * kb, n0, drow0, scr, F.lane);
        } else { const float* W = wd + ((size_t)layer * NEXP + e) * DEXP * DM;
            const int kb = loc >> 5, nb = loc & 31; transpose_item(W, DEXP, DM, WD + (size_t)e * DM * DEXP, 64 * kb, 32 * nb, 32 * nb, scr, F.lane); }
    }
}
__device__ __forceinline__ void cvt_rows_bf16(Frame& F, const float* src, bf16_t* dst, size_t n) {
    const size_t gt = (size_t)(F.vcu * NWAVES + F.wave) * 64 + F.lane, NT_ = (size_t)F.G * NWAVES * 64;
    for (size_t i = gt; i < n / 8; i += NT_) { const f32x4 a = *(const GAS f32x4*)(src + i * 8), b = *(const GAS f32x4*)(src + i * 8 + 4);
        u32x4 o; o.x = pk2(a.x, a.y); o.y = pk2(a.z, a.w); o.z = pk2(b.x, b.y); o.w = pk2(b.z, b.w); *(GAS u32x4*)(dst + i * 8) = o; }
}

__device__ __forceinline__ int sel4i(int k, int a0, int a1, int a2, int a3) { return k == 0 ? a0 : (k == 1 ? a1 : (k == 2 ? a2 : a3)); }
__device__ __forceinline__ float sel4f(int k, float a0, float a1, float a2, float a3) { return k == 0 ? a0 : (k == 1 ? a1 : (k == 2 ? a2 : a3)); }

__device__ __forceinline__ void ln1_router_phase(Frame& F, float* zx, const float* lng, const float* lnb, const float* rw, const float* rb, int layer) {
    LAS f32x4* rwl = (LAS f32x4*)(F.lds + RING_OFF);
    LAS int* lcnt = (LAS int*)(F.lds + RING_OFF + 65536);
    LAS int* lbase = lcnt + 16;
    LAS int* rec = lcnt + 64;
    LAS float* recw = (LAS float*)(rec + 256);
    for (int idx = F.tid; idx < 4096; idx += 512) { const int l = idx & 63, qd = (idx >> 6) & 3, c = (idx >> 8) & 3, j = idx >> 10; const int k = 4 * l + c + 256 * j;
        rwl[idx] = *(const GAS f32x4*)(rw + k * 16 + 4 * qd); }
    if (F.tid < 16) lcnt[F.tid] = 0;
    __syncthreads();
    bf16_t* XB = (bf16_t*)(F.ws + WS_XB);
    const int lane = F.lane;
    f32x4 gv[4], bv[4];
#pragma unroll
    for (int j = 0; j < 4; ++j) { gv[j] = *(const GAS f32x4*)(lng + 4 * lane + 256 * j); bv[j] = *(const GAS f32x4*)(lnb + 4 * lane + 256 * j); }
    float rbv[16];
#pragma unroll
    for (int e = 0; e < 16; ++e) rbv[e] = rb[e];
    for (int i = 0; i < 8; ++i) {
        const int lrow = F.wave * 8 + i; const int row = F.vcu * 64 + lrow;
        float* zr = zx + (size_t)row * DM;
        f32x4 v[4]; float s = 0.f;
#pragma unroll
        for (int j = 0; j < 4; ++j) { v[j] = *(const GAS f32x4*)(zr + 4 * lane + 256 * j); s += (v[j].x + v[j].y) + (v[j].z + v[j].w); }
        const float mean = wave_sum(s) * (1.f / DM); float s2 = 0.f;
#pragma unroll
        for (int j = 0; j < 4; ++j) { v[j] = v[j] - mean; s2 += (v[j].x * v[j].x + v[j].y * v[j].y) + (v[j].z * v[j].z + v[j].w * v[j].w); }
        const float rstd = __builtin_amdgcn_rsqf(wave_sum(s2) * (1.f / DM) + NORM_EPS);
#pragma unroll
        for (int j = 0; j < 4; ++j) { v[j] = v[j] * rstd * gv[j] + bv[j];
            *(GAS f32x4*)(zr + 4 * lane + 256 * j) = v[j];
            u32x2 o; o.x = pk2(v[j].x, v[j].y); o.y = pk2(v[j].z, v[j].w); *(GAS u32x2*)(XB + (size_t)row * DM + 4 * lane + 256 * j) = o; }
        float p[16];
#pragma unroll
        for (int e = 0; e < 16; ++e) p[e] = 0.f;
#pragma unroll
        for (int j = 0; j < 4; ++j)
#pragma unroll
            for (int c = 0; c < 4; ++c) { const float xv = v[j][c];
#pragma unroll
                for (int qd = 0; qd < 4; ++qd) { const f32x4 w = rwl[((j * 4 + c) * 4 + qd) * 64 + lane];
                    p[4 * qd + 0] += xv * w.x; p[4 * qd + 1] += xv * w.y; p[4 * qd + 2] += xv * w.z; p[4 * qd + 3] += xv * w.w; } }
        const int b5 = (lane >> 5) & 1, b4 = (lane >> 4) & 1, b3 = (lane >> 3) & 1, b2 = (lane >> 2) & 1;
        float q8[8], q4[4], q2[2], q1;
#pragma unroll
        for (int k = 0; k < 8; ++k) { const float keep = b5 ? p[8 + k] : p[k], send = b5 ? p[k] : p[8 + k]; q8[k] = keep + __shfl_xor(send, 32); }
#pragma unroll
        for (int k = 0; k < 4; ++k) { const float keep = b4 ? q8[4 + k] : q8[k], send = b4 ? q8[k] : q8[4 + k]; q4[k] = keep + __shfl_xor(send, 16); }
#pragma unroll
        for (int k = 0; k < 2; ++k) { const float keep = b3 ? q4[2 + k] : q4[k], send = b3 ? q4[k] : q4[2 + k]; q2[k] = keep + __shfl_xor(send, 8); }
        { const float keep = b2 ? q2[1] : q2[0], send = b2 ? q2[0] : q2[1]; q1 = keep + __shfl_xor(send, 4); }
        q1 += __shfl_xor(q1, 1); q1 += __shfl_xor(q1, 2);
        float aff[16], sel[16];
#pragma unroll
        for (int e = 0; e < 16; ++e) { const int src = ((e >> 3) & 1) * 32 + ((e >> 2) & 1) * 16 + ((e >> 1) & 1) * 8 + (e & 1) * 4;
            const float lg = __builtin_bit_cast(float, __builtin_amdgcn_readlane(__builtin_bit_cast(int, q1), src));
            aff[e] = 1.f / (1.f + __expf(-lg)); sel[e] = aff[e] + rbv[e]; }
        float gs[4];
#pragma unroll
        for (int g = 0; g < 4; ++g) { const float a = sel[4 * g], b = sel[4 * g + 1], c = sel[4 * g + 2], d = sel[4 * g + 3];
            const float mx1 = fmaxf(fmaxf(a, b), fmaxf(c, d));
            const float mn_ab = fminf(a, b), mx_ab = fmaxf(a, b), mn_cd = fminf(c, d), mx_cd = fmaxf(c, d);
            const float second = fmaxf(fminf(mx_ab, mx_cd), fmaxf(mn_ab, mn_cd));
            gs[g] = mx1 + second; }
        int best = 0; float bsc = gs[0];
#pragma unroll
        for (int g = 1; g < 4; ++g) if (gs[g] > bsc) { bsc = gs[g]; best = g; }
        const float s0 = sel4f(best, sel[0], sel[4], sel[8], sel[12]), s1 = sel4f(best, sel[1], sel[5], sel[9], sel[13]), s2_ = sel4f(best, sel[2], sel[6], sel[10], sel[14]), s3 = sel4f(best, sel[3], sel[7], sel[11], sel[15]);
        const float a0 = sel4f(best, aff[0], aff[4], aff[8], aff[12]), a1 = sel4f(best, aff[1], aff[5], aff[9], aff[13]), a2 = sel4f(best, aff[2], aff[6], aff[10], aff[14]), a3 = sel4f(best, aff[3], aff[7], aff[11], aff[15]);
        int i0 = 0; float m0 = s0; if (s1 > m0) { m0 = s1; i0 = 1; } if (s2_ > m0) { m0 = s2_; i0 = 2; } if (s3 > m0) { m0 = s3; i0 = 3; }
        int i1 = -1; float m1 = -INFINITY;
        if (i0 != 0 && s0 > m1) { m1 = s0; i1 = 0; } if (i0 != 1 && s1 > m1) { m1 = s1; i1 = 1; } if (i0 != 2 && s2_ > m1) { m1 = s2_; i1 = 2; } if (i0 != 3 && s3 > m1) { m1 = s3; i1 = 3; }
        const float w0r = sel4f(i0, a0, a1, a2, a3), w1r = sel4f(i1, a0, a1, a2, a3); const float inv = 1.f / (w0r + w1r);
        if (lane == 0) { const int e0 = 4 * best + i0, e1 = 4 * best + i1;
            const int r0 = __hip_atomic_fetch_add(lcnt + e0, 1, __ATOMIC_RELAXED, __HIP_MEMORY_SCOPE_WORKGROUP), r1 = __hip_atomic_fetch_add(lcnt + e1, 1, __ATOMIC_RELAXED, __HIP_MEMORY_SCOPE_WORKGROUP);
            rec[lrow * 4 + 0] = e0; rec[lrow * 4 + 1] = e1; rec[lrow * 4 + 2] = r0; rec[lrow * 4 + 3] = r1; recw[lrow * 2 + 0] = w0r * inv; recw[lrow * 2 + 1] = w1r * inv; }
    }
    __syncthreads();
    if (F.tid < 16) { const int n = lcnt[F.tid]; lbase[F.tid] = n ? (int)__hip_atomic_fetch_add((unsigned*)(F.ctl + CW_CNT + (layer * 16 + F.tid) * 64), (unsigned)n, RLX_AGENT) : 0; }
    __syncthreads();
    if (F.tid < 128) { const int lrow = F.tid >> 1, sl = F.tid & 1; const int e = rec[lrow * 4 + sl], rk = rec[lrow * 4 + 2 + sl]; const int pos = lbase[e] + rk; const int row = F.vcu * 64 + lrow;
        int* rowmap = (int*)(F.ws + WS_ROWMAP); float* roww = (float*)(F.ws + WS_ROWW);
        rowmap[(size_t)e * RCAP + pos] = row * 2 + sl; roww[(size_t)e * RCAP + pos] = recw[lrow * 2 + sl]; }
    __syncthreads();
}

__device__ __forceinline__ void ln2_phase(Frame& F, float* xio, const float* lng, const float* lnb, bool write_bf) {
    const bf16_t* Y = (const bf16_t*)(F.ws + WS_Y); bf16_t* XB = (bf16_t*)(F.ws + WS_XB);
    const int lane = F.lane;
    f32x4 gv[4], bv[4];
#pragma unroll
    for (int j = 0; j < 4; ++j) { gv[j] = *(const GAS f32x4*)(lng + 4 * lane + 256 * j); bv[j] = *(const GAS f32x4*)(lnb + 4 * lane + 256 * j); }
    for (int i = 0; i < 8; ++i) {
        const int row = F.vcu * 64 + F.wave * 8 + i;
        float* xr = xio + (size_t)row * DM;
        f32x4 v[4]; float s = 0.f;
#pragma unroll
        for (int j = 0; j < 4; ++j) { const f32x4 x = *(const GAS f32x4*)(xr + 4 * lane + 256 * j);
            const u32x2 y0 = *(const GAS u32x2*)(Y + (size_t)row * DM + 4 * lane + 256 * j), y1 = *(const GAS u32x2*)(Y + ((size_t)NTOK + row) * DM + 4 * lane + 256 * j);
            v[j].x = x.x * ALPHA + (bflo(y0.x) + bflo(y1.x)); v[j].y = x.y * ALPHA + (bfhi(y0.x) + bfhi(y1.x)); v[j].z = x.z * ALPHA + (bflo(y0.y) + bflo(y1.y)); v[j].w = x.w * ALPHA + (bfhi(y0.y) + bfhi(y1.y));
            s += (v[j].x + v[j].y) + (v[j].z + v[j].w); }
        const float mean = wave_sum(s) * (1.f / DM); float s2 = 0.f;
#pragma unroll
        for (int j = 0; j < 4; ++j) { v[j] = v[j] - mean; s2 += (v[j].x * v[j].x + v[j].y * v[j].y) + (v[j].z * v[j].z + v[j].w * v[j].w); }
        const float rstd = __builtin_amdgcn_rsqf(wave_sum(s2) * (1.f / DM) + NORM_EPS);
#pragma unroll
        for (int j = 0; j < 4; ++j) { v[j] = v[j] * rstd * gv[j] + bv[j];
            *(GAS f32x4*)(xr + 4 * lane + 256 * j) = v[j];
            if (write_bf) { u32x2 o; o.x = pk2(v[j].x, v[j].y); o.y = pk2(v[j].z, v[j].w); *(GAS u32x2*)(XB + (size_t)row * DM + 4 * lane + 256 * j) = o; } }
    }
}

__device__ __forceinline__ void rope0_phase(Frame& F, const float* qn, const float* kn) {
    bf16_t* P0 = (bf16_t*)(F.ws + WS_BIG); const float* tab = (const float*)(F.ws + WS_TAB);
    const int lane = F.lane, head = lane >> 2, qd = lane & 3;
    const float* gn = (head < 12 ? qn : kn) + (qd * 16);
    float gnv[16];
#pragma unroll
    for (int d = 0; d < 16; ++d) gnv[d] = gn[d];
    const float osc = head < 12 ? C2 : 1.f;
    for (int i = 0; i < 8; ++i) {
        const int row = F.vcu * 64 + F.wave * 8 + i; const int t = row & (SEQ - 1);
        bf16_t* p = P0 + (size_t)row * A_IN + head * 64 + qd * 16;
        const u32x4 w0 = *(const GAS u32x4*)p, w1 = *(const GAS u32x4*)(p + 8);
        float x[16];
        x[0] = bflo(w0.x); x[1] = bfhi(w0.x); x[2] = bflo(w0.y); x[3] = bfhi(w0.y); x[4] = bflo(w0.z); x[5] = bfhi(w0.z); x[6] = bflo(w0.w); x[7] = bfhi(w0.w);
        x[8] = bflo(w1.x); x[9] = bfhi(w1.x); x[10] = bflo(w1.y); x[11] = bfhi(w1.y); x[12] = bflo(w1.z); x[13] = bfhi(w1.z); x[14] = bflo(w1.w); x[15] = bfhi(w1.w);
        float ss = 0.f;
#pragma unroll
        for (int d = 0; d < 16; ++d) ss += x[d] * x[d];
        ss += __shfl_xor(ss, 1); ss += __shfl_xor(ss, 2);
        const float rs = __builtin_amdgcn_rsqf(ss * (1.f / 64.f) + NORM_EPS);
        const float* ct = (qd < 2) ? tab + TB_ROWC + (t >> 6) * 16 : tab + TB_COLC + (t & 63) * 16;
        const float* st = (qd < 2) ? tab + TB_ROWS + (t >> 6) * 16 : tab + TB_COLS + (t & 63) * 16;
        float y[16];
#pragma unroll
        for (int d = 0; d < 16; ++d) { const float xn = x[d] * rs * gnv[d]; const float xp = __shfl_xor(xn, 1);
            const float c = ct[d], sn = st[d];
            y[d] = ((qd & 1) ? (xn * c + xp * sn) : (xn * c - xp * sn)) * osc; }
        u32x4 o0, o1;
        o0.x = pk2(y[0], y[1]); o0.y = pk2(y[2], y[3]); o0.z = pk2(y[4], y[5]); o0.w = pk2(y[6], y[7]); o1.x = pk2(y[8], y[9]); o1.y = pk2(y[10], y[11]); o1.z = pk2(y[12], y[13]); o1.w = pk2(y[14], y[15]);
        *(GAS u32x4*)p = o0; *(GAS u32x4*)(p + 8) = o1;
    }
}
__device__ __forceinline__ void rope1_phase(Frame& F) {
    bf16_t* P1 = (bf16_t*)(F.ws + WS_BIG); const float* tab = (const float*)(F.ws + WS_TAB);
    const int lane = F.lane;
    for (int i = 0; i < 8; ++i) {
        const int row = F.vcu * 64 + F.wave * 8 + i; const int t = row & (SEQ - 1);
        if (lane < 48) {
            bf16_t* p = P1 + (size_t)row * B_IN + lane * 64;
            const u32x4 w0 = *(const GAS u32x4*)p, w1 = *(const GAS u32x4*)(p + 8);
            float x1[8], x2[8];
            x1[0] = bflo(w0.x); x1[1] = bfhi(w0.x); x1[2] = bflo(w0.y); x1[3] = bfhi(w0.y); x1[4] = bflo(w0.z); x1[5] = bfhi(w0.z); x1[6] = bflo(w0.w); x1[7] = bfhi(w0.w);
            x2[0] = bflo(w1.x); x2[1] = bfhi(w1.x); x2[2] = bflo(w1.y); x2[3] = bfhi(w1.y); x2[4] = bflo(w1.z); x2[5] = bfhi(w1.z); x2[6] = bflo(w1.w); x2[7] = bfhi(w1.w);
            const float* ct = tab + TB_PC + t * 8; const float* st = tab + TB_PS + t * 8;
            float y1[8], y2[8];
#pragma unroll
            for (int d = 0; d < 8; ++d) { const float c = ct[d], sn = st[d]; y1[d] = x1[d] * c - x2[d] * sn; y2[d] = x2[d] * c + x1[d] * sn; }
            u32x4 o0, o1;
            o0.x = pk2(y1[0], y1[1]); o0.y = pk2(y1[2], y1[3]); o0.z = pk2(y1[4], y1[5]); o0.w = pk2(y1[6], y1[7]); o1.x = pk2(y2[0], y2[1]); o1.y = pk2(y2[2], y2[3]); o1.z = pk2(y2[4], y2[5]); o1.w = pk2(y2[6], y2[7]);
            *(GAS u32x4*)p = o0; *(GAS u32x4*)(p + 8) = o1;
        }
    }
}
__device__ __forceinline__ void merge_phase(Frame& F) {
    const bf16_t* P1 = (const bf16_t*)(F.ws + WS_BIG); const float* lse = (const float*)(F.ws + WS_LSE); bf16_t* ATT = (bf16_t*)(F.ws + WS_ATT);
    const int lane = F.lane, h = lane >> 3, dd = (lane & 7) * 8;
    for (int i = 0; i < 8; ++i) {
        const int row = F.vcu * 64 + F.wave * 8 + i;
        float l0 = lse[((size_t)0 * NTOK + row) * 8 + h], l1 = lse[((size_t)1 * NTOK + row) * 8 + h], l2 = lse[((size_t)2 * NTOK + row) * 8 + h];
        const float mx = fmaxf(l0, fmaxf(l1, l2)); float w0 = __builtin_amdgcn_exp2f(l0 - mx), w1 = __builtin_amdgcn_exp2f(l1 - mx), w2 = __builtin_amdgcn_exp2f(l2 - mx);
        const float inv = 1.f / (w0 + w1 + w2); w0 *= inv; w1 *= inv; w2 *= inv;
        const bf16_t* p = P1 + (size_t)row * B_IN + h * 64 + dd;
        const u32x4 a = *(const GAS u32x4*)p, b = *(const GAS u32x4*)(p + 512), c = *(const GAS u32x4*)(p + 1024);
        u32x4 o;
        o.x = pk2(w0 * bflo(a.x) + w1 * bflo(b.x) + w2 * bflo(c.x), w0 * bfhi(a.x) + w1 * bfhi(b.x) + w2 * bfhi(c.x));
        o.y = pk2(w0 * bflo(a.y) + w1 * bflo(b.y) + w2 * bflo(c.y), w0 * bfhi(a.y) + w1 * bfhi(b.y) + w2 * bfhi(c.y));
        o.z = pk2(w0 * bflo(a.z) + w1 * bflo(b.z) + w2 * bflo(c.z), w0 * bfhi(a.z) + w1 * bfhi(b.z) + w2 * bfhi(c.z));
        o.w = pk2(w0 * bflo(a.w) + w1 * bflo(b.w) + w2 * bflo(c.w), w0 * bfhi(a.w) + w1 * bfhi(b.w) + w2 * bfhi(c.w));
        *(GAS u32x4*)(ATT + (size_t)row * 768 + h * 64 + dd) = o;
    }
}

constexpr int N_PHASES = 19;
__global__ void __launch_bounds__(NWAVES * 64, 2) mega_fwd(Args args) {
    extern __shared__ __attribute__((aligned(16))) unsigned char lds[];
    Frame F;
    F.lds = (LAS unsigned char*)lds; F.MISC = (volatile LAS unsigned*)(F.lds + MISC_OFF);
    F.tid = threadIdx.x; F.lane = F.tid & 63; F.wave = __builtin_amdgcn_readfirstlane(F.tid >> 6);
    F.G = gridDim.x; { const int bx = blockIdx.x; F.vcu = (F.G % 8 == 0) ? (bx % 8) * (F.G / 8) + bx / 8 : bx; }
    F.ws = args.ws; F.ctl = (gu32*)(args.ws + WS_CTL);
    for (int u = F.tid; u < (LDS_BYTES - LDSCTL_OFF) / 4; u += NWAVES * 64) ((LAS unsigned*)(F.lds + LDSCTL_OFF))[u] = 0u;
    __syncthreads();
    { const int lo0 = args.ph_lo, hi0 = args.ph_hi; if (hi0 - lo0 > 1) (void)xcd_barrier_post((unsigned*)(F.ctl + CW_BAR), F.MISC + 8); }
#define KA_INT(off) (*(const int CAS*)((const CAS unsigned char*)__builtin_amdgcn_kernarg_segment_ptr() + (off)))
#define IN(k) (KA_INT(160) <= (k) && (k) < KA_INT(164))
#define SEAM(k) do { if (IN(k) && IN((k) + 1)) { XcdBarrier bar_; bar_.bar = (unsigned*)(*(unsigned char* const CAS*)((const CAS unsigned char*)__builtin_amdgcn_kernarg_segment_ptr() + 152) + WS_CTL) + CW_BAR; \
        bar_.x = xb_xcc_id(); bar_.st = (volatile LAS unsigned*)((LAS unsigned char*)lds + MISC_OFF) + 8; xcd_barrier(bar_); } } while (0)
#define AIN(i) (*(const float* const CAS*)(ka_ + 8 * (i)))
#define PHASE_FRAME() \
    const CAS unsigned char* ka_ = (const CAS unsigned char*)__builtin_amdgcn_kernarg_segment_ptr(); asm volatile("" : "+s"(ka_)); \
    Frame P; unsigned P_l0 = 0u; { unsigned char* w_ = *(unsigned char* const CAS*)(ka_ + 152); asm volatile("" : "+s"(P_l0)); int t_ = threadIdx.x; asm volatile("" : "+v"(t_)); \
      P.ws = w_; P.ctl = (gu32*)(w_ + WS_CTL); P.lds = (LAS unsigned char*)lds + P_l0; P.MISC = (volatile LAS unsigned*)(P.lds + MISC_OFF); \
      P.tid = t_; P.lane = t_ & 63; P.wave = __builtin_amdgcn_readfirstlane(t_ >> 6); P.G = gridDim.x; { int bx = blockIdx.x; asm volatile("" : "+s"(bx)); P.bx = bx; P.vcu = (P.G % 8 == 0) ? (bx % 8) * (P.G / 8) + bx / 8 : bx; } } \
    const float* x_in = AIN(0); float* out = *(float* const CAS*)(ka_ + 144); \
    bf16_t* XB = (bf16_t*)(P.ws + WS_XB); bf16_t* ATT = (bf16_t*)(P.ws + WS_ATT); bf16_t* BIG = (bf16_t*)(P.ws + WS_BIG); \
    bf16_t* MKV = (bf16_t*)(P.ws + WS_MKV); bf16_t* MEMB = (bf16_t*)(P.ws + WS_MEMB); \
    int* rowmap = (int*)(P.ws + WS_ROWMAP); float* roww = (float*)(P.ws + WS_ROWW); \
    LAS int* tpre = (LAS int*)(P.lds + SCHED_OFF); \
    (void)x_in; (void)out; (void)XB; (void)ATT; (void)BIG; (void)MKV; (void)MEMB; (void)rowmap; (void)roww; (void)tpre

    if (IN(0)) { PHASE_FRAME();
        LAS float* scr = (LAS float*)(P.lds + RING_OFF + P.wave * 16384);
        const int gw = P.vcu * NWAVES + P.wave, NGW = P.G * NWAVES;
        constexpr int I_MKV = 16 * 16, I_AIN = 16 * 48, I_AOUT = 16 * 32, I_BIN = 16 * 152, I_BOUT = 12 * 32, NIT = I_MKV + I_AIN + I_AOUT + I_BIN + I_BOUT;
        for (int it = gw; it < NIT; it += NGW) {
            int r = it;
            if (r < I_MKV) { transpose_plain(AIN(2), DM, 512, (bf16_t*)(P.ws + WS_WMKV), r, scr, P.lane); continue; } r -= I_MKV;
            if (r < I_AIN) { transpose_plain(AIN(5), DM, A_IN, (bf16_t*)(P.ws + WS_WAIN), r, scr, P.lane); continue; } r -= I_AIN;
            if (r < I_AOUT) { transpose_plain(AIN(6), DM, DM, (bf16_t*)(P.ws + WS_WAOUT), r, scr, P.lane); continue; } r -= I_AOUT;
            if (r < I_BIN) { transpose_plain(AIN(9), DM, B_IN, (bf16_t*)(P.ws + WS_WBIN), r, scr, P.lane); continue; } r -= I_BIN;
            transpose_plain(AIN(10), 768, DM, (bf16_t*)(P.ws + WS_WBOUT), r, scr, P.lane);
        }
        moe_weight_items(P, AIN(15), AIN(16), AIN(17), 0, scr);
        cvt_rows_bf16(P, x_in, XB, (size_t)NTOK * DM);
        cvt_rows_bf16(P, AIN(1), MEMB, (size_t)NB * NMEM * DM);
        { float* tab = (float*)(P.ws + WS_TAB); const int gt = gw * 64 + P.lane, NT_ = NGW * 64;
          for (int idx = gt; idx < 32 * 16 + 64 * 16 + 2048 * 8; idx += NT_) {
              int p, i, oc, os; float l2t, den;
              if (idx < 512) { p = idx >> 4; i = idx & 15; oc = TB_ROWC + idx; os = TB_ROWS + idx; l2t = 13.287712379549449f; den = 32.f; }
              else if (idx < 512 + 1024) { const int k = idx - 512; p = k >> 4; i = k & 15; oc = TB_COLC + k; os = TB_COLS + k; l2t = 13.287712379549449f; den = 32.f; }
              else { const int k = idx - 1536; p = k >> 3; i = k & 7; oc = TB_PC + k; os = TB_PS + k; l2t = 18.931568569324174f; den = 16.f; }
              const float inv = 1.0f / __builtin_amdgcn_exp2f(l2t * ((float)(2 * i) / den));
              const float ang = (float)p * inv;
              const double rev = (double)ang * 0.15915494309189535;
              const float fr = (float)(rev - __builtin_rint(rev));
              tab[oc] = __builtin_amdgcn_cosf(fr); tab[os] = __builtin_amdgcn_sinf(fr);
          } }
    }
    SEAM(0);

    for (int L = 0; L < 2; ++L) {
        const int pb = 1 + 9 * L;
        if (IN(pb)) { PHASE_FRAME();
            pg8::DenseSched S;
            if (L == 0) S.init(XB, P.ws + WS_WAIN, NTOK, A_IN, DM, MEMB, P.ws + WS_WMKV, NB * NMEM, 512, P.G, P.bx);
            else        S.init(XB, P.ws + WS_WBIN, NTOK, B_IN, DM, nullptr, nullptr, 0, 0, P.G, P.bx);
            pg8::EpiProj E{BIG, L == 0 ? A_IN : B_IN, L == 0 ? (1u << 5) : (0x3Fu | (1u << 18)), C2, MKV, 512};
            pg8::gemm_phase<pg8::EpiProj, pg8::DenseSched, false, DM>(P.lds + RING_OFF, S, E, P.tid);
        }
        SEAM(pb);
        if (IN(pb + 1)) { PHASE_FRAME(); if (L == 0) rope0_phase(P, AIN(7), AIN(8)); else rope1_phase(P); }
        SEAM(pb + 1);
        if (IN(pb + 2)) { PHASE_FRAME();
            char* shm = (char*)lds + P_l0 + RING_OFF;
            if (L == 0) {
                const int v = P.vcu; const int pair = v >> 3, qb = v & 7, b = pair >> 2, kvh = pair & 3;
                const bf16_t* base = BIG + (size_t)b * SEQ * A_IN;
#pragma unroll 1
                for (int i = 0; i < 3; ++i) { const int hq = kvh * 3 + i;
                    attn_body::attn_unit<8, A_IN, A_IN, A_IN, DM, SEQ / 64>(base + hq * 64, base + 768 + kvh * 64, base + 1024 + kvh * 64, ATT + (size_t)b * SEQ * DM + hq * 64, qb * 256, shm, P.tid); }
                { const int mb = v >> 5, mh = (v >> 3) & 3; const bf16_t* qb_ = BIG + (size_t)mb * SEQ * A_IN + 1280 + mh * 64; const bf16_t* mk = MKV + (size_t)mb * NMEM * 512 + mh * 64;
                  attn_body::attn_unit<8, A_IN, 512, 512, DM, NMEM / 64>(qb_, mk, mk + 256, ATT + (size_t)mb * SEQ * DM + 768 + mh * 64, qb * 256, shm, P.tid); }
            } else {
                { const int v = P.vcu; const int qb = v & 7, mb = v >> 5, mh = (v >> 3) & 3; const bf16_t* qb_ = BIG + (size_t)mb * SEQ * B_IN + 4608 + mh * 64; const bf16_t* mk = MKV + (size_t)mb * NMEM * 512 + mh * 64;
                  attn_body::attn_unit<8, B_IN, 512, 512, 768, NMEM / 64>(qb_, mk, mk + 256, ATT + (size_t)mb * SEQ * 768 + 512 + mh * 64, qb * 256, shm, P.tid); }
                __syncthreads();
                float* lse = (float*)(P.ws + WS_LSE);
                char* wl = shm + P.wave * 8192;
                const int gw = P.vcu * NWAVES + P.wave, NGW = P.G * NWAVES;
                for (int it = gw; it < NB * 3 * 8 * 64; it += NGW) {
                    const int k = it & 63, bgh = it >> 6, h = bgh & 7, bg = bgh >> 3, g = bg % 3, b = bg / 3;
                    const int dil = (g == 0) ? 1 : (g == 1 ? 4 : 16), Lr = SEQ / dil, nb = Lr / 32; const int r = k / nb, qi = k % nb;
                    attn_body::band_item(BIG, lse, b, g, h, r, qi, dil, Lr, wl, P.lane);
                }
            }
        }
        SEAM(pb + 2);
        if (L == 1) { if (IN(pb + 3)) { PHASE_FRAME(); merge_phase(P); } SEAM(pb + 3); }
        if (IN(pb + 4)) { PHASE_FRAME();
            pg8::DenseSched S;
            if (L == 0) S.init(ATT, P.ws + WS_WAOUT, NTOK, DM, DM, nullptr, nullptr, 0, 0, P.G, P.bx);
            else        S.init(ATT, P.ws + WS_WBOUT, NTOK, DM, 768, nullptr, nullptr, 0, 0, P.G, P.bx);
            pg8::EpiZ E{L == 0 ? x_in : out, out};
            if (L == 0) pg8::gemm_phase<pg8::EpiZ, pg8::DenseSched, false, DM>(P.lds + RING_OFF, S, E, P.tid); else pg8::gemm_phase<pg8::EpiZ, pg8::DenseSched, false, 768>(P.lds + RING_OFF, S, E, P.tid);
        }
        SEAM(pb + 4);
        if (IN(pb + 5)) { PHASE_FRAME(); ln1_router_phase(P, out, AIN(11) + L * DM, AIN(12) + L * DM, AIN(3), AIN(4), L); }
        SEAM(pb + 5);
        if (IN(pb + 6) || IN(pb + 7)) { PHASE_FRAME();
            if (P.tid == 0) { int acc = 0;
                for (int e = 0; e < 16; ++e) { const int c = (int)__hip_atomic_load(P.ctl + CW_CNT + (L * 16 + e) * 64, RLX_AGENT); tpre[e] = acc; tpre[32 + e] = c; acc += (c + 255) >> 8; }
                tpre[16] = acc; }
            __syncthreads();
        }
        if (IN(pb + 6)) { PHASE_FRAME();
            pg8::MoeSched S{(const char*)XB, (const char*)(P.ws + WS_WGU), DM, (size_t)1024 * DM * 2, tpre, rowmap, P.G, P.bx, true};
            pg8::EpiGU E{(bf16_t*)(P.ws + WS_H)};
            pg8::gemm_phase<pg8::EpiGU, pg8::MoeSched, true, DM>(P.lds + RING_OFF, S, E, P.tid);
        }
        SEAM(pb + 6);
        if (IN(pb + 7)) { PHASE_FRAME();
            pg8::MoeSched S{(const char*)(P.ws + WS_H), (const char*)(P.ws + WS_WD), DEXP, (size_t)DM * DEXP * 2, tpre, rowmap, P.G, P.bx, false};
            pg8::EpiDown E{(bf16_t*)(P.ws + WS_Y), rowmap, roww};
            pg8::gemm_phase<pg8::EpiDown, pg8::MoeSched, false, DEXP>(P.lds + RING_OFF, S, E, P.tid);
        }
        SEAM(pb + 7);
        if (IN(pb + 8)) { PHASE_FRAME();
            ln2_phase(P, out, AIN(13) + L * DM, AIN(14) + L * DM, L == 0);
            if (L == 0) { LAS float* scr = (LAS float*)(P.lds + RING_OFF + P.wave * 16384); moe_weight_items(P, AIN(15), AIN(16), AIN(17), 1, scr); }
        }
        if (L == 0) SEAM(pb + 8);
    }
#undef IN
#undef SEAM
#undef PHASE_FRAME
#undef AIN
#undef KA_INT
}

extern "C" void kernel_launch(void* const* d_in, const int* in_sizes, int n_in, void* d_out, int out_size, void* d_ws, size_t ws_size, hipStream_t stream) {
    static int grid = 0;
    if (grid == 0) {
        if (n_in != 18 || out_size != NTOK * DM || ws_size < WS_END) { fprintf(stderr, "kernel_launch: unexpected shapes (n_in %d, out %d, ws %zu < %zu)\n", n_in, out_size, ws_size, (size_t)WS_END); grid = -1; return; }
        int dev = 0, cus = 0, per_cu = 0;
        if (hipGetDevice(&dev) != hipSuccess || hipDeviceGetAttribute(&cus, hipDeviceAttributeMultiprocessorCount, dev) != hipSuccess) { grid = -1; return; }
        if (hipFuncSetAttribute((const void*)mega_fwd, hipFuncAttributeMaxDynamicSharedMemorySize, LDS_BYTES) != hipSuccess) { fprintf(stderr, "kernel_launch: hipFuncSetAttribute failed\n"); grid = -1; return; }
        if (hipOccupancyMaxActiveBlocksPerMultiprocessor(&per_cu, (const void*)mega_fwd, NWAVES * 64, LDS_BYTES) != hipSuccess || per_cu < 1) { fprintf(stderr, "kernel_launch: occupancy query says %d\n", per_cu); }
        (void)hipGetLastError();
        grid = cus;
        if (grid != 256) fprintf(stderr, "kernel_launch: %d CUs (built for 256)\n", grid);
    }
    if (grid < 0) return;
    (void)hipMemsetAsync((char*)d_ws + WS_CTL, 0, CTL_ZERO_BYTES, stream);
    Args a{};
    for (int i = 0; i < 18; ++i) a.in[i] = (const float*)d_in[i];
    a.out = (float*)d_out; a.ws = (unsigned char*)d_ws;
#if MK_ONE_LAUNCH
    a.ph_lo = 0; a.ph_hi = N_PHASES;
    hipLaunchKernelGGL(mega_fwd, dim3(grid), dim3(NWAVES * 64), LDS_BYTES, stream, a);
#else
    for (int p = 0; p < N_PHASES; ++p) {
        if (p == 4) continue;
        a.ph_lo = p; a.ph_hi = p + 1;
        hipLaunchKernelGGL(mega_fwd, dim3(grid), dim3(NWAVES * 64), LDS_BYTES, stream, a);
    }
#endif
}
```

```cpp
#include <hip/hip_runtime.h>
#include <cstdio>
#include <cstdint>

#ifndef MK_ONE_LAUNCH
#define MK_ONE_LAUNCH 1
#endif

#define GAS __attribute__((address_space(1)))
#define LAS __attribute__((address_space(3)))
#define CAS __attribute__((address_space(4)))
typedef unsigned short bf16_t;
typedef short bf16x8 __attribute__((ext_vector_type(8)));
typedef short s16x4 __attribute__((ext_vector_type(4)));
typedef float f32x4 __attribute__((ext_vector_type(4)));
typedef float f32x2 __attribute__((ext_vector_type(2)));
typedef float f32x16 __attribute__((ext_vector_type(16)));
typedef unsigned u32x4 __attribute__((ext_vector_type(4)));
typedef unsigned u32x2 __attribute__((ext_vector_type(2)));
typedef GAS unsigned gu32;

constexpr int NTOK = 16384, DM = 1024, SEQ = 2048, NB = 8, NMEM = 256, HD = 64;
constexpr int A_IN = 1536, B_IN = 4864, NEXP = 16, DEXP = 512;
constexpr float ALPHA = 1.4142135623730951f;
constexpr float NORM_EPS = 1e-6f;
constexpr float C2 = 0.125f * 1.4426950408889634f;
constexpr int RCAP = 16384;

constexpr size_t MiB = 1u << 20;
constexpr size_t WS_CTL = 0, CTL_ZERO_BYTES = 1 * MiB;
constexpr size_t WS_TAB = 1 * MiB;
constexpr size_t WS_ROWMAP = 2 * MiB;
constexpr size_t WS_ROWW = 3 * MiB;
constexpr size_t WS_WMKV = 4 * MiB;
constexpr size_t WS_WAIN = 5 * MiB;
constexpr size_t WS_WAOUT = 8 * MiB;
constexpr size_t WS_WBIN = 10 * MiB;
constexpr size_t WS_WBOUT = 20 * MiB;
constexpr size_t WS_WGU = 22 * MiB;
constexpr size_t WS_WD = 54 * MiB;
constexpr size_t WS_MEMB = 70 * MiB;
constexpr size_t WS_MKV = 74 * MiB;
constexpr size_t WS_XB = 76 * MiB;
constexpr size_t WS_ATT = 108 * MiB;
constexpr size_t WS_BIG = 140 * MiB;
constexpr size_t WS_H = WS_BIG, WS_Y = WS_BIG + 36 * MiB;
constexpr size_t WS_LSE = 292 * MiB;
constexpr size_t WS_END = 294 * MiB;
constexpr int TB_ROWC = 0, TB_ROWS = 512, TB_COLC = 1024, TB_COLS = 2048, TB_PC = 4096, TB_PS = 4096 + 16384;
constexpr int CW_TMO = 0;
constexpr int CW_BAR = 4096;
constexpr int CW_CNT = 16384;

constexpr int RING_OFF = 0, RING_BYTES = 131072;
constexpr int LDSCTL_OFF = RING_BYTES, MISC_OFF = LDSCTL_OFF + 320, SCHED_OFF = LDSCTL_OFF + 512;
constexpr int LDS_BYTES = 147456;
constexpr int NWAVES = 8;

#define RLX_AGENT __ATOMIC_RELAXED, __HIP_MEMORY_SCOPE_AGENT
#define LDS_WAIT() asm volatile("s_waitcnt lgkmcnt(0)" ::: "memory")
#define VM_WAIT() asm volatile("s_waitcnt vmcnt(0)" ::: "memory")
__device__ __forceinline__ unsigned f2bf(float f) { unsigned u = __builtin_bit_cast(unsigned, f); return (u + 0x7fffu + ((u >> 16) & 1u)) >> 16; }
__device__ __forceinline__ unsigned pk2(float lo, float hi) { return f2bf(lo) | (f2bf(hi) << 16); }
__device__ __forceinline__ float bf2f(unsigned short b) { return __builtin_bit_cast(float, (unsigned)b << 16); }
__device__ __forceinline__ float bflo(unsigned w) { return __builtin_bit_cast(float, w << 16); }
__device__ __forceinline__ float bfhi(unsigned w) { return __builtin_bit_cast(float, w & 0xffff0000u); }
__device__ __forceinline__ unsigned cvt_pk_bf16(float lo, float hi) { unsigned r; asm volatile("v_cvt_pk_bf16_f32 %0, %1, %2" : "=v"(r) : "v"(lo), "v"(hi)); return r; }
__device__ __forceinline__ float wave_sum(float v) {
#pragma unroll
    for (int o = 1; o < 64; o <<= 1) v += __shfl_xor(v, o);
    return v;
}

#define XB_TMO      128
#define XB_XCNT(j)  (256  + 64 * (j))
#define XB_XSUB(j)  (1280 + 64 * (j))
#define XB_XGEN(j)  (2304 + 64 * (j))
#define XB_TOP      3328
#define XB_TOPGEN   3392
#define XCD_BAR_WORDS 3456
#define XB_SPIN_CAP (1u << 20)
__device__ __forceinline__ unsigned xb_ld(unsigned* p)              { return __hip_atomic_load(p, __ATOMIC_RELAXED, __HIP_MEMORY_SCOPE_AGENT); }
__device__ __forceinline__ unsigned xb_add(unsigned* p, unsigned v) { return __hip_atomic_fetch_add(p, v, __ATOMIC_RELAXED, __HIP_MEMORY_SCOPE_AGENT); }
__device__ __forceinline__ unsigned xb_xcc_id() { return (unsigned)__builtin_amdgcn_s_getreg((3 << 11) | 20) & 0xFu; }
#define XB_SPIN(cond, bar) do { unsigned _sp = 0; while (cond) { __builtin_amdgcn_s_sleep(1); \
    if ((++_sp & 255u) == 0u) { if (xb_ld(&(bar)[XB_TMO])) break; if (_sp > XB_SPIN_CAP) { atomicAdd(&(bar)[XB_TMO], 1u); break; } } } } while (0)
struct XcdBarrier { unsigned* bar; unsigned x; volatile LAS unsigned* st; };
__device__ __forceinline__ XcdBarrier xcd_barrier_post(unsigned* bar, volatile LAS unsigned* st) {
    XcdBarrier b; b.bar = bar; b.x = xb_xcc_id(); b.st = st;
    if (threadIdx.x == 0) (void)xb_add(&bar[XB_XCNT(b.x)], 1u);
    return b;
}
__device__ __forceinline__ void xcd_barrier_complete(unsigned* bar, unsigned x, unsigned& nloc, unsigned& nx) {
    const unsigned G = gridDim.x * gridDim.y * gridDim.z;
    unsigned sum, cnt, mine, sp = 0u;
    for (;;) {
        sum = 0u; cnt = 0u; mine = 0u;
#pragma unroll
        for (unsigned j = 0; j < 16; ++j) { const unsigned c = xb_ld(&bar[XB_XCNT(j)]); sum += c; cnt += (c > 0u) ? 1u : 0u; mine = (j == x) ? c : mine; }
        if (sum == G) break;
        __builtin_amdgcn_s_sleep(1);
        if ((++sp & 255u) == 0u) { if (xb_ld(&bar[XB_TMO])) break; if (sp > XB_SPIN_CAP) { atomicAdd(&bar[XB_TMO], 1u); break; } }
    }
    nloc = mine > 0u ? mine : 1u; nx = cnt > 0u ? cnt : 1u;
}
__device__ __forceinline__ void xcd_barrier(const XcdBarrier& b) {
    asm volatile("s_waitcnt vmcnt(0)" ::: "memory");
    __syncthreads();
    if (threadIdx.x == 0) {
        unsigned* bar = b.bar;
        __builtin_amdgcn_s_waitcnt(0);
        unsigned nloc = b.st[0], nx = b.st[1];
        if (nloc == 0u) { xcd_barrier_complete(bar, b.x, nloc, nx); b.st[0] = nloc; b.st[1] = nx; }
        const unsigned old = xb_add(&bar[XB_XSUB(b.x)], 1u);
        const unsigned gen = old / nloc;
        if (old + 1u == (gen + 1u) * nloc) {
            __builtin_amdgcn_fence(__ATOMIC_RELEASE, "agent");
            asm volatile("s_waitcnt vmcnt(0)" ::: "memory");
            const unsigned og = xb_add(&bar[XB_TOP], 1u);
            const unsigned tg = og / nx;
            if (og + 1u == (tg + 1u) * nx) xb_add(&bar[XB_TOPGEN], 1u);
            else XB_SPIN(xb_ld(&bar[XB_TOPGEN]) == tg, bar);
            __builtin_amdgcn_fence(__ATOMIC_ACQUIRE, "agent");
            xb_add(&bar[XB_XGEN(b.x)], 1u);
            asm volatile("s_waitcnt vmcnt(0)" ::: "memory");
        } else {
            XB_SPIN(xb_ld(&bar[XB_XGEN(b.x)]) == gen, bar);
            __builtin_amdgcn_fence(__ATOMIC_ACQUIRE, "agent");
            asm volatile("s_waitcnt vmcnt(0)" ::: "memory");
        }
    }
    __syncthreads();
}

namespace pg8 {
constexpr int BM = 256, BK = 64, HALF = 128, HTB = HALF * BK * 2, STAGE_BYTES = 8 * HTB, NXCD = 8, WGM = 8;
__host__ __device__ __forceinline__ int lds_byte(int r, int c) { const int st = (r >> 4) * 2 + (c >> 5), rr = r & 15, cc = c & 31, ob = rr * 64 + cc * 2; return st * 1024 + (ob ^ (((ob >> 9) & 1) << 5)); }
__host__ __device__ __forceinline__ void stage_rc(int b, int& R, int& C) { const int st = b / 1024, sb = b % 1024, swz = sb ^ (((sb >> 9) & 1) << 5); R = (st >> 1) * 16 + swz / 64; C = (st & 1) * 32 + (swz % 64) / 2; }
__host__ __device__ __forceinline__ int perm32(int rho) { const int n = rho >> 4, i = rho & 15; return 8 * (i >> 2) + 4 * n + (i & 3); }

struct Unit { int pm, pn, e, ti, nv; };

template <class Epi, class Sched, bool GATHER, int K>
__device__ __forceinline__ void gemm_phase(LAS unsigned char* lds, const Sched& S, const Epi& E, const int tid) {
    const int wid = __builtin_amdgcn_readfirstlane(tid >> 6), lane = tid & 63, wr = wid >> 2, wc = wid & 3, fr = lane & 15, fq = lane >> 4;
    const int nt = K / BK;
    unsigned voffA[2], voffB[2]; int RA[2], CA[2];
#pragma unroll
    for (int i = 0; i < 2; ++i) { int R, C; stage_rc(tid * 16 + i * 8192, R, C); const int Rb = Epi::PERM ? ((R & ~31) + perm32(R & 31)) : R;
        RA[i] = R; CA[i] = C; voffA[i] = (unsigned)(R * K + C) * 2u; voffB[i] = (unsigned)(Rb * K + C) * 2u; }
    const size_t kstep = (size_t)(BK * 2);
    const size_t hstep = (size_t)HALF * K * 2;
    const unsigned ldsw = (unsigned)wid * 1024u;
    const int aoff = lds_byte(wr * 64 + fr, fq * 8), boff = lds_byte(wc * 32 + fr, fq * 8);
    unsigned gA[2][2], ngA[2][2];
#define PG8_SA(b, h) (((b) * 2 + (h)) * HTB)
#define PG8_SB(b, h) ((4 + (b) * 2 + (h)) * HTB)
#define PG8_STAGE(bufoff, gbase, voff) do { _Pragma("unroll") for (int _i = 0; _i < 2; ++_i) \
        __builtin_amdgcn_global_load_lds((const unsigned*)((const char*)(gbase) + (voff)[_i]), (LAS unsigned*)(lds + (bufoff) + ldsw + _i * 8192), 16, 0, 0); } while (0)
#define PG8_STAGE_A(bufoff, gptr, H, NX) do { _Pragma("unroll") for (int _i = 0; _i < 2; ++_i) { \
        const unsigned _vo = GATHER ? ((NX) ? ngA[H][_i] : gA[H][_i]) : voffA[_i]; \
        const char* _gp = GATHER ? (const char*)(gptr) : (const char*)(gptr) + (H) * hstep; \
        __builtin_amdgcn_global_load_lds((const unsigned*)(_gp + _vo), (LAS unsigned*)(lds + (bufoff) + ldsw + _i * 8192), 16, 0, 0); } } while (0)
#define PG8_LDA(dst, b, h) do { _Pragma("unroll") for (int m = 0; m < 4; ++m) _Pragma("unroll") for (int k = 0; k < 2; ++k) dst[m][k] = *(const LAS bf16x8*)(lds + PG8_SA(b, h) + aoff + m * 2048 + k * 1024); } while (0)
#define PG8_LDB(dst, b, h) do { _Pragma("unroll") for (int n = 0; n < 2; ++n) _Pragma("unroll") for (int k = 0; k < 2; ++k) dst[n][k] = *(const LAS bf16x8*)(lds + PG8_SB(b, h) + boff + n * 2048 + k * 1024); } while (0)
#define PG8_MMA(ai, bj, At, Bt) do { __builtin_amdgcn_s_setprio(1); _Pragma("unroll") for (int m = 0; m < 4; ++m) _Pragma("unroll") for (int n = 0; n < 2; ++n) _Pragma("unroll") for (int k = 0; k < 2; ++k) \
        acc[ai][bj][m][n] = __builtin_amdgcn_mfma_f32_16x16x32_bf16(Bt[n][k], At[m][k], acc[ai][bj][m][n], 0, 0, 0); __builtin_amdgcn_s_setprio(0); } while (0)
#define PG8_WAIT_V(n) asm volatile("s_waitcnt vmcnt(" #n ")" ::: "memory")
#define PG8_WAIT_L(n) asm volatile("s_waitcnt lgkmcnt(" #n ")" ::: "memory")
#define PG8_BAR __builtin_amdgcn_s_barrier()
#define PG8_SCHED __builtin_amdgcn_sched_barrier(0)
#define PG8_GLOAD(dst, u) do { if constexpr (GATHER) { const int* _rm = S.rows(u); \
        _Pragma("unroll") for (int _h = 0; _h < 2; ++_h) _Pragma("unroll") for (int _i = 0; _i < 2; ++_i) { const int _r = _h * HALF + RA[_i]; \
            const int _tok = (_r < (u).nv) ? (_rm[_r] >> 1) : 0; dst[_h][_i] = (unsigned)(_tok * K + CA[_i]) * 2u; } \
        asm volatile("s_waitcnt vmcnt(0)" : "+v"(dst[0][0]), "+v"(dst[0][1]), "+v"(dst[1][0]), "+v"(dst[1][1]) :: "memory"); } } while (0)
    Unit cur, nxt; int ui = 0;
    if (!S.next(0, cur)) return;
    f32x4 acc[2][2][4][2];
#pragma unroll
    for (int a = 0; a < 2; ++a)
#pragma unroll
        for (int b = 0; b < 2; ++b)
#pragma unroll
            for (int m = 0; m < 4; ++m)
#pragma unroll
                for (int n = 0; n < 2; ++n) acc[a][b][m][n] = (f32x4){0.f, 0.f, 0.f, 0.f};
    bf16x8 At[4][2], B0[2][2], B1[2][2];
    const char* cA = S.a_base(cur); const char* cB = S.b_base(cur);
    PG8_GLOAD(gA, cur);
    PG8_STAGE(PG8_SB(0, 0), cB, voffB); PG8_STAGE(PG8_SB(0, 1), cB + hstep, voffB); PG8_STAGE_A(PG8_SA(0, 0), cA, 0, false); PG8_STAGE_A(PG8_SA(0, 1), cA, 1, false);
    if (wr == 1) PG8_BAR;
    PG8_WAIT_V(2); PG8_BAR;
    PG8_STAGE(PG8_SB(1, 0), cB + kstep, voffB); PG8_STAGE_A(PG8_SA(1, 0), cA + kstep, 0, false); PG8_STAGE(PG8_SB(1, 1), cB + hstep + kstep, voffB);
    PG8_WAIT_V(6); PG8_BAR;
    for (;;) {
        const bool has_next = S.next(ui + 1, nxt);
        const char* nA = has_next ? S.a_base(nxt) : cA; const char* nB = has_next ? S.b_base(nxt) : cB;
        if constexpr (GATHER) {
            if (has_next) { PG8_GLOAD(ngA, nxt); }
            else {
#pragma unroll
                for (int _h = 0; _h < 2; ++_h)
#pragma unroll
                    for (int _i = 0; _i < 2; ++_i) ngA[_h][_i] = gA[_h][_i]; }
        }
        for (int t = 0; t < nt; t += 2) {
            const bool last = (t == nt - 2);
            const char* a1 = cA + (size_t)(t + 1) * kstep;
            const char* a2 = last ? nA : cA + (size_t)(t + 2) * kstep; const char* b2 = last ? nB : cB + (size_t)(t + 2) * kstep;
            const char* a3 = a2 + kstep; const char* b3 = b2 + kstep;
            PG8_LDB(B0, 0, 0); PG8_LDB(B1, 0, 1); PG8_SCHED; PG8_LDA(At, 0, 0); PG8_STAGE_A(PG8_SA(1, 1), a1, 1, false);
            PG8_WAIT_V(8); PG8_WAIT_L(0); PG8_BAR; PG8_MMA(0, 0, At, B0); PG8_MMA(0, 1, At, B1); PG8_BAR; PG8_SCHED;
            PG8_LDA(At, 0, 1); PG8_STAGE(PG8_SB(0, 0), b2, voffB); PG8_STAGE(PG8_SB(0, 1), b2 + hstep, voffB); PG8_STAGE_A(PG8_SA(0, 0), a2, 0, last);
            PG8_WAIT_V(8); PG8_WAIT_L(0); PG8_BAR; PG8_MMA(1, 0, At, B0); PG8_MMA(1, 1, At, B1); PG8_BAR; PG8_SCHED;
            PG8_LDB(B0, 1, 0); PG8_LDB(B1, 1, 1); PG8_SCHED; PG8_LDA(At, 1, 0); PG8_STAGE_A(PG8_SA(0, 1), a2, 1, last);
            PG8_WAIT_V(8); PG8_WAIT_L(0); PG8_BAR; PG8_MMA(0, 0, At, B0); PG8_MMA(0, 1, At, B1); PG8_BAR; PG8_SCHED;
            PG8_LDA(At, 1, 1); PG8_STAGE(PG8_SB(1, 0), b3, voffB); PG8_STAGE(PG8_SB(1, 1), b3 + hstep, voffB); PG8_STAGE_A(PG8_SA(1, 0), a3, 0, last);
            PG8_WAIT_V(8); PG8_WAIT_L(0); PG8_BAR; PG8_MMA(1, 0, At, B0); PG8_MMA(1, 1, At, B1); PG8_BAR; PG8_SCHED;
        }
        if (wr == 0) PG8_BAR;
        E(acc, cur, wr, wc, fr, fq);
        if (!has_next) break;
#pragma unroll
        for (int a = 0; a < 2; ++a)
#pragma unroll
            for (int b = 0; b < 2; ++b)
#pragma unroll
                for (int m = 0; m < 4; ++m)
#pragma unroll
                    for (int n = 0; n < 2; ++n) acc[a][b][m][n] = (f32x4){0.f, 0.f, 0.f, 0.f};
        cur = nxt; cA = nA; cB = nB; ++ui;
        if constexpr (GATHER) {
#pragma unroll
            for (int _h = 0; _h < 2; ++_h)
#pragma unroll
                for (int _i = 0; _i < 2; ++_i) gA[_h][_i] = ngA[_h][_i]; }
        if (wr == 1) PG8_BAR;
    }
    PG8_WAIT_V(0);
    PG8_BAR;
#undef PG8_SA
#undef PG8_SB
#undef PG8_STAGE
#undef PG8_STAGE_A
#undef PG8_LDA
#undef PG8_LDB
#undef PG8_MMA
#undef PG8_WAIT_V
#undef PG8_WAIT_L
#undef PG8_BAR
#undef PG8_SCHED
#undef PG8_GLOAD
}

struct DenseSched {
    const char *A0, *B0, *A1, *B1; int K; int nM, nN, nwg, G, c, nM1, nwg1;
    __device__ __forceinline__ void init(const void* a0, const void* b0, int M, int N, int K_, const void* a1, const void* b1, int M1, int N1, int G_, int c_) {
        A0 = (const char*)a0; B0 = (const char*)b0; A1 = (const char*)a1; B1 = (const char*)b1; K = K_; nM = M / BM; nN = N / BM; nwg = nM * nN; G = G_; c = c_;
        nM1 = M1 / BM > 0 ? M1 / BM : 1; nwg1 = (M1 / BM) * (N1 / BM); }
    __device__ __forceinline__ bool next(int i, Unit& u) const {
        const int L = i * G + c; if (L >= nwg + nwg1) return false;
        u.ti = 0; u.nv = BM;
        if (L < nwg) {
            int wgid = L; { const int q = nwg / NXCD, r = nwg % NXCD, xcd = wgid % NXCD, off = wgid / NXCD; wgid = (xcd < r ? xcd * (q + 1) : r * (q + 1) + (xcd - r) * q) + off; }
            const int nig = WGM * nN, gid = wgid / nig, fm = gid * WGM, gsz = (nM - fm) < WGM ? (nM - fm) : WGM;
            u.pm = fm + ((wgid % nig) % gsz); u.pn = (wgid % nig) / gsz; u.e = 0;
        } else { const int l = L - nwg; u.pm = l % nM1; u.pn = l / nM1; u.e = 1; }
        return true;
    }
    __device__ __forceinline__ const char* a_base(const Unit& u) const { return (u.e ? A1 : A0) + (size_t)u.pm * BM * K * 2; }
    __device__ __forceinline__ const char* b_base(const Unit& u) const { return (u.e ? B1 : B0) + (size_t)u.pn * BM * K * 2; }
    __device__ __forceinline__ const int* rows(const Unit&) const { return nullptr; }
};
struct MoeSched {
    const char* A; const char* Bt; int K; size_t bstride; const LAS int* tpre; const int* rowmap; int G, c; bool gather;
    __device__ __forceinline__ bool next(int i, Unit& u) const {
        const int L = i * G + c; const int tot = tpre[16]; if (L >= tot * 4) return false;
        const int rt = L >> 2; int e = 0;
#pragma unroll
        for (int k = 1; k < 16; ++k) e += (rt >= tpre[k]) ? 1 : 0;
        const int ti = rt - tpre[e]; const int rem = tpre[32 + e] - ti * BM;
        u.pn = L & 3; u.pm = __builtin_amdgcn_readfirstlane(rt); u.e = __builtin_amdgcn_readfirstlane(e); u.ti = __builtin_amdgcn_readfirstlane(ti); u.nv = __builtin_amdgcn_readfirstlane(rem < BM ? rem : BM);
        return true;
    }
    __device__ __forceinline__ const char* a_base(const Unit& u) const { return gather ? A : A + (size_t)u.pm * BM * K * 2; }
    __device__ __forceinline__ const char* b_base(const Unit& u) const { return Bt + (size_t)u.e * bstride + (size_t)u.pn * BM * K * 2; }
    __device__ __forceinline__ const int* rows(const Unit& u) const { return rowmap + (size_t)u.e * RCAP + u.ti * BM; }
};

struct EpiProj {
    static constexpr bool PERM = true;
    bf16_t* O0; int ldc0; unsigned smask; float sc; bf16_t* O1; int ldc1;
    __device__ __forceinline__ void operator()(const f32x4 (&acc)[2][2][4][2], const Unit& u, int wr, int wc, int fr, int fq) const {
        bf16_t* O = u.e ? O1 : O0; const int ldc = u.e ? ldc1 : ldc0; const float s = (!u.e && ((smask >> u.pn) & 1u)) ? sc : 1.f;
        const int row0 = u.pm * BM + wr * 64 + fr, col0 = u.pn * BM + wc * 32 + 8 * fq;
#pragma unroll
        for (int ai = 0; ai < 2; ++ai)
#pragma unroll
            for (int m = 0; m < 4; ++m) { bf16_t* rowp = O + (size_t)(row0 + ai * HALF + m * 16) * ldc + col0;
#pragma unroll
                for (int bj = 0; bj < 2; ++bj) { const f32x4 v0 = acc[ai][bj][m][0] * s, v1 = acc[ai][bj][m][1] * s; u32x4 w;
                    w.x = cvt_pk_bf16(v0[0], v0[1]); w.y = cvt_pk_bf16(v0[2], v0[3]); w.z = cvt_pk_bf16(v1[0], v1[1]); w.w = cvt_pk_bf16(v1[2], v1[3]);
                    *(u32x4*)(rowp + bj * HALF) = w; } }
    }
};
struct EpiZ {
    static constexpr bool PERM = false;
    const float* res; float* out;
    __device__ __forceinline__ void operator()(const f32x4 (&acc)[2][2][4][2], const Unit& u, int wr, int wc, int fr, int fq) const {
        const int row0 = u.pm * BM + wr * 64 + fr, col0 = u.pn * BM + wc * 32 + 4 * fq;
#pragma unroll
        for (int ai = 0; ai < 2; ++ai)
#pragma unroll
            for (int m = 0; m < 4; ++m) { const size_t off = (size_t)(row0 + ai * HALF + m * 16) * DM + col0;
#pragma unroll
                for (int bj = 0; bj < 2; ++bj)
#pragma unroll
                    for (int n = 0; n < 2; ++n) { const f32x4 r = *(const f32x4*)(res + off + bj * HALF + n * 16); *(f32x4*)(out + off + bj * HALF + n * 16) = r * ALPHA + acc[ai][bj][m][n]; } }
    }
};
struct EpiGU {
    static constexpr bool PERM = true;
    bf16_t* H;
    __device__ __forceinline__ void operator()(const f32x4 (&acc)[2][2][4][2], const Unit& u, int wr, int wc, int fr, int fq) const {
        const int row0 = u.pm * BM + wr * 64 + fr, col0 = u.pn * HALF + wc * 32 + 8 * fq;
#pragma unroll
        for (int ai = 0; ai < 2; ++ai)
#pragma unroll
            for (int m = 0; m < 4; ++m) { float hv[8];
#pragma unroll
                for (int n = 0; n < 2; ++n)
#pragma unroll
                    for (int j = 0; j < 4; ++j) { const float g = acc[ai][0][m][n][j], uu = acc[ai][1][m][n][j];
                        hv[n * 4 + j] = g * __builtin_amdgcn_rcpf(1.f + __builtin_amdgcn_exp2f(-1.4426950408889634f * g)) * uu; }
                u32x4 w; w.x = cvt_pk_bf16(hv[0], hv[1]); w.y = cvt_pk_bf16(hv[2], hv[3]); w.z = cvt_pk_bf16(hv[4], hv[5]); w.w = cvt_pk_bf16(hv[6], hv[7]);
                *(u32x4*)(H + (size_t)(row0 + ai * HALF + m * 16) * DEXP + col0) = w; }
    }
};
struct EpiDown {
    static constexpr bool PERM = true;
    bf16_t* Y; const int* rowmap; const float* roww;
    __device__ __forceinline__ void operator()(const f32x4 (&acc)[2][2][4][2], const Unit& u, int wr, int wc, int fr, int fq) const {
        const int* rm = rowmap + (size_t)u.e * RCAP + u.ti * BM; const float* rw = roww + (size_t)u.e * RCAP + u.ti * BM;
        const int col0 = u.pn * BM + wc * 32 + 8 * fq;
#pragma unroll
        for (int ai = 0; ai < 2; ++ai)
#pragma unroll
            for (int m = 0; m < 4; ++m) { const int r = ai * HALF + wr * 64 + m * 16 + fr;
                if (r < u.nv) { const int code = rm[r]; const float s = rw[r];
                    bf16_t* rowp = Y + ((size_t)(code & 1) * NTOK + (size_t)(code >> 1)) * DM + col0;
#pragma unroll
                    for (int bj = 0; bj < 2; ++bj) { const f32x4 v0 = acc[ai][bj][m][0] * s, v1 = acc[ai][bj][m][1] * s; u32x4 w;
                        w.x = cvt_pk_bf16(v0[0], v0[1]); w.y = cvt_pk_bf16(v0[2], v0[3]); w.z = cvt_pk_bf16(v1[0], v1[1]); w.w = cvt_pk_bf16(v1[2], v1[3]);
                        *(u32x4*)(rowp + bj * HALF) = w; } } }
    }
};
}

namespace attn_body {
using bf16 = bf16_t;
constexpr int D = 64, NW = 8, QBLK = 32, QB = QBLK * NW, KVBLK = 64;
__device__ __forceinline__ int crow(int r, int hi) { return (r & 3) + 8 * (r >> 2) + 4 * hi; }
#define SBAR() __builtin_amdgcn_sched_barrier(0)
constexpr int NSLOT = 3, SLOTB = 8192;
constexpr int LDS_K = 0, LDS_V = NSLOT * SLOTB, LDS_WS = 2 * NSLOT * SLOTB, LDS_OST = LDS_WS + NW * 64 * 4, LDS_BYTES_A = LDS_OST + NW * 4096;
__device__ __forceinline__ void glds16(const void* gsrc, unsigned lds_dst) { unsigned keep;
  asm volatile("s_mov_b32 %0, m0\n\ts_mov_b32 m0, %2\n\ts_nop 0\n\tglobal_load_lds_dwordx4 %1, off\n\ts_mov_b32 m0, %0" : "=&s"(keep) : "v"(gsrc), "s"(lds_dst) : "memory"); }
__device__ __forceinline__ float max3f(float a, float b, float c) { float r; asm("v_max3_f32 %0, %1, %2, %3" : "=v"(r) : "v"(a), "v"(b), "v"(c)); return r; }
__device__ __forceinline__ float max2f(float a, float b) { float r; asm("v_max_f32_e32 %0, %1, %2" : "=v"(r) : "v"(a), "v"(b)); return r; }
__device__ __forceinline__ float fadd_s(float a, float b) { float r; asm("v_add_f32_e32 %0, %1, %2" : "=v"(r) : "v"(a), "v"(b)); return r; }
__device__ __forceinline__ float fsub_s(float a, float b) { float r; asm("v_sub_f32_e32 %0, %1, %2" : "=v"(r) : "v"(a), "v"(b)); return r; }
typedef float f32x2_t __attribute__((ext_vector_type(2))); typedef __bf16 bf16x2_t __attribute__((ext_vector_type(2)));
__device__ __forceinline__ unsigned cvtpk_s(float lo, float hi) { f32x2_t v = {lo, hi}; bf16x2_t b = __builtin_convertvector(v, bf16x2_t); return __builtin_bit_cast(unsigned, b); }
#define WAIT_BAR(N) asm volatile("s_waitcnt vmcnt(" #N ") lgkmcnt(0)\n\ts_barrier" ::: "memory")
__device__ __forceinline__ void qkt(f32x16& p0, f32x16& p1, const char* Kslot, const bf16x8* qr, const f32x16& negm, int r32, int hi) {
  const char* kb = Kslot + hi * 1024 + r32 * 16;
  #pragma unroll
  for (int d0 = 0; d0 < 4; ++d0) {
    const bf16x8 b0 = *reinterpret_cast<const bf16x8*>(kb + d0 * 2048);
    const bf16x8 b1 = *reinterpret_cast<const bf16x8*>(kb + d0 * 2048 + 512);
    if (d0 == 0) { p0 = __builtin_amdgcn_mfma_f32_32x32x16_bf16(b0, qr[0], negm, 0, 0, 0); p1 = __builtin_amdgcn_mfma_f32_32x32x16_bf16(b1, qr[0], negm, 0, 0, 0); }
    else { p0 = __builtin_amdgcn_mfma_f32_32x32x16_bf16(b0, qr[d0], p0, 0, 0, 0); p1 = __builtin_amdgcn_mfma_f32_32x32x16_bf16(b1, qr[d0], p1, 0, 0, 0); } }
}
typedef __attribute__((address_space(3))) const char* lds_cptr;
typedef short v4i16_t __attribute__((ext_vector_type(4)));
__device__ __forceinline__ void kload8(bf16x8* kf, lds_cptr kp) {
  kf[0] = *(const LAS bf16x8*)(kp);        kf[1] = *(const LAS bf16x8*)(kp + 512);
  kf[2] = *(const LAS bf16x8*)(kp + 2048); kf[3] = *(const LAS bf16x8*)(kp + 2560);
  kf[4] = *(const LAS bf16x8*)(kp + 4096); kf[5] = *(const LAS bf16x8*)(kp + 4608);
  kf[6] = *(const LAS bf16x8*)(kp + 6144); kf[7] = *(const LAS bf16x8*)(kp + 6656);
}
__device__ __forceinline__ void kload2(bf16x8* kf, lds_cptr kp, int j) { kf[2 * j] = *(const LAS bf16x8*)(kp + j * 2048); kf[2 * j + 1] = *(const LAS bf16x8*)(kp + j * 2048 + 512); }
__device__ __forceinline__ s16x4 vtr(lds_cptr p) { return __builtin_bit_cast(s16x4, __builtin_amdgcn_ds_read_tr16_b64_v4i16((LAS v4i16_t*)p)); }
__device__ __forceinline__ float rowmax(const f32x16& p0, const f32x16& p1) {
  float a = max3f(p0[0], p0[1], p1[0]), b = max3f(p0[2], p0[3], p1[1]); a = max3f(a, p1[2], p1[3]);
  #pragma unroll
  for (int r = 4; r < 16; r += 4) { a = max3f(a, p0[r], p0[r + 1]); b = max3f(b, p0[r + 2], p0[r + 3]); a = max3f(a, p1[r], p1[r + 1]); b = max3f(b, p1[r + 2], p1[r + 3]); }
  const float m = max2f(a, b);
  auto rr = __builtin_amdgcn_permlane32_swap(__float_as_uint(m), __float_as_uint(m), false, false);
  return max2f(__uint_as_float(rr[0]), __uint_as_float(rr[1]));
}
__device__ __forceinline__ void pv(f32x16* o, int vb, bf16x8 pa0, bf16x8 pa1, bf16x8 pa2, bf16x8 pa3) {
  #pragma unroll
  for (int d0 = 0; d0 < 2; ++d0) { s16x4 lo[4], hi[4];
    #pragma unroll
    for (int ks = 0; ks < 4; ++ks) {
      asm volatile("ds_read_b64_tr_b16 %0,%1 offset:%c2" : "=&v"(lo[ks]) : "v"(vb), "i"(d0 * 4096 + ks * 1024) : "memory");
      asm volatile("ds_read_b64_tr_b16 %0,%1 offset:%c2" : "=&v"(hi[ks]) : "v"(vb), "i"(d0 * 4096 + ks * 1024 + 512) : "memory"); }
    asm volatile("s_waitcnt lgkmcnt(0)" ::: "memory"); SBAR();
    #define PK(k) (bf16x8){lo[k][0], lo[k][1], lo[k][2], lo[k][3], hi[k][0], hi[k][1], hi[k][2], hi[k][3]}
    o[d0] = __builtin_amdgcn_mfma_f32_32x32x16_bf16(pa0, PK(0), o[d0], 0, 0, 0);
    o[d0] = __builtin_amdgcn_mfma_f32_32x32x16_bf16(pa1, PK(1), o[d0], 0, 0, 0);
    o[d0] = __builtin_amdgcn_mfma_f32_32x32x16_bf16(pa2, PK(2), o[d0], 0, 0, 0);
    o[d0] = __builtin_amdgcn_mfma_f32_32x32x16_bf16(pa3, PK(3), o[d0], 0, 0, 0);
    #undef PK
  }
}
template<int THRL, int QP, int KP, int VP, int OP, int NT> __device__ __forceinline__ void attn_unit(const bf16* Qb, const bf16* __restrict__ Kb, const bf16* __restrict__ Vb, bf16* Ob, const int q0, char* shm, const int tid) {
  const int lane = tid & 63, r32 = lane & 31, hi = lane >> 5; const int wid = __builtin_amdgcn_readfirstlane(tid >> 6);
  const bf16* Qw = Qb + (long)(q0 + wid * QBLK) * QP;
  const unsigned lds0 = (unsigned)(uintptr_t)shm;
  float* wsf = (float*)(shm + LDS_WS) + wid * 64;
  const bf16* ksrc = Kb + (long)lane * KP + wid * 8;
  const bf16* vsrc = Vb + (long)(16 * (wid & 3) + (lane >> 2)) * VP + (wid >> 2) * 32 + (lane & 3) * 8;
  const unsigned kdst = lds0 + LDS_K + wid * 1024, vdst = lds0 + LDS_V + wid * 1024;
  #define DMA_K(t, slot) glds16(ksrc + (long)(t) * KVBLK * KP, (unsigned)__builtin_amdgcn_readfirstlane(kdst + (slot)))
  #define DMA_V(t, slot) glds16(vsrc + (long)(t) * KVBLK * VP, (unsigned)__builtin_amdgcn_readfirstlane(vdst + (slot)))
  const int vb0 = (int)(lds0 + LDS_V) + ((lane >> 4) & 1) * 32 + (lane & 3) * 8 + (4 * hi + ((lane & 15) >> 2)) * 64;
  const char* Kbase = shm + LDS_K; bf16x8 kf[8];
  const lds_cptr shm3 = (lds_cptr)shm; const lds_cptr kp0 = shm3 + LDS_K + hi * 1024 + r32 * 16; const lds_cptr vp0 = shm3 + LDS_V + ((lane >> 4) & 1) * 32 + (lane & 3) * 8 + (4 * hi + ((lane & 15) >> 2)) * 64;
  DMA_K(0, 0); DMA_V(0, 0); DMA_K(1, SLOTB);
  bf16x8 qr[4];
  #pragma unroll
  for (int d0 = 0; d0 < 4; ++d0) qr[d0] = *reinterpret_cast<const bf16x8*>(&Qw[(long)r32 * QP + d0 * 16 + hi * 8]);
  float mhat = 0.f, l_reg = 0.f; f32x16 o[2]; o[0] = f32x16{}; o[1] = f32x16{}; float zz_ = 0.f; asm volatile("" : "+v"(zz_)); f32x16 negm; _Pragma("unroll") for (int r = 0; r < 16; ++r) negm[r] = zz_; asm volatile("" : "+v"(negm));
  bool resc = false;
  #define START(P0, P1) do { const float rm = rowmax(P0, P1); resc = false; \
    { const float dl = rm; mhat = fadd_s(mhat, dl); \
      _Pragma("unroll") for (int r = 0; r < 16; ++r) { P0[r] = fsub_s(P0[r], dl); P1[r] = fsub_s(P1[r], dl); } \
      _Pragma("unroll") for (int r = 0; r < 16; ++r) negm[r] = -mhat; asm volatile("" : "+v"(negm)); } \
    _Pragma("unroll") for (int r = 0; r < 16; ++r) P0[r] = __builtin_amdgcn_exp2f(P0[r]); } while (0)
  #define RESC() do { if (resc) { asm volatile("s_waitcnt lgkmcnt(0)" ::: "memory"); \
      _Pragma("unroll") for (int d_ = 0; d_ < 2; ++d_) _Pragma("unroll") for (int r = 0; r < 16; ++r) o[d_][r] *= wsf[crow(r, hi)]; } } while (0)
  f32x16 pA0, pA1, pB0, pB1;
  int sl_prev = 0, sl_cur = 0, sl_next = SLOTB;
  #define ROT() do { sl_prev = sl_cur; sl_cur = sl_next; sl_next = (sl_next == (NSLOT - 1) * SLOTB) ? 0 : sl_next + SLOTB; } while (0)
  DMA_K(2, 2 * SLOTB);
  WAIT_BAR(3);
  qkt(pA0, pA1, Kbase, qr, negm, r32, hi); asm volatile("s_nop 15\n\ts_nop 7" : "+v"(pA0), "+v"(pA1));
  START(pA0, pA1);
  _Pragma("unroll") for (int r = 0; r < 16; ++r) pA1[r] = __builtin_amdgcn_exp2f(pA1[r]);
  WAIT_BAR(0);
  DMA_K(3, 0); DMA_V(1, SLOTB);
  ROT();
  kload8(kf, kp0 + sl_cur);
  WAIT_BAR(2);
  s16x4 vlo[8], vhi[8]; u32x4 pw0, pw1, pw2, pw3;
  #define PKW(P, B) cvtpk_s(P[B], P[B + 1])
  #define PAF(k) __builtin_bit_cast(bf16x8, pw##k)
  #define VFR(i) (bf16x8){vlo[i][0], vlo[i][1], vlo[i][2], vlo[i][3], vhi[i][0], vhi[i][1], vhi[i][2], vhi[i][3]}
  #define PIN(x) asm volatile("" : "+v"(x))
  #define MX3(a, b, c) __builtin_fmaxf(__builtin_fmaxf((a), (b)), (c))
  #define GAPA(MF, A0, A1, A2, A3, W0, W1, PW) do { MF; sacc += A0; sacc += A1; sacc += A2; sacc += A3; PIN(sacc); W0; W1; PIN(PW); SBAR(); } while (0)
  #define EX(v) __builtin_amdgcn_exp2f(v)
  #define GAPB(MF, X, B) do { MF; X[B] = EX(X[B]); X[B + 1] = EX(X[B + 1]); X[B + 2] = EX(X[B + 2]); X[B + 3] = EX(X[B + 3]); PIN(X); SBAR(); } while (0)
  #define VRD(i) do { vlo[i] = vtr(vp_ + (((i) >> 2) * 4096 + ((i) & 3) * 1024)); vhi[i] = vtr(vp_ + (((i) >> 2) * 4096 + ((i) & 3) * 1024 + 512)); } while (0)
  #define KRD(G, j) do { if (G) { kload2(kf, kp0 + sl_next, j); SBAR(); } } while (0)
  #define STEP(C0, C1, P0, P1, t, GK, GV, GL) do { SBAR(); \
    const lds_cptr vp_ = vp0 + sl_prev; \
    VRD(0); SBAR(); float sacc = (P0[0] + P0[1]); \
    GAPA(C0 = __builtin_amdgcn_mfma_f32_32x32x16_bf16(kf[0], qr[0], negm, 0, 0, 0), P0[2], P0[3], P0[4], P0[5],     pw0[0] = PKW(P0, 0), pw0[1] = PKW(P0, 2), pw0); \
    VRD(4); SBAR(); GAPA(C1 = __builtin_amdgcn_mfma_f32_32x32x16_bf16(kf[1], qr[0], negm, 0, 0, 0), P0[6], P0[7], P0[8], P0[9],     pw0[2] = PKW(P0, 4), pw0[3] = PKW(P0, 6), pw0); \
    VRD(1); SBAR(); GAPA(C0 = __builtin_amdgcn_mfma_f32_32x32x16_bf16(kf[2], qr[1], C0, 0, 0, 0),   P0[10], P0[11], P0[12], P0[13], pw1[0] = PKW(P0, 8), pw1[1] = PKW(P0, 10), pw1); \
    VRD(5); SBAR(); GAPA(C1 = __builtin_amdgcn_mfma_f32_32x32x16_bf16(kf[3], qr[1], C1, 0, 0, 0),   P0[14], P0[15], P1[0], P1[1],   pw1[2] = PKW(P0, 12), pw1[3] = PKW(P0, 14), pw1); \
    VRD(2); SBAR(); GAPA(C0 = __builtin_amdgcn_mfma_f32_32x32x16_bf16(kf[4], qr[2], C0, 0, 0, 0),   P1[2], P1[3], P1[4], P1[5],     pw2[0] = PKW(P1, 0), pw2[1] = PKW(P1, 2), pw2); \
    VRD(6); SBAR(); GAPA(C1 = __builtin_amdgcn_mfma_f32_32x32x16_bf16(kf[5], qr[2], C1, 0, 0, 0),   P1[6], P1[7], P1[8], P1[9],     pw2[2] = PKW(P1, 4), pw2[3] = PKW(P1, 6), pw2); \
    VRD(3); SBAR(); GAPA(C0 = __builtin_amdgcn_mfma_f32_32x32x16_bf16(kf[6], qr[3], C0, 0, 0, 0),   P1[10], P1[11], P1[12], P1[13], pw3[0] = PKW(P1, 8), pw3[1] = PKW(P1, 10), pw3); \
    VRD(7); SBAR(); GAPA(C1 = __builtin_amdgcn_mfma_f32_32x32x16_bf16(kf[7], qr[3], C1, 0, 0, 0),   P1[14], P1[15], 0.f, 0.f,       pw3[2] = PKW(P1, 12), pw3[3] = PKW(P1, 14), pw3); \
    l_reg += sacc; \
    if (GK) { DMA_K((t) + 3, sl_cur); } if (GV) { DMA_V((t) + 1, sl_next); } \
    { float a = MX3(C0[0], C0[1], C1[0]), b = MX3(C0[2], C0[3], C1[1]); a = MX3(a, C1[2], C1[3]); \
      _Pragma("unroll") for (int r = 4; r < 16; r += 4) { a = MX3(a, C0[r], C0[r + 1]); b = MX3(b, C0[r + 2], C0[r + 3]); a = MX3(a, C1[r], C1[r + 1]); b = MX3(b, C1[r + 2], C1[r + 3]); } \
      float rm = __builtin_fmaxf(a, b); { auto rr = __builtin_amdgcn_permlane32_swap(__float_as_uint(rm), __float_as_uint(rm), false, false); rm = __builtin_fmaxf(__uint_as_float(rr[0]), __uint_as_float(rr[1])); } \
      resc = false; \
      if (__builtin_expect(__any(rm > (float)THRL), 0)) { const float dl = __builtin_fmaxf(rm, 0.f); mhat += dl; \
        _Pragma("unroll") for (int r = 0; r < 16; ++r) { C0[r] -= dl; C1[r] -= dl; } \
        _Pragma("unroll") for (int r = 0; r < 16; ++r) negm[r] = -mhat; asm volatile("" : "+v"(negm)); \
        const float f = __builtin_amdgcn_exp2f(-dl); l_reg *= f; if (hi == 0) wsf[r32] = f; resc = true; } } \
    SBAR(); \
    GAPB(o[0] = __builtin_amdgcn_mfma_f32_32x32x16_bf16(PAF(0), VFR(0), o[0], 0, 0, 0), C0, 0); \
    GAPB(o[1] = __builtin_amdgcn_mfma_f32_32x32x16_bf16(PAF(0), VFR(4), o[1], 0, 0, 0), C0, 4); \
    KRD(GL, 0); GAPB(o[0] = __builtin_amdgcn_mfma_f32_32x32x16_bf16(PAF(1), VFR(1), o[0], 0, 0, 0), C0, 8); \
    KRD(GL, 1); GAPB(o[1] = __builtin_amdgcn_mfma_f32_32x32x16_bf16(PAF(1), VFR(5), o[1], 0, 0, 0), C0, 12); \
    KRD(GL, 2); GAPB(o[0] = __builtin_amdgcn_mfma_f32_32x32x16_bf16(PAF(2), VFR(2), o[0], 0, 0, 0), C1, 0); \
    KRD(GL, 3); GAPB(o[1] = __builtin_amdgcn_mfma_f32_32x32x16_bf16(PAF(2), VFR(6), o[1], 0, 0, 0), C1, 4); \
    GAPB(o[0] = __builtin_amdgcn_mfma_f32_32x32x16_bf16(PAF(3), VFR(3), o[0], 0, 0, 0), C1, 8); \
    GAPB(o[1] = __builtin_amdgcn_mfma_f32_32x32x16_bf16(PAF(3), VFR(7), o[1], 0, 0, 0), C1, 12); \
    } while (0)
  int t = 1;
  for (; t + 5 < NT; t += 2) {
    STEP(pB0, pB1, pA0, pA1, t, true, true, true);     WAIT_BAR(2); RESC(); ROT();
    STEP(pA0, pA1, pB0, pB1, t + 1, true, true, true); WAIT_BAR(2); RESC(); ROT();
  }
  #define ENDW(tt) do { if ((tt) + 3 < NT) { WAIT_BAR(2); } else if ((tt) + 2 < NT) { WAIT_BAR(1); } else { WAIT_BAR(0); } } while (0)
  for (; t + 1 < NT; t += 2) {
    STEP(pB0, pB1, pA0, pA1, t, (t + 3 < NT), (t + 1 < NT), (t + 1 < NT));         ENDW(t);     RESC(); ROT();
    STEP(pA0, pA1, pB0, pB1, t + 1, (t + 4 < NT), (t + 2 < NT), (t + 2 < NT));     ENDW(t + 1); RESC(); ROT();
  }
  STEP(pB0, pB1, pA0, pA1, NT - 1, false, false, false); RESC();
  { float sacc = pB0[0] + pB0[1]; _Pragma("unroll") for (int r = 2; r < 16; ++r) sacc += pB0[r]; _Pragma("unroll") for (int r = 0; r < 16; ++r) sacc += pB1[r]; l_reg += sacc;
    pw0 = (u32x4){PKW(pB0, 0), PKW(pB0, 2), PKW(pB0, 4), PKW(pB0, 6)}; pw1 = (u32x4){PKW(pB0, 8), PKW(pB0, 10), PKW(pB0, 12), PKW(pB0, 14)}; pw2 = (u32x4){PKW(pB1, 0), PKW(pB1, 2), PKW(pB1, 4), PKW(pB1, 6)}; pw3 = (u32x4){PKW(pB1, 8), PKW(pB1, 10), PKW(pB1, 12), PKW(pB1, 14)};
    SBAR(); pv(o, vb0 + sl_cur, PAF(0), PAF(1), PAF(2), PAF(3)); }
  #undef PKW
  #undef PAF
  #undef VFR
  #undef PIN
  #undef MX3
  #undef GAPA
  #undef GAPB
  #undef EX
  #undef VRD
  #undef KRD
  #undef STEP
  #undef ENDW
  { auto rr = __builtin_amdgcn_permlane32_swap(__float_as_uint(l_reg), __float_as_uint(l_reg), false, false); l_reg = __uint_as_float(rr[0]) + __uint_as_float(rr[1]); }
  if (hi == 0) wsf[32 + r32] = l_reg; asm volatile("s_waitcnt lgkmcnt(0)" ::: "memory");
  float rli[16];
  #pragma unroll
  for (int r = 0; r < 16; ++r) rli[r] = __builtin_amdgcn_rcpf(wsf[32 + crow(r, hi)]);
  bf16* Ow = Ob + (long)(q0 + wid * QBLK) * OP;
  { bf16* stg = (bf16*)(shm + LDS_OST) + wid * 2048;
    #pragma unroll
    for (int r = 0; r < 16; ++r) { const int orow = crow(r, hi);
      #pragma unroll
      for (int d0 = 0; d0 < 2; ++d0) stg[orow * 64 + d0 * 32 + r32] = (bf16)f2bf(o[d0][r] * rli[r]); }
    asm volatile("s_waitcnt lgkmcnt(0)" ::: "memory");
    #pragma unroll
    for (int i = 0; i < 4; ++i) { const int row = i * 8 + (lane >> 3), ch = lane & 7; const u32x4 v = *(const u32x4*)(stg + row * 64 + ch * 8); *(u32x4*)(Ow + (long)row * OP + ch * 8) = v; } }
  asm volatile("s_waitcnt lgkmcnt(0)\n\ts_barrier" ::: "memory");
  #undef DMA_K
  #undef DMA_V
  #undef START
  #undef RESC
  #undef ROT
}
#undef WAIT_BAR

__device__ __forceinline__ void band_item(const bf16* P1, float* lse, int b, int g, int h, int r, int qi, int dil, int Lr, char* wlds, int lane) {
  const int r32 = lane & 31, hi = lane >> 5;
  const long pitch = B_IN;
  const int colq = (g * 8 + h) * 64, colk = 1536 + colq, colv = 3072 + colq;
  const long row0 = (long)b * SEQ;
  bf16x8 qf[4];
  { const long tq = row0 + (long)(32 * qi + r32) * dil + r; const bf16* qp = P1 + tq * pitch + colq + hi * 8;
    #pragma unroll
    for (int d0 = 0; d0 < 4; ++d0) qf[d0] = *reinterpret_cast<const bf16x8*>(qp + d0 * 16); }
  f32x16 sc[5];
  const int nblk = Lr / 32;
  #pragma unroll
  for (int s = 0; s < 5; ++s) {
    const int kb = qi - 2 + s;
    if (kb >= 0 && kb < nblk) {
      const long tk = row0 + (long)(32 * kb + r32) * dil + r; const bf16* kp = P1 + tk * pitch + colk + hi * 8;
      bf16x8 kf[4];
      #pragma unroll
      for (int d0 = 0; d0 < 4; ++d0) kf[d0] = *reinterpret_cast<const bf16x8*>(kp + d0 * 16);
      f32x16 a = f32x16{};
      #pragma unroll
      for (int d0 = 0; d0 < 4; ++d0) a = __builtin_amdgcn_mfma_f32_32x32x16_bf16(kf[d0], qf[d0], a, 0, 0, 0);
      if (s == 0) {
        #pragma unroll
        for (int rg = 0; rg < 16; ++rg) { const int j = crow(rg, hi); if (j < r32) a[rg] = -INFINITY; } }
      if (s == 4) {
        #pragma unroll
        for (int rg = 0; rg < 16; ++rg) { const int j = crow(rg, hi); if (j > r32) a[rg] = -INFINITY; } }
      sc[s] = a;
    } else {
      #pragma unroll
      for (int rg = 0; rg < 16; ++rg) sc[s][rg] = -INFINITY;
    }
  }
  float m = -INFINITY;
  #pragma unroll
  for (int s = 0; s < 5; ++s)
    #pragma unroll
    for (int rg = 0; rg < 16; ++rg) m = __builtin_fmaxf(m, sc[s][rg]);
  { auto rr = __builtin_amdgcn_permlane32_swap(__float_as_uint(m), __float_as_uint(m), false, false); m = __builtin_fmaxf(__uint_as_float(rr[0]), __uint_as_float(rr[1])); }
  float l = 0.f;
  #pragma unroll
  for (int s = 0; s < 5; ++s)
    #pragma unroll
    for (int rg = 0; rg < 16; ++rg) { const float p = __builtin_amdgcn_exp2f(sc[s][rg] - m); sc[s][rg] = p; l += p; }
  { auto rr = __builtin_amdgcn_permlane32_swap(__float_as_uint(l), __float_as_uint(l), false, false); l = __uint_as_float(rr[0]) + __uint_as_float(rr[1]); }
  f32x16 o[2]; o[0] = f32x16{}; o[1] = f32x16{};
  const lds_cptr w3 = (lds_cptr)wlds;
  const lds_cptr vrd = w3 + ((lane >> 4) & 1) * 32 + (lane & 3) * 8 + (4 * hi + ((lane & 15) >> 2)) * 64;
  #pragma unroll
  for (int s = 0; s < 5; ++s) {
    const int kb = qi - 2 + s;
    if (kb >= 0 && kb < nblk) {
      u32x4 vv[4];
      #pragma unroll
      for (int i = 0; i < 4; ++i) { const int c = i * 64 + lane, row = c >> 3, ch = c & 7; const long tv = row0 + (long)(32 * kb + row) * dil + r;
        vv[i] = *reinterpret_cast<const u32x4*>(P1 + tv * pitch + colv + ch * 8); }
      asm volatile("s_waitcnt lgkmcnt(0)" ::: "memory");
      #pragma unroll
      for (int i = 0; i < 4; ++i) { const int c = i * 64 + lane, row = c >> 3, ch = c & 7; *(LAS u32x4*)((LAS char*)wlds + (ch >> 2) * 2048 + row * 64 + (ch & 3) * 16) = vv[i]; }
      asm volatile("s_waitcnt lgkmcnt(0)" ::: "memory");
      #pragma unroll
      for (int ks = 0; ks < 2; ++ks) {
        u32x4 pw; pw[0] = cvtpk_s(sc[s][8 * ks + 0], sc[s][8 * ks + 1]); pw[1] = cvtpk_s(sc[s][8 * ks + 2], sc[s][8 * ks + 3]); pw[2] = cvtpk_s(sc[s][8 * ks + 4], sc[s][8 * ks + 5]); pw[3] = cvtpk_s(sc[s][8 * ks + 6], sc[s][8 * ks + 7]);
        const bf16x8 pa = __builtin_bit_cast(bf16x8, pw);
        #pragma unroll
        for (int d0 = 0; d0 < 2; ++d0) {
          const s16x4 lo = vtr(vrd + d0 * 2048 + ks * 1024), hh = vtr(vrd + d0 * 2048 + ks * 1024 + 512);
          const bf16x8 vf = (bf16x8){lo[0], lo[1], lo[2], lo[3], hh[0], hh[1], hh[2], hh[3]};
          o[d0] = __builtin_amdgcn_mfma_f32_32x32x16_bf16(pa, vf, o[d0], 0, 0, 0); }
      }
    }
  }
  asm volatile("s_waitcnt lgkmcnt(0)" ::: "memory");
  float* wsf = (float*)(wlds + 4096);
  if (hi == 0) { wsf[r32] = l; const long tq = row0 + (long)(32 * qi + r32) * dil + r; lse[((long)g * NTOK + tq) * 8 + h] = m + __builtin_amdgcn_logf(l); }
  asm volatile("s_waitcnt lgkmcnt(0)" ::: "memory");
  float rli[16];
  #pragma unroll
  for (int rg = 0; rg < 16; ++rg) rli[rg] = __builtin_amdgcn_rcpf(wsf[crow(rg, hi)]);
  bf16* stg = (bf16*)wlds;
  #pragma unroll
  for (int rg = 0; rg < 16; ++rg) { const int orow = crow(rg, hi);
    #pragma unroll
    for (int d0 = 0; d0 < 2; ++d0) stg[orow * 64 + d0 * 32 + r32] = (bf16)f2bf(o[d0][rg] * rli[rg]); }
  asm volatile("s_waitcnt lgkmcnt(0)" ::: "memory");
  #pragma unroll
  for (int i = 0; i < 4; ++i) { const int row = i * 8 + (lane >> 3), ch = lane & 7; const u32x4 v = *(const u32x4*)(stg + row * 64 + ch * 8);
    const long tq = row0 + (long)(32 * qi + row) * dil + r; *(u32x4*)(const_cast<bf16*>(P1) + tq * pitch + colq + ch * 8) = v; }
  asm volatile("s_waitcnt lgkmcnt(0)" ::: "memory");
}
#undef SBAR
}

struct Args { const float* in[18]; float* out; unsigned char* ws; int ph_lo, ph_hi; };
struct Frame {
    LAS unsigned char* lds; volatile LAS unsigned* MISC; gu32* ctl;
    int tid, lane, wave, vcu, G, bx;
    unsigned char* ws;
};

__device__ __forceinline__ void transpose_item(const float* W, int K, int N, bf16_t* WT, int k0, int n0, int drow0, LAS float* scr, int lane) {
#pragma unroll 8
    for (int i = 0; i < 32; ++i) { const int kk = 2 * i + (lane >> 5); scr[kk * 33 + (lane & 31)] = W[(size_t)(k0 + kk) * N + n0 + (lane & 31)]; }
    LDS_WAIT(); asm volatile("" ::: "memory");
    const int c = lane & 7;
#pragma unroll
    for (int j = 0; j < 4; ++j) { const int n = (lane >> 3) + 8 * j; const LAS float* s = scr + (8 * c) * 33 + n;
        u32x4 o; o.x = pk2(s[0 * 33], s[1 * 33]); o.y = pk2(s[2 * 33], s[3 * 33]); o.z = pk2(s[4 * 33], s[5 * 33]); o.w = pk2(s[6 * 33], s[7 * 33]);
        *(GAS u32x4*)(WT + (size_t)(drow0 + n) * K + k0 + 8 * c) = o; }
    LDS_WAIT(); asm volatile("" ::: "memory");
}
__device__ __forceinline__ void transpose_plain(const float* W, int K, int N, bf16_t* WT, int item, LAS float* scr, int lane) {
    const int nblk = N / 32, kb = item / nblk, nb = item % nblk; transpose_item(W, K, N, WT, 64 * kb, 32 * nb, 32 * nb, scr, lane);
}
__device__ __forceinline__ void moe_weight_items(Frame& F, const float* wg, const float* wu, const float* wd, int layer, LAS float* scr) {
    bf16_t* WGU = (bf16_t*)(F.ws + WS_WGU); bf16_t* WD = (bf16_t*)(F.ws + WS_WD);
    const int gw = F.vcu * NWAVES + F.wave, NGW = F.G * NWAVES;
    for (int it = gw; it < 48 * 256; it += NGW) {
        const int job = it >> 8, loc = it & 255, e = job / 3, kind = job % 3;
        if (kind < 2) { const float* W = (kind == 0 ? wg : wu) + ((size_t)layer * NEXP + e) * DM * DEXP;
            const int kb = loc >> 4, nb = loc & 15, n0 = 32 * nb; const int drow0 = 256 * (n0 >> 7) + (n0 & 127) + (kind ? 128 : 0);
            transpose_item(W, DM, DEXP, WGU + (size_t)e * 1024 * DM, 64 * kb, n0, drow0, scr, F.lane);
        } else { const float* W = wd + ((size_t)layer * NEXP + e) * DEXP * DM;
            const int kb = loc >> 5, nb = loc & 31; transpose_item(W, DEXP, DM, WD + (size_t)e * DM * DEXP, 64 * kb, 32 * nb, 32 * nb, scr, F.lane); }
    }
}
__device__ __forceinline__ void cvt_rows_bf16(Frame& F, const float* src, bf16_t* dst, size_t n) {
    const size_t gt = (size_t)(F.vcu * NWAVES + F.wave) * 64 + F.lane, NT_ = (size_t)F.G * NWAVES * 64;
    for (size_t i = gt; i < n / 8; i += NT_) { const f32x4 a = *(const GAS f32x4*)(src + i * 8), b = *(const GAS f32x4*)(src + i * 8 + 4);
        u32x4 o; o.x = pk2(a.x, a.y); o.y = pk2(a.z, a.w); o.z = pk2(b.x, b.y); o.w = pk2(b.z, b.w); *(GAS u32x4*)(dst + i * 8) = o; }
}

__device__ __forceinline__ int sel4i(int k, int a0, int a1, int a2, int a3) { return k == 0 ? a0 : (k == 1 ? a1 : (k == 2 ? a2 : a3)); }
__device__ __forceinline__ float sel4f(int k, float a0, float a1, float a2, float a3) { return k == 0 ? a0 : (k == 1 ? a1 : (k == 2 ? a2 : a3)); }

__device__ __forceinline__ void ln1_router_phase(Frame& F, float* zx, const float* lng, const float* lnb, const float* rw, const float* rb, int layer) {
    LAS f32x4* rwl = (LAS f32x4*)(F.lds + RING_OFF);
    LAS int* lcnt = (LAS int*)(F.lds + RING_OFF + 65536);
    LAS int* lbase = lcnt + 16;
    LAS int* rec = lcnt + 64;
    LAS float* recw = (LAS float*)(rec + 256);
    for (int idx = F.tid; idx < 4096; idx += 512) { const int l = idx & 63, qd = (idx >> 6) & 3, c = (idx >> 8) & 3, j = idx >> 10; const int k = 4 * l + c + 256 * j;
        rwl[idx] = *(const GAS f32x4*)(rw + k * 16 + 4 * qd); }
    if (F.tid < 16) lcnt[F.tid] = 0;
    __syncthreads();
    bf16_t* XB = (bf16_t*)(F.ws + WS_XB);
    const int lane = F.lane;
    f32x4 gv[4], bv[4];
#pragma unroll
    for (int j = 0; j < 4; ++j) { gv[j] = *(const GAS f32x4*)(lng + 4 * lane + 256 * j); bv[j] = *(const GAS f32x4*)(lnb + 4 * lane + 256 * j); }
    float rbv[16];
#pragma unroll
    for (int e = 0; e < 16; ++e) rbv[e] = rb[e];
    for (int i = 0; i < 8; ++i) {
        const int lrow = F.wave * 8 + i; const int row = F.vcu * 64 + lrow;
        float* zr = zx + (size_t)row * DM;
        f32x4 v[4]; float s = 0.f;
#pragma unroll
        for (int j = 0; j < 4; ++j) { v[j] = *(const GAS f32x4*)(zr + 4 * lane + 256 * j); s += (v[j].x + v[j].y) + (v[j].z + v[j].w); }
        const float mean = wave_sum(s) * (1.f / DM); float s2 = 0.f;
#pragma unroll
        for (int j = 0; j < 4; ++j) { v[j] = v[j] - mean; s2 += (v[j].x * v[j].x + v[j].y * v[j].y) + (v[j].z * v[j].z + v[j].w * v[j].w); }
        const float rstd = __builtin_amdgcn_rsqf(wave_sum(s2) * (1.f / DM) + NORM_EPS);
#pragma unroll
        for (int j = 0; j < 4; ++j) { v[j] = v[j] * rstd * gv[j] + bv[j];
            *(GAS f32x4*)(zr + 4 * lane + 256 * j) = v[j];
            u32x2 o; o.x = pk2(v[j].x, v[j].y); o.y = pk2(v[j].z, v[j].w); *(GAS u32x2*)(XB + (size_t)row * DM + 4 * lane + 256 * j) = o; }
        float p[16];
#pragma unroll
        for (int e = 0; e < 16; ++e) p[e] = 0.f;
#pragma unroll
        for (int j = 0; j < 4; ++j)
#pragma unroll
            for (int c = 0; c < 4; ++c) { const float xv = v[j][c];
#pragma unroll
                for (int qd = 0; qd < 4; ++qd) { const f32x4 w = rwl[((j * 4 + c) * 4 + qd) * 64 + lane];
                    p[4 * qd + 0] += xv * w.x; p[4 * qd + 1] += xv * w.y; p[4 * qd + 2] += xv * w.z; p[4 * qd + 3] += xv * w.w; } }
        const int b5 = (lane >> 5) & 1, b4 = (lane >> 4) & 1, b3 = (lane >> 3) & 1, b2 = (lane >> 2) & 1;
        float q8[8], q4[4], q2[2], q1;
#pragma unroll
        for (int k = 0; k < 8; ++k) { const float keep = b5 ? p[8 + k] : p[k], send = b5 ? p[k] : p[8 + k]; q8[k] = keep + __shfl_xor(send, 32); }
#pragma unroll
        for (int k = 0; k < 4; ++k) { const float keep = b4 ? q8[4 + k] : q8[k], send = b4 ? q8[k] : q8[4 + k]; q4[k] = keep + __shfl_xor(send, 16); }
#pragma unroll
        for (int k = 0; k < 2; ++k) { const float keep = b3 ? q4[2 + k] : q4[k], send = b3 ? q4[k] : q4[2 + k]; q2[k] = keep + __shfl_xor(send, 8); }
        { const float keep = b2 ? q2[1] : q2[0], send = b2 ? q2[0] : q2[1]; q1 = keep + __shfl_xor(send, 4); }
        q1 += __shfl_xor(q1, 1); q1 += __shfl_xor(q1, 2);
        float aff[16], sel[16];
#pragma unroll
        for (int e = 0; e < 16; ++e) { const int src = ((e >> 3) & 1) * 32 + ((e >> 2) & 1) * 16 + ((e >> 1) & 1) * 8 + (e & 1) * 4;
            const float lg = __builtin_bit_cast(float, __builtin_amdgcn_readlane(__builtin_bit_cast(int, q1), src));
            aff[e] = 1.f / (1.f + __expf(-lg)); sel[e] = aff[e] + rbv[e]; }
        float gs[4];
#pragma unroll
        for (int g = 0; g < 4; ++g) { const float a = sel[4 * g], b = sel[4 * g + 1], c = sel[4 * g + 2], d = sel[4 * g + 3];
            const float mx1 = fmaxf(fmaxf(a, b), fmaxf(c, d));
            const float mn_ab = fminf(a, b), mx_ab = fmaxf(a, b), mn_cd = fminf(c, d), mx_cd = fmaxf(c, d);
            const float second = fmaxf(fminf(mx_ab, mx_cd), fmaxf(mn_ab, mn_cd));
            gs[g] = mx1 + second; }
        int best = 0; float bsc = gs[0];
#pragma unroll
        for (int g = 1; g < 4; ++g) if (gs[g] > bsc) { bsc = gs[g]; best = g; }
        const float s0 = sel4f(best, sel[0], sel[4], sel[8], sel[12]), s1 = sel4f(best, sel[1], sel[5], sel[9], sel[13]), s2_ = sel4f(best, sel[2], sel[6], sel[10], sel[14]), s3 = sel4f(best, sel[3], sel[7], sel[11], sel[15]);
        const float a0 = sel4f(best, aff[0], aff[4], aff[8], aff[12]), a1 = sel4f(best, aff[1], aff[5], aff[9], aff[13]), a2 = sel4f(best, aff[2], aff[6], aff[10], aff[14]), a3 = sel4f(best, aff[3], aff[7], aff[11], aff[15]);
        int i0 = 0; float m0 = s0; if (s1 > m0) { m0 = s1; i0 = 1; } if (s2_ > m0) { m0 = s2_; i0 = 2; } if (s3 > m0) { m0 = s3; i0 = 3; }
        int i1 = -1; float m1 = -INFINITY;
        if (i0 != 0 && s0 > m1) { m1 = s0; i1 = 0; } if (i0 != 1 && s1 > m1) { m1 = s1; i1 = 1; } if (i0 != 2 && s2_ > m1) { m1 = s2_; i1 = 2; } if (i0 != 3 && s3 > m1) { m1 = s3; i1 = 3; }
        const float w0r = sel4f(i0, a0, a1, a2, a3), w1r = sel4f(i1, a0, a1, a2, a3); const float inv = 1.f / (w0r + w1r);
        if (lane == 0) { const int e0 = 4 * best + i0, e1 = 4 * best + i1;
            const int r0 = __hip_atomic_fetch_add(lcnt + e0, 1, __ATOMIC_RELAXED, __HIP_MEMORY_SCOPE_WORKGROUP), r1 = __hip_atomic_fetch_add(lcnt + e1, 1, __ATOMIC_RELAXED, __HIP_MEMORY_SCOPE_WORKGROUP);
            rec[lrow * 4 + 0] = e0; rec[lrow * 4 + 1] = e1; rec[lrow * 4 + 2] = r0; rec[lrow * 4 + 3] = r1; recw[lrow * 2 + 0] = w0r * inv; recw[lrow * 2 + 1] = w1r * inv; }
    }
    __syncthreads();
    if (F.tid < 16) { const int n = lcnt[F.tid]; lbase[F.tid] = n ? (int)__hip_atomic_fetch_add((unsigned*)(F.ctl + CW_CNT + (layer * 16 + F.tid) * 64), (unsigned)n, RLX_AGENT) : 0; }
    __syncthreads();
    if (F.tid < 128) { const int lrow = F.tid >> 1, sl = F.tid & 1; const int e = rec[lrow * 4 + sl], rk = rec[lrow * 4 + 2 + sl]; const int pos = lbase[e] + rk; const int row = F.vcu * 64 + lrow;
        int* rowmap = (int*)(F.ws + WS_ROWMAP); float* roww = (float*)(F.ws + WS_ROWW);
        rowmap[(size_t)e * RCAP + pos] = row * 2 + sl; roww[(size_t)e * RCAP + pos] = recw[lrow * 2 + sl]; }
    __syncthreads();
}

__device__ __forceinline__ void ln2_phase(Frame& F, float* xio, const float* lng, const float* lnb, bool write_bf) {
    const bf16_t* Y = (const bf16_t*)(F.ws + WS_Y); bf16_t* XB = (bf16_t*)(F.ws + WS_XB);
    const int lane = F.lane;
    f32x4 gv[4], bv[4];
#pragma unroll
    for (int j = 0; j < 4; ++j) { gv[j] = *(const GAS f32x4*)(lng + 4 * lane + 256 * j); bv[j] = *(const GAS f32x4*)(lnb + 4 * lane + 256 * j); }
    for (int i = 0; i < 8; ++i) {
        const int row = F.vcu * 64 + F.wave * 8 + i;
        float* xr = xio + (size_t)row * DM;
        f32x4 v[4]; float s = 0.f;
#pragma unroll
        for (int j = 0; j < 4; ++j) { const f32x4 x = *(const GAS f32x4*)(xr + 4 * lane + 256 * j);
            const u32x2 y0 = *(const GAS u32x2*)(Y + (size_t)row * DM + 4 * lane + 256 * j), y1 = *(const GAS u32x2*)(Y + ((size_t)NTOK + row) * DM + 4 * lane + 256 * j);
            v[j].x = x.x * ALPHA + (bflo(y0.x) + bflo(y1.x)); v[j].y = x.y * ALPHA + (bfhi(y0.x) + bfhi(y1.x)); v[j].z = x.z * ALPHA + (bflo(y0.y) + bflo(y1.y)); v[j].w = x.w * ALPHA + (bfhi(y0.y) + bfhi(y1.y));
            s += (v[j].x + v[j].y) + (v[j].z + v[j].w); }
        const float mean = wave_sum(s) * (1.f / DM); float s2 = 0.f;
#pragma unroll
        for (int j = 0; j < 4; ++j) { v[j] = v[j] - mean; s2 += (v[j].x * v[j].x + v[j].y * v[j].y) + (v[j].z * v[j].z + v[j].w * v[j].w); }
        const float rstd = __builtin_amdgcn_rsqf(wave_sum(s2) * (1.f / DM) + NORM_EPS);
#pragma unroll
        for (int j = 0; j < 4; ++j) { v[j] = v[j] * rstd * gv[j] + bv[j];
            *(GAS f32x4*)(xr + 4 * lane + 256 * j) = v[j];
            if (write_bf) { u32x2 o; o.x = pk2(v[j].x, v[j].y); o.y = pk2(v[j].z, v[j].w); *(GAS u32x2*)(XB + (size_t)row * DM + 4 * lane + 256 * j) = o; } }
    }
}

__device__ __forceinline__ void rope0_phase(Frame& F, const float* qn, const float* kn) {
    bf16_t* P0 = (bf16_t*)(F.ws + WS_BIG); const float* tab = (const float*)(F.ws + WS_TAB);
    const int lane = F.lane, head = lane >> 2, qd = lane & 3;
    const float* gn = (head < 12 ? qn : kn) + (qd * 16);
    float gnv[16];
#pragma unroll
    for (int d = 0; d < 16; ++d) gnv[d] = gn[d];
    const float osc = head < 12 ? C2 : 1.f;
    for (int i = 0; i < 8; ++i) {
        const int row = F.vcu * 64 + F.wave * 8 + i; const int t = row & (SEQ - 1);
        bf16_t* p = P0 + (size_t)row * A_IN + head * 64 + qd * 16;
        const u32x4 w0 = *(const GAS u32x4*)p, w1 = *(const GAS u32x4*)(p + 8);
        float x[16];
        x[0] = bflo(w0.x); x[1] = bfhi(w0.x); x[2] = bflo(w0.y); x[3] = bfhi(w0.y); x[4] = bflo(w0.z); x[5] = bfhi(w0.z); x[6] = bflo(w0.w); x[7] = bfhi(w0.w);
        x[8] = bflo(w1.x); x[9] = bfhi(w1.x); x[10] = bflo(w1.y); x[11] = bfhi(w1.y); x[12] = bflo(w1.z); x[13] = bfhi(w1.z); x[14] = bflo(w1.w); x[15] = bfhi(w1.w);
        float ss = 0.f;
#pragma unroll
        for (int d = 0; d < 16; ++d) ss += x[d] * x[d];
        ss += __shfl_xor(ss, 1); ss += __shfl_xor(ss, 2);
        const float rs = __builtin_amdgcn_rsqf(ss * (1.f / 64.f) + NORM_EPS);
        const float* ct = (qd < 2) ? tab + TB_ROWC + (t >> 6) * 16 : tab + TB_COLC + (t & 63) * 16;
        const float* st = (qd < 2) ? tab + TB_ROWS + (t >> 6) * 16 : tab + TB_COLS + (t & 63) * 16;
        float y[16];
#pragma unroll
        for (int d = 0; d < 16; ++d) { const float xn = x[d] * rs * gnv[d]; const float xp = __shfl_xor(xn, 1);
            const float c = ct[d], sn = st[d];
            y[d] = ((qd & 1) ? (xn * c + xp * sn) : (xn * c - xp * sn)) * osc; }
        u32x4 o0, o1;
        o0.x = pk2(y[0], y[1]); o0.y = pk2(y[2], y[3]); o0.z = pk2(y[4], y[5]); o0.w = pk2(y[6], y[7]); o1.x = pk2(y[8], y[9]); o1.y = pk2(y[10], y[11]); o1.z = pk2(y[12], y[13]); o1.w = pk2(y[14], y[15]);
        *(GAS u32x4*)p = o0; *(GAS u32x4*)(p + 8) = o1;
    }
}
__device__ __forceinline__ void rope1_phase(Frame& F) {
    bf16_t* P1 = (bf16_t*)(F.ws + WS_BIG); const float* tab = (const float*)(F.ws + WS_TAB);
    const int lane = F.lane;
    for (int i = 0; i < 8; ++i) {
        const int row = F.vcu * 64 + F.wave * 8 + i; const int t = row & (SEQ - 1);
        if (lane < 48) {
            bf16_t* p = P1 + (size_t)row * B_IN + lane * 64;
            const u32x4 w0 = *(const GAS u32x4*)p, w1 = *(const GAS u32x4*)(p + 8);
            float x1[8], x2[8];
            x1[0] = bflo(w0.x); x1[1] = bfhi(w0.x); x1[2] = bflo(w0.y); x1[3] = bfhi(w0.y); x1[4] = bflo(w0.z); x1[5] = bfhi(w0.z); x1[6] = bflo(w0.w); x1[7] = bfhi(w0.w);
            x2[0] = bflo(w1.x); x2[1] = bfhi(w1.x); x2[2] = bflo(w1.y); x2[3] = bfhi(w1.y); x2[4] = bflo(w1.z); x2[5] = bfhi(w1.z); x2[6] = bflo(w1.w); x2[7] = bfhi(w1.w);
            const float* ct = tab + TB_PC + t * 8; const float* st = tab + TB_PS + t * 8;
            float y1[8], y2[8];
#pragma unroll
            for (int d = 0; d < 8; ++d) { const float c = ct[d], sn = st[d]; y1[d] = x1[d] * c - x2[d] * sn; y2[d] = x2[d] * c + x1[d] * sn; }
            u32x4 o0, o1;
            o0.x = pk2(y1[0], y1[1]); o0.y = pk2(y1[2], y1[3]); o0.z = pk2(y1[4], y1[5]); o0.w = pk2(y1[6], y1[7]); o1.x = pk2(y2[0], y2[1]); o1.y = pk2(y2[2], y2[3]); o1.z = pk2(y2[4], y2[5]); o1.w = pk2(y2[6], y2[7]);
            *(GAS u32x4*)p = o0; *(GAS u32x4*)(p + 8) = o1;
        }
    }
}
__device__ __forceinline__ void merge_phase(Frame& F) {
    const bf16_t* P1 = (const bf16_t*)(F.ws + WS_BIG); const float* lse = (const float*)(F.ws + WS_LSE); bf16_t* ATT = (bf16_t*)(F.ws + WS_ATT);
    const int lane = F.lane, h = lane >> 3, dd = (lane & 7) * 8;
    for (int i = 0; i < 8; ++i) {
        const int row = F.vcu * 64 + F.wave * 8 + i;
        float l0 = lse[((size_t)0 * NTOK + row) * 8 + h], l1 = lse[((size_t)1 * NTOK + row) * 8 + h], l2 = lse[((size_t)2 * NTOK + row) * 8 + h];
        const float mx = fmaxf(l0, fmaxf(l1, l2)); float w0 = __builtin_amdgcn_exp2f(l0 - mx), w1 = __builtin_amdgcn_exp2f(l1 - mx), w2 = __builtin_amdgcn_exp2f(l2 - mx);
        const float inv = 1.f / (w0 + w1 + w2); w0 *= inv; w1 *= inv; w2 *= inv;
        const bf16_t* p = P1 + (size_t)row * B_IN + h * 64 + dd;
        const u32x4 a = *(const GAS u32x4*)p, b = *(const GAS u32x4*)(p + 512), c = *(const GAS u32x4*)(p + 1024);
        u32x4 o;
        o.x = pk2(w0 * bflo(a.x) + w1 * bflo(b.x) + w2 * bflo(c.x), w0 * bfhi(a.x) + w1 * bfhi(b.x) + w2 * bfhi(c.x));
        o.y = pk2(w0 * bflo(a.y) + w1 * bflo(b.y) + w2 * bflo(c.y), w0 * bfhi(a.y) + w1 * bfhi(b.y) + w2 * bfhi(c.y));
        o.z = pk2(w0 * bflo(a.z) + w1 * bflo(b.z) + w2 * bflo(c.z), w0 * bfhi(a.z) + w1 * bfhi(b.z) + w2 * bfhi(c.z));
        o.w = pk2(w0 * bflo(a.w) + w1 * bflo(b.w) + w2 * bflo(c.w), w0 * bfhi(a.w) + w1 * bfhi(b.w) + w2 * bfhi(c.w));
        *(GAS u32x4*)(ATT + (size_t)row * 768 + h * 64 + dd) = o;
    }
}

constexpr int N_PHASES = 19;
__global__ void __launch_bounds__(NWAVES * 64, 2) mega_fwd(Args args) {
    extern __shared__ __attribute__((aligned(16))) unsigned char lds[];
    Frame F;
    F.lds = (LAS unsigned char*)lds; F.MISC = (volatile LAS unsigned*)(F.lds + MISC_OFF);
    F.tid = threadIdx.x; F.lane = F.tid & 63; F.wave = __builtin_amdgcn_readfirstlane(F.tid >> 6);
    F.G = gridDim.x; { const int bx = blockIdx.x; F.vcu = (F.G % 8 == 0) ? (bx % 8) * (F.G / 8) + bx / 8 : bx; }
    F.ws = args.ws; F.ctl = (gu32*)(args.ws + WS_CTL);
    for (int u = F.tid; u < (LDS_BYTES - LDSCTL_OFF) / 4; u += NWAVES * 64) ((LAS unsigned*)(F.lds + LDSCTL_OFF))[u] = 0u;
    __syncthreads();
    { const int lo0 = args.ph_lo, hi0 = args.ph_hi; if (hi0 - lo0 > 1) (void)xcd_barrier_post((unsigned*)(F.ctl + CW_BAR), F.MISC + 8); }
#define KA_INT(off) (*(const int CAS*)((const CAS unsigned char*)__builtin_amdgcn_kernarg_segment_ptr() + (off)))
#define IN(k) (KA_INT(160) <= (k) && (k) < KA_INT(164))
#define SEAM(k) do { if (IN(k) && IN((k) + 1)) { XcdBarrier bar_; bar_.bar = (unsigned*)(*(unsigned char* const CAS*)((const CAS unsigned char*)__builtin_amdgcn_kernarg_segment_ptr() + 152) + WS_CTL) + CW_BAR; \
        bar_.x = xb_xcc_id(); bar_.st = (volatile LAS unsigned*)((LAS unsigned char*)lds + MISC_OFF) + 8; xcd_barrier(bar_); } } while (0)
#define AIN(i) (*(const float* const CAS*)(ka_ + 8 * (i)))
#define PHASE_FRAME() \
    const CAS unsigned char* ka_ = (const CAS unsigned char*)__builtin_amdgcn_kernarg_segment_ptr(); asm volatile("" : "+s"(ka_)); \
    Frame P; unsigned P_l0 = 0u; { unsigned char* w_ = *(unsigned char* const CAS*)(ka_ + 152); asm volatile("" : "+s"(P_l0)); int t_ = threadIdx.x; asm volatile("" : "+v"(t_)); \
      P.ws = w_; P.ctl = (gu32*)(w_ + WS_CTL); P.lds = (LAS unsigned char*)lds + P_l0; P.MISC = (volatile LAS unsigned*)(P.lds + MISC_OFF); \
      P.tid = t_; P.lane = t_ & 63; P.wave = __builtin_amdgcn_readfirstlane(t_ >> 6); P.G = gridDim.x; { int bx = blockIdx.x; asm volatile("" : "+s"(bx)); P.bx = bx; P.vcu = (P.G % 8 == 0) ? (bx % 8) * (P.G / 8) + bx / 8 : bx; } } \
    const float* x_in = AIN(0); float* out = *(float* const CAS*)(ka_ + 144); \
    bf16_t* XB = (bf16_t*)(P.ws + WS_XB); bf16_t* ATT = (bf16_t*)(P.ws + WS_ATT); bf16_t* BIG = (bf16_t*)(P.ws + WS_BIG); \
    bf16_t* MKV = (bf16_t*)(P.ws + WS_MKV); bf16_t* MEMB = (bf16_t*)(P.ws + WS_MEMB); \
    int* rowmap = (int*)(P.ws + WS_ROWMAP); float* roww = (float*)(P.ws + WS_ROWW); \
    LAS int* tpre = (LAS int*)(P.lds + SCHED_OFF); \
    (void)x_in; (void)out; (void)XB; (void)ATT; (void)BIG; (void)MKV; (void)MEMB; (void)rowmap; (void)roww; (void)tpre

    if (IN(0)) { PHASE_FRAME();
        LAS float* scr = (LAS float*)(P.lds + RING_OFF + P.wave * 16384);
        const int gw = P.vcu * NWAVES + P.wave, NGW = P.G * NWAVES;
        constexpr int I_MKV = 16 * 16, I_AIN = 16 * 48, I_AOUT = 16 * 32, I_BIN = 16 * 152, I_BOUT = 12 * 32, NIT = I_MKV + I_AIN + I_AOUT + I_BIN + I_BOUT;
        for (int it = gw; it < NIT; it += NGW) {
            int r = it;
            if (r < I_MKV) { transpose_plain(AIN(2), DM, 512, (bf16_t*)(P.ws + WS_WMKV), r, scr, P.lane); continue; } r -= I_MKV;
            if (r < I_AIN) { transpose_plain(AIN(5), DM, A_IN, (bf16_t*)(P.ws + WS_WAIN), r, scr, P.lane); continue; } r -= I_AIN;
            if (r < I_AOUT) { transpose_plain(AIN(6), DM, DM, (bf16_t*)(P.ws + WS_WAOUT), r, scr, P.lane); continue; } r -= I_AOUT;
            if (r < I_BIN) { transpose_plain(AIN(9), DM, B_IN, (bf16_t*)(P.ws + WS_WBIN), r, scr, P.lane); continue; } r -= I_BIN;
            transpose_plain(AIN(10), 768, DM, (bf16_t*)(P.ws + WS_WBOUT), r, scr, P.lane);
        }
        moe_weight_items(P, AIN(15), AIN(16), AIN(17), 0, scr);
        cvt_rows_bf16(P, x_in, XB, (size_t)NTOK * DM);
        cvt_rows_bf16(P, AIN(1), MEMB, (size_t)NB * NMEM * DM);
        { float* tab = (float*)(P.ws + WS_TAB); const int gt = gw * 64 + P.lane, NT_ = NGW * 64;
          for (int idx = gt; idx < 32 * 16 + 64 * 16 + 2048 * 8; idx += NT_) {
              int p, i, oc, os; float l2t, den;
              if (idx < 512) { p = idx >> 4; i = idx & 15; oc = TB_ROWC + idx; os = TB_ROWS + idx; l2t = 13.287712379549449f; den = 32.f; }
              else if (idx < 512 + 1024) { const int k = idx - 512; p = k >> 4; i = k & 15; oc = TB_COLC + k; os = TB_COLS + k; l2t = 13.287712379549449f; den = 32.f; }
              else { const int k = idx - 1536; p = k >> 3; i = k & 7; oc = TB_PC + k; os = TB_PS + k; l2t = 18.931568569324174f; den = 16.f; }
              const float inv = 1.0f / __builtin_amdgcn_exp2f(l2t * ((float)(2 * i) / den));
              const float ang = (float)p * inv;
              const double rev = (double)ang * 0.15915494309189535;
              const float fr = (float)(rev - __builtin_rint(rev));
              tab[oc] = __builtin_amdgcn_cosf(fr); tab[os] = __builtin_amdgcn_sinf(fr);
          } }
    }
    SEAM(0);

    for (int L = 0; L < 2; ++L) {
        const int pb = 1 + 9 * L;
        if (IN(pb)) { PHASE_FRAME();
            pg8::DenseSched S;
            if (L == 0) S.init(XB, P.ws + WS_WAIN, NTOK, A_IN, DM, MEMB, P.ws + WS_WMKV, NB * NMEM, 512, P.G, P.bx);
            else        S.init(XB, P.ws + WS_WBIN, NTOK, B_IN, DM, nullptr, nullptr, 0, 0, P.G, P.bx);
            pg8::EpiProj E{BIG, L == 0 ? A_IN : B_IN, L == 0 ? (1u << 5) : (0x3Fu | (1u << 18)), C2, MKV, 512};
            pg8::gemm_phase<pg8::EpiProj, pg8::DenseSched, false, DM>(P.lds + RING_OFF, S, E, P.tid);
        }
        SEAM(pb);
        if (IN(pb + 1)) { PHASE_FRAME(); if (L == 0) rope0_phase(P, AIN(7), AIN(8)); else rope1_phase(P); }
        SEAM(pb + 1);
        if (IN(pb + 2)) { PHASE_FRAME();
            char* shm = (char*)lds + P_l0 + RING_OFF;
            if (L == 0) {
                const int v = P.vcu; const int pair = v >> 3, qb = v & 7, b = pair >> 2, kvh = pair & 3;
                const bf16_t* base = BIG + (size_t)b * SEQ * A_IN;
#pragma unroll 1
                for (int i = 0; i < 3; ++i) { const int hq = kvh * 3 + i;
                    attn_body::attn_unit<8, A_IN, A_IN, A_IN, DM, SEQ / 64>(base + hq * 64, base + 768 + kvh * 64, base + 1024 + kvh * 64, ATT + (size_t)b * SEQ * DM + hq * 64, qb * 256, shm, P.tid); }
                { const int mb = v >> 5, mh = (v >> 3) & 3; const bf16_t* qb_ = BIG + (size_t)mb * SEQ * A_IN + 1280 + mh * 64; const bf16_t* mk = MKV + (size_t)mb * NMEM * 512 + mh * 64;
                  attn_body::attn_unit<8, A_IN, 512, 512, DM, NMEM / 64>(qb_, mk, mk + 256, ATT + (size_t)mb * SEQ * DM + 768 + mh * 64, qb * 256, shm, P.tid); }
            } else {
                { const int v = P.vcu; const int qb = v & 7, mb = v >> 5, mh = (v >> 3) & 3; const bf16_t* qb_ = BIG + (size_t)mb * SEQ * B_IN + 4608 + mh * 64; const bf16_t* mk = MKV + (size_t)mb * NMEM * 512 + mh * 64;
                  attn_body::attn_unit<8, B_IN, 512, 512, 768, NMEM / 64>(qb_, mk, mk + 256, ATT + (size_t)mb * SEQ * 768 + 512 + mh * 64, qb * 256, shm, P.tid); }
                __syncthreads();
                float* lse = (float*)(P.ws + WS_LSE);
                char* wl = shm + P.wave * 8192;
                const int gw = P.vcu * NWAVES + P.wave, NGW = P.G * NWAVES;
                for (int it = gw; it < NB * 3 * 8 * 64; it += NGW) {
                    const int k = it & 63, bgh = it >> 6, h = bgh & 7, bg = bgh >> 3, g = bg % 3, b = bg / 3;
                    const int dil = (g == 0) ? 1 : (g == 1 ? 4 : 16), Lr = SEQ / dil, nb = Lr / 32; const int r = k / nb, qi = k % nb;
                    attn_body::band_item(BIG, lse, b, g, h, r, qi, dil, Lr, wl, P.lane);
                }
            }
        }
        SEAM(pb + 2);
        if (L == 1) { if (IN(pb + 3)) { PHASE_FRAME(); merge_phase(P); } SEAM(pb + 3); }
        if (IN(pb + 4)) { PHASE_FRAME();
            pg8::DenseSched S;
            if (L == 0) S.init(ATT, P.ws + WS_WAOUT, NTOK, DM, DM, nullptr, nullptr, 0, 0, P.G, P.bx);
            else        S.init(ATT, P.ws + WS_WBOUT, NTOK, DM, 768, nullptr, nullptr, 0, 0, P.G, P.bx);
            pg8::EpiZ E{L == 0 ? x_in : out, out};
            if (L == 0) pg8::gemm_phase<pg8::EpiZ, pg8::DenseSched, false, DM>(P.lds + RING_OFF, S, E, P.tid); else pg8::gemm_phase<pg8::EpiZ, pg8::DenseSched, false, 768>(P.lds + RING_OFF, S, E, P.tid);
        }
        SEAM(pb + 4);
        if (IN(pb + 5)) { PHASE_FRAME(); ln1_router_phase(P, out, AIN(11) + L * DM, AIN(12) + L * DM, AIN(3), AIN(4), L); }
        SEAM(pb + 5);
        if (IN(pb + 6) || IN(pb + 7)) { PHASE_FRAME();
            if (P.tid == 0) { int acc = 0;
                for (int e = 0; e < 16; ++e) { const int c = (int)__hip_atomic_load(P.ctl + CW_CNT + (L * 16 + e) * 64, RLX_AGENT); tpre[e] = acc; tpre[32 + e] = c; acc += (c + 255) >> 8; }
                tpre[16] = acc; }
            __syncthreads();
        }
        if (IN(pb + 6)) { PHASE_FRAME();
            pg8::MoeSched S{(const char*)XB, (const char*)(P.ws + WS_WGU), DM, (size_t)1024 * DM * 2, tpre, rowmap, P.G, P.bx, true};
            pg8::EpiGU E{(bf16_t*)(P.ws + WS_H)};
            pg8::gemm_phase<pg8::EpiGU, pg8::MoeSched, true, DM>(P.lds + RING_OFF, S, E, P.tid);
        }
        SEAM(pb + 6);
        if (IN(pb + 7)) { PHASE_FRAME();
            pg8::MoeSched S{(const char*)(P.ws + WS_H), (const char*)(P.ws + WS_WD), DEXP, (size_t)DM * DEXP * 2, tpre, rowmap, P.G, P.bx, false};
            pg8::EpiDown E{(bf16_t*)(P.ws + WS_Y), rowmap, roww};
            pg8::gemm_phase<pg8::EpiDown, pg8::MoeSched, false, DEXP>(P.lds + RING_OFF, S, E, P.tid);
        }
        SEAM(pb + 7);
        if (IN(pb + 8)) { PHASE_FRAME();
            ln2_phase(P, out, AIN(13) + L * DM, AIN(14) + L * DM, L == 0);
            if (L == 0) { LAS float* scr = (LAS float*)(P.lds + RING_OFF + P.wave * 16384); moe_weight_items(P, AIN(15), AIN(16), AIN(17), 1, scr); }
        }
        if (L == 0) SEAM(pb + 8);
    }
#undef IN
#undef SEAM
#undef PHASE_FRAME
#undef AIN
#undef KA_INT
}

extern "C" void kernel_launch(void* const* d_in, const int* in_sizes, int n_in, void* d_out, int out_size, void* d_ws, size_t ws_size, hipStream_t stream) {
    static int grid = 0;
    if (grid == 0) {
        if (n_in != 18 || out_size != NTOK * DM || ws_size < WS_END) { fprintf(stderr, "kernel_launch: unexpected shapes (n_in %d, out %d, ws %zu < %zu)\n", n_in, out_size, ws_size, (size_t)WS_END); grid = -1; return; }
        int dev = 0, cus = 0, per_cu = 0;
        if (hipGetDevice(&dev) != hipSuccess || hipDeviceGetAttribute(&cus, hipDeviceAttributeMultiprocessorCount, dev) != hipSuccess) { grid = -1; return; }
        if (hipFuncSetAttribute((const void*)mega_fwd, hipFuncAttributeMaxDynamicSharedMemorySize, LDS_BYTES) != hipSuccess) { fprintf(stderr, "kernel_launch: hipFuncSetAttribute failed\n"); grid = -1; return; }
        if (hipOccupancyMaxActiveBlocksPerMultiprocessor(&per_cu, (const void*)mega_fwd, NWAVES * 64, LDS_BYTES) != hipSuccess || per_cu < 1) { fprintf(stderr, "kernel_launch: occupancy query says %d\n", per_cu); }
        (void)hipGetLastError();
        grid = cus;
        if (grid != 256) fprintf(stderr, "kernel_launch: %d CUs (built for 256)\n", grid);
    }
    if (grid < 0) return;
    (void)hipMemsetAsync((char*)d_ws + WS_CTL, 0, CTL_ZERO_BYTES, stream);
    Args a{};
    for (int i = 0; i < 18; ++i) a.in[i] = (const float*)d_in[i];
    a.out = (float*)d_out; a.ws = (unsigned char*)d_ws;
#if MK_ONE_LAUNCH
    a.ph_lo = 0; a.ph_hi = N_PHASES;
    hipLaunchKernelGGL(mega_fwd, dim3(grid), dim3(NWAVES * 64), LDS_BYTES, stream, a);
#else
    for (int p = 0; p < N_PHASES; ++p) {
        if (p == 4) continue;
        a.ph_lo = p; a.ph_hi = p + 1;
        hipLaunchKernelGGL(mega_fwd, dim3(grid), dim3(NWAVES * 64), LDS_BYTES, stream, a);
    }
#endif
}
```

```cpp
#include <hip/hip_runtime.h>
#include <cstdio>
#include <cstdint>

#ifndef MK_ONE_LAUNCH
#define MK_ONE_LAUNCH 1
#endif

#ifndef REP_K
#define REP_K -1
#endif
#ifndef PROBE_K
#define PROBE_K -1
#endif
#ifndef PROBE_K2
#define PROBE_K2 (PROBE_K + 1)
#endif
#define GAS __attribute__((address_space(1)))
#define LAS __attribute__((address_space(3)))
#define CAS __attribute__((address_space(4)))
typedef unsigned short bf16_t;
typedef short bf16x8 __attribute__((ext_vector_type(8)));
typedef short s16x4 __attribute__((ext_vector_type(4)));
typedef float f32x4 __attribute__((ext_vector_type(4)));
typedef float f32x2 __attribute__((ext_vector_type(2)));
typedef float f32x16 __attribute__((ext_vector_type(16)));
typedef unsigned u32x4 __attribute__((ext_vector_type(4)));
typedef unsigned u32x2 __attribute__((ext_vector_type(2)));
typedef GAS unsigned gu32;

constexpr int NTOK = 16384, DM = 1024, SEQ = 2048, NB = 8, NMEM = 256, HD = 64;
constexpr int A_IN = 1536, B_IN = 4864, NEXP = 16, DEXP = 512;
constexpr float ALPHA = 1.4142135623730951f;
constexpr float NORM_EPS = 1e-6f;
constexpr float C2 = 0.125f * 1.4426950408889634f;
constexpr int RCAP = 16384;

constexpr size_t MiB = 1u << 20;
constexpr size_t WS_CTL = 0, CTL_ZERO_BYTES = 512 * 1024;
constexpr size_t WS_TAB = 1 * MiB;
constexpr size_t WS_ROWMAP = 2 * MiB;
constexpr size_t WS_ROWW = 3 * MiB;
constexpr size_t WS_WMKV = 4 * MiB;
constexpr size_t WS_WAIN = 5 * MiB;
constexpr size_t WS_WAOUT = 8 * MiB;
constexpr size_t WS_WBIN = 10 * MiB;
constexpr size_t WS_WBOUT = 20 * MiB;
__host__ __device__ constexpr size_t ws_wgu(int L) { return (L ? 22 : 140) * MiB; }
__host__ __device__ constexpr size_t ws_wd(int L) { return ws_wgu(L) + 32 * MiB; }
constexpr size_t WS_MEMB = 70 * MiB;
constexpr size_t WS_MKV = 74 * MiB;
constexpr size_t WS_XB = 76 * MiB;
constexpr size_t WS_ATT = 108 * MiB;
__host__ __device__ constexpr size_t ws_big(int L) { return (L ? 140 : 188) * MiB; }
__host__ __device__ constexpr size_t ws_h(int L) { return ws_big(L); }
__host__ __device__ constexpr size_t ws_y(int L) { return ws_big(L) + 36 * MiB; }
constexpr size_t WS_LSE = 292 * MiB;
constexpr size_t WS_END = 294 * MiB;
constexpr int TB_ROWC = 0, TB_ROWS = 512, TB_COLC = 1024, TB_COLS = 2048, TB_PC = 4096, TB_PS = 4096 + 16384;
constexpr int CW_TMO = 0;
constexpr int CW_BAR = 4096;
constexpr int CW_CNT = 16384;
constexpr int CW_XCC = 8192;
constexpr int CW_ATT = 20480;
constexpr int CW_Z = 57344;
constexpr int CW_GRP = 12288;
constexpr int CW_MRG = 28672;
constexpr int CW_HCNT = 32768;

constexpr int RING_OFF = 0, RING_BYTES = 131072;
constexpr int LDSCTL_OFF = RING_BYTES, MISC_OFF = LDSCTL_OFF + 320, SCHED_OFF = LDSCTL_OFF + 512;
constexpr int LDS_BYTES = 147456;
constexpr int NWAVES = 8;

#define RLX_AGENT __ATOMIC_RELAXED, __HIP_MEMORY_SCOPE_AGENT
#define LDS_WAIT() asm volatile("s_waitcnt lgkmcnt(0)" ::: "memory")
#define VM_WAIT() asm volatile("s_waitcnt vmcnt(0)" ::: "memory")
__device__ __forceinline__ unsigned f2bf(float f) { unsigned u = __builtin_bit_cast(unsigned, f); return (u + 0x7fffu + ((u >> 16) & 1u)) >> 16; }
__device__ __forceinline__ unsigned pk2(float lo, float hi) { return f2bf(lo) | (f2bf(hi) << 16); }
__device__ __forceinline__ float bf2f(unsigned short b) { return __builtin_bit_cast(float, (unsigned)b << 16); }
__device__ __forceinline__ float bflo(unsigned w) { return __builtin_bit_cast(float, w << 16); }
__device__ __forceinline__ float bfhi(unsigned w) { return __builtin_bit_cast(float, w & 0xffff0000u); }
__device__ __forceinline__ unsigned cvt_pk_bf16(float lo, float hi) { unsigned r; asm volatile("v_cvt_pk_bf16_f32 %0, %1, %2" : "=v"(r) : "v"(lo), "v"(hi)); return r; }
__device__ __forceinline__ void store16_sc1(void* p, u32x4 v) { asm volatile("global_store_dwordx4 %0, %1, off sc1\n\ts_nop 1" :: "v"(p), "v"(v) : "memory"); }
__device__ __forceinline__ float wave_sum(float v) {
#pragma unroll
    for (int o = 1; o < 64; o <<= 1) v += __shfl_xor(v, o);
    return v;
}

#define DPP_F(v, ctrl, rmask) __builtin_bit_cast(float, __builtin_amdgcn_update_dpp(0, __builtin_bit_cast(int, (v)), (ctrl), (rmask), 0xF, true))
__device__ __forceinline__ float wave_sum_dpp(float v) {
    v += DPP_F(v, 0xB1, 0xF); v += DPP_F(v, 0x4E, 0xF); v += DPP_F(v, 0x141, 0xF); v += DPP_F(v, 0x140, 0xF); v += DPP_F(v, 0x142, 0xA); v += DPP_F(v, 0x143, 0xC);
    return __builtin_bit_cast(float, __builtin_amdgcn_readlane(__builtin_bit_cast(int, v), 63));
}
#define XB_TMO      128
#define XB_XCNT(j)  (256  + 64 * (j))
#define XB_XSUB(j)  (1280 + 64 * (j))
#define XB_XGEN(j)  (2304 + 64 * (j))
#define XB_TOP      3328
#define XB_TOPGEN   3392
#define XCD_BAR_WORDS 3456
#define XB_SPIN_CAP (1u << 20)
__device__ __forceinline__ unsigned xb_ld(unsigned* p)              { return __hip_atomic_load(p, __ATOMIC_RELAXED, __HIP_MEMORY_SCOPE_AGENT); }
__device__ __forceinline__ unsigned xb_add(unsigned* p, unsigned v) { return __hip_atomic_fetch_add(p, v, __ATOMIC_RELAXED, __HIP_MEMORY_SCOPE_AGENT); }
__device__ __forceinline__ unsigned xb_xcc_id() { return (unsigned)__builtin_amdgcn_s_getreg((3 << 11) | 20) & 0xFu; }
#define XB_SPIN(cond, bar) do { unsigned _sp = 0; while (cond) { __builtin_amdgcn_s_sleep(1); \
    if ((++_sp & 255u) == 0u) { if (xb_ld(&(bar)[XB_TMO])) break; if (_sp > XB_SPIN_CAP) { atomicAdd(&(bar)[XB_TMO], 1u); break; } } } } while (0)
struct XcdBarrier { unsigned* bar; unsigned x; volatile LAS unsigned* st; };
__device__ __forceinline__ XcdBarrier xcd_barrier_post(unsigned* bar, volatile LAS unsigned* st) {
    XcdBarrier b; b.bar = bar; b.x = xb_xcc_id(); b.st = st;
    if (threadIdx.x == 0) (void)xb_add(&bar[XB_XCNT(b.x)], 1u);
    return b;
}
__device__ __forceinline__ void xcd_barrier_complete(unsigned* bar, unsigned x, unsigned& nloc, unsigned& nx) {
    const unsigned G = gridDim.x * gridDim.y * gridDim.z;
    unsigned sum, cnt, mine, sp = 0u;
    for (;;) {
        sum = 0u; cnt = 0u; mine = 0u;
#pragma unroll
        for (unsigned j = 0; j < 16; ++j) { const unsigned c = xb_ld(&bar[XB_XCNT(j)]); sum += c; cnt += (c > 0u) ? 1u : 0u; mine = (j == x) ? c : mine; }
        if (sum == G) break;
        __builtin_amdgcn_s_sleep(1);
        if ((++sp & 255u) == 0u) { if (xb_ld(&bar[XB_TMO])) break; if (sp > XB_SPIN_CAP) { atomicAdd(&bar[XB_TMO], 1u); break; } }
    }
    nloc = mine > 0u ? mine : 1u; nx = cnt > 0u ? cnt : 1u;
}
__device__ __forceinline__ void xcd_barrier(const XcdBarrier& b) {
    asm volatile("s_waitcnt vmcnt(0)" ::: "memory");
    __syncthreads();
    if (threadIdx.x == 0) {
        unsigned* bar = b.bar;
        __builtin_amdgcn_s_waitcnt(0);
        unsigned nloc = b.st[0], nx = b.st[1];
        if (nloc == 0u) { xcd_barrier_complete(bar, b.x, nloc, nx); b.st[0] = nloc; b.st[1] = nx; }
        const unsigned old = xb_add(&bar[XB_XSUB(b.x)], 1u);
        const unsigned gen = old / nloc;
        if (old + 1u == (gen + 1u) * nloc) {
            __builtin_amdgcn_fence(__ATOMIC_RELEASE, "agent");
            asm volatile("s_waitcnt vmcnt(0)" ::: "memory");
            const unsigned og = xb_add(&bar[XB_TOP], 1u);
            const unsigned tg = og / nx;
            if (og + 1u == (tg + 1u) * nx) xb_add(&bar[XB_TOPGEN], 1u);
            else XB_SPIN(xb_ld(&bar[XB_TOPGEN]) == tg, bar);
            __builtin_amdgcn_fence(__ATOMIC_ACQUIRE, "agent");
            xb_add(&bar[XB_XGEN(b.x)], 1u);
            asm volatile("s_waitcnt vmcnt(0)" ::: "memory");
        } else {
            XB_SPIN(xb_ld(&bar[XB_XGEN(b.x)]) == gen, bar);
            __builtin_amdgcn_fence(__ATOMIC_ACQUIRE, "agent");
            asm volatile("s_waitcnt vmcnt(0)" ::: "memory");
        }
    }
    __syncthreads();
}

namespace pg8 {
constexpr int BM = 256, BK = 64, HALF = 128, HTB = HALF * BK * 2, STAGE_BYTES = 8 * HTB, NXCD = 8, WGM = 8;
__host__ __device__ __forceinline__ int lds_byte(int r, int c) { const int st = (r >> 4) * 2 + (c >> 5), rr = r & 15, cc = c & 31, ob = rr * 64 + cc * 2; return st * 1024 + (ob ^ (((ob >> 9) & 1) << 5)); }
__host__ __device__ __forceinline__ void stage_rc(int b, int& R, int& C) { const int st = b / 1024, sb = b % 1024, swz = sb ^ (((sb >> 9) & 1) << 5); R = (st >> 1) * 16 + swz / 64; C = (st & 1) * 32 + (swz % 64) / 2; }
__host__ __device__ __forceinline__ int perm32(int rho) { const int n = rho >> 4, i = rho & 15; return 8 * (i >> 2) + 4 * n + (i & 3); }

struct Unit { int pm, pn, e, ti, nv; };

template <class Epi, class Sched, bool GATHER, int K>
__device__ __forceinline__ void gemm_phase(LAS unsigned char* lds, const Sched& S, const Epi& E, const int tid) {
    const int wid = __builtin_amdgcn_readfirstlane(tid >> 6), lane = tid & 63, wr = wid >> 2, wc = wid & 3, fr = lane & 15, fq = lane >> 4;
    const int nt = K / BK;
    unsigned voffA[2], voffB[2]; int RA[2], CA[2];
#pragma unroll
    for (int i = 0; i < 2; ++i) { int R, C; stage_rc(tid * 16 + i * 8192, R, C); const int Rb = Epi::PERM ? ((R & ~31) + perm32(R & 31)) : R;
        RA[i] = R; CA[i] = C; voffA[i] = (unsigned)(R * K + C) * 2u; voffB[i] = (unsigned)(Rb * K + C) * 2u; }
    const size_t kstep = (size_t)(BK * 2);
    const size_t hstep = (size_t)HALF * K * 2;
    const unsigned ldsw = (unsigned)wid * 1024u;
    const int aoff = lds_byte(wr * 64 + fr, fq * 8), boff = lds_byte(wc * 32 + fr, fq * 8);
    unsigned gA[2][2], ngA[2][2];
#define PG8_SA(b, h) (((b) * 2 + (h)) * HTB)
#define PG8_SB(b, h) ((4 + (b) * 2 + (h)) * HTB)
#define PG8_STAGE(bufoff, gbase, voff) do { _Pragma("unroll") for (int _i = 0; _i < 2; ++_i) \
        __builtin_amdgcn_global_load_lds((const unsigned*)((const char*)(gbase) + (voff)[_i]), (LAS unsigned*)(lds + (bufoff) + ldsw + _i * 8192), 16, 0, 0); } while (0)
#define PG8_STAGE_A(bufoff, gptr, H, NX) do { _Pragma("unroll") for (int _i = 0; _i < 2; ++_i) { \
        const unsigned _vo = GATHER ? ((NX) ? ngA[H][_i] : gA[H][_i]) : voffA[_i]; \
        const char* _gp = GATHER ? (const char*)(gptr) : (const char*)(gptr) + (H) * hstep; \
        __builtin_amdgcn_global_load_lds((const unsigned*)(_gp + _vo), (LAS unsigned*)(lds + (bufoff) + ldsw + _i * 8192), 16, 0, 0); } } while (0)
#define PG8_LDA(dst, b, h) do { _Pragma("unroll") for (int m = 0; m < 4; ++m) _Pragma("unroll") for (int k = 0; k < 2; ++k) dst[m][k] = *(const LAS bf16x8*)(lds + PG8_SA(b, h) + aoff + m * 2048 + k * 1024); } while (0)
#define PG8_LDB(dst, b, h) do { _Pragma("unroll") for (int n = 0; n < 2; ++n) _Pragma("unroll") for (int k = 0; k < 2; ++k) dst[n][k] = *(const LAS bf16x8*)(lds + PG8_SB(b, h) + boff + n * 2048 + k * 1024); } while (0)
#define PG8_MMA(ai, bj, At, Bt) do { __builtin_amdgcn_s_setprio(1); _Pragma("unroll") for (int m = 0; m < 4; ++m) _Pragma("unroll") for (int n = 0; n < 2; ++n) _Pragma("unroll") for (int k = 0; k < 2; ++k) \
        acc[ai][bj][m][n] = __builtin_amdgcn_mfma_f32_16x16x32_bf16(Bt[n][k], At[m][k], acc[ai][bj][m][n], 0, 0, 0); __builtin_amdgcn_s_setprio(0); } while (0)
#define PG8_WAIT_V(n) asm volatile("s_waitcnt vmcnt(" #n ")" ::: "memory")
#define PG8_WAIT_L(n) asm volatile("s_waitcnt lgkmcnt(" #n ")" ::: "memory")
#define PG8_BAR __builtin_amdgcn_s_barrier()
#define PG8_SCHED __builtin_amdgcn_sched_barrier(0)
#define PG8_GLOAD(dst, u) do { if constexpr (GATHER) { const int* _rm = S.rows(u); \
        _Pragma("unroll") for (int _h = 0; _h < 2; ++_h) _Pragma("unroll") for (int _i = 0; _i < 2; ++_i) { const int _r = _h * HALF + RA[_i]; \
            const int _tok = (_r < (u).nv) ? (_rm[_r] >> 1) : 0; dst[_h][_i] = (unsigned)(_tok * K + CA[_i]) * 2u; } \
        asm volatile("s_waitcnt vmcnt(0)" : "+v"(dst[0][0]), "+v"(dst[0][1]), "+v"(dst[1][0]), "+v"(dst[1][1]) :: "memory"); } } while (0)
    Unit cur, nxt; int ui = 0;
    if (!S.next(0, cur)) return;
    f32x4 acc[2][2][4][2];
#pragma unroll
    for (int a = 0; a < 2; ++a)
#pragma unroll
        for (int b = 0; b < 2; ++b)
#pragma unroll
            for (int m = 0; m < 4; ++m)
#pragma unroll
                for (int n = 0; n < 2; ++n) acc[a][b][m][n] = (f32x4){0.f, 0.f, 0.f, 0.f};
    bf16x8 At[4][2], B0[2][2], B1[2][2];
    const char* cA = S.a_base(cur); const char* cB = S.b_base(cur);
    S.a_ready(cur, tid);
    PG8_GLOAD(gA, cur);
    PG8_STAGE(PG8_SB(0, 0), cB, voffB); PG8_STAGE(PG8_SB(0, 1), cB + hstep, voffB); PG8_STAGE_A(PG8_SA(0, 0), cA, 0, false); PG8_STAGE_A(PG8_SA(0, 1), cA, 1, false);
    if (wr == 1) PG8_BAR;
    PG8_WAIT_V(2); PG8_BAR;
    PG8_STAGE(PG8_SB(1, 0), cB + kstep, voffB); PG8_STAGE_A(PG8_SA(1, 0), cA + kstep, 0, false); PG8_STAGE(PG8_SB(1, 1), cB + hstep + kstep, voffB);
    PG8_WAIT_V(6); PG8_BAR;
    for (;;) {
        const bool has_next = S.next(ui + 1, nxt);
        const char* nA = has_next ? S.a_base(nxt) : cA; const char* nB = has_next ? S.b_base(nxt) : cB;
        if constexpr (GATHER) {
            if (has_next) { PG8_GLOAD(ngA, nxt); }
            else {
#pragma unroll
                for (int _h = 0; _h < 2; ++_h)
#pragma unroll
                    for (int _i = 0; _i < 2; ++_i) ngA[_h][_i] = gA[_h][_i]; }
        }
        for (int t = 0; t < nt; t += 2) {
            const bool last = (t == nt - 2);
            const char* a1 = cA + (size_t)(t + 1) * kstep;
            const char* a2 = last ? nA : cA + (size_t)(t + 2) * kstep; const char* b2 = last ? nB : cB + (size_t)(t + 2) * kstep;
            const char* a3 = a2 + kstep; const char* b3 = b2 + kstep;
            if (last && has_next) S.a_ready(nxt, tid);
            PG8_LDB(B0, 0, 0); PG8_LDB(B1, 0, 1); PG8_SCHED; PG8_LDA(At, 0, 0); PG8_STAGE_A(PG8_SA(1, 1), a1, 1, false);
            PG8_WAIT_V(8); PG8_WAIT_L(0); PG8_BAR; PG8_MMA(0, 0, At, B0); PG8_MMA(0, 1, At, B1); PG8_BAR; PG8_SCHED;
            PG8_LDA(At, 0, 1); PG8_STAGE(PG8_SB(0, 0), b2, voffB); PG8_STAGE(PG8_SB(0, 1), b2 + hstep, voffB); PG8_STAGE_A(PG8_SA(0, 0), a2, 0, last);
            PG8_WAIT_V(8); PG8_WAIT_L(0); PG8_BAR; PG8_MMA(1, 0, At, B0); PG8_MMA(1, 1, At, B1); PG8_BAR; PG8_SCHED;
            PG8_LDB(B0, 1, 0); PG8_LDB(B1, 1, 1); PG8_SCHED; PG8_LDA(At, 1, 0); PG8_STAGE_A(PG8_SA(0, 1), a2, 1, last);
            PG8_WAIT_V(8); PG8_WAIT_L(0); PG8_BAR; PG8_MMA(0, 0, At, B0); PG8_MMA(0, 1, At, B1); PG8_BAR; PG8_SCHED;
            PG8_LDA(At, 1, 1); PG8_STAGE(PG8_SB(1, 0), b3, voffB); PG8_STAGE(PG8_SB(1, 1), b3 + hstep, voffB); PG8_STAGE_A(PG8_SA(1, 0), a3, 0, last);
            PG8_WAIT_V(8); PG8_WAIT_L(0); PG8_BAR; PG8_MMA(1, 0, At, B0); PG8_MMA(1, 1, At, B1); PG8_BAR; PG8_SCHED;
        }
        if (wr == 0) PG8_BAR;
        E(acc, cur, wr, wc, fr, fq);
        S.done(cur, lane);
        if (!has_next) break;
#pragma unroll
        for (int a = 0; a < 2; ++a)
#pragma unroll
            for (int b = 0; b < 2; ++b)
#pragma unroll
                for (int m = 0; m < 4; ++m)
#pragma unroll
                    for (int n = 0; n < 2; ++n) acc[a][b][m][n] = (f32x4){0.f, 0.f, 0.f, 0.f};
        cur = nxt; cA = nA; cB = nB; ++ui;
        if constexpr (GATHER) {
#pragma unroll
            for (int _h = 0; _h < 2; ++_h)
#pragma unroll
                for (int _i = 0; _i < 2; ++_i) gA[_h][_i] = ngA[_h][_i]; }
        if (wr == 1) PG8_BAR;
    }
    PG8_WAIT_V(0);
    PG8_BAR;
#undef PG8_SA
#undef PG8_SB
#undef PG8_STAGE
#undef PG8_STAGE_A
#undef PG8_LDA
#undef PG8_LDB
#undef PG8_MMA
#undef PG8_WAIT_V
#undef PG8_WAIT_L
#undef PG8_BAR
#undef PG8_SCHED
#undef PG8_GLOAD
}

struct DenseSched {
    const char *A0, *B0, *A1, *B1; int K; int nM, nN, nwg, G, c, nM1, nwg1;
    __device__ __forceinline__ void init(const void* a0, const void* b0, int M, int N, int K_, const void* a1, const void* b1, int M1, int N1, int G_, int c_) {
        A0 = (const char*)a0; B0 = (const char*)b0; A1 = (const char*)a1; B1 = (const char*)b1; K = K_; nM = M / BM; nN = N / BM; nwg = nM * nN; G = G_; c = c_;
        nM1 = M1 / BM > 0 ? M1 / BM : 1; nwg1 = (M1 / BM) * (N1 / BM); }
    __device__ __forceinline__ bool next(int i, Unit& u) const {
        const int L = i * G + c; if (L >= nwg + nwg1) return false;
        u.ti = 0; u.nv = BM;
        if (L < nwg) {
            int wgid = L; { const int q = nwg / NXCD, r = nwg % NXCD, xcd = wgid % NXCD, off = wgid / NXCD; wgid = (xcd < r ? xcd * (q + 1) : r * (q + 1) + (xcd - r) * q) + off; }
            const int nig = WGM * nN, gid = wgid / nig, fm = gid * WGM, gsz = (nM - fm) < WGM ? (nM - fm) : WGM;
            u.pm = fm + ((wgid % nig) % gsz); u.pn = (wgid % nig) / gsz; u.e = 0;
        } else { const int l = L - nwg; u.pm = l % nM1; u.pn = l / nM1; u.e = 1; }
        return true;
    }
    __device__ __forceinline__ const char* a_base(const Unit& u) const { return (u.e ? A1 : A0) + (size_t)u.pm * BM * K * 2; }
    __device__ __forceinline__ const char* b_base(const Unit& u) const { return (u.e ? B1 : B0) + (size_t)u.pn * BM * K * 2; }
    __device__ __forceinline__ const int* rows(const Unit&) const { return nullptr; }
    __device__ __forceinline__ void a_ready(const Unit&, int) const {}
    __device__ __forceinline__ void done(const Unit&, int) const {}
};
struct PanelSched {
    const char* A; const char* Bt; int K; int v; unsigned* cnt; unsigned need; unsigned* tmo;
    __device__ __forceinline__ bool next(int i, Unit& u) const { if (i > 0) return false; u.pm = (v >> 5) * 8 + (v & 7); u.pn = (v >> 3) & 3; u.e = 0; u.ti = 0; u.nv = BM; return true; }
    __device__ __forceinline__ const char* a_base(const Unit& u) const { return A + (size_t)u.pm * BM * K * 2; }
    __device__ __forceinline__ const char* b_base(const Unit& u) const { return Bt + (size_t)u.pn * BM * K * 2; }
    __device__ __forceinline__ const int* rows(const Unit&) const { return nullptr; }
    __device__ __forceinline__ void a_ready(const Unit& u, int tid) const {
        if (tid < 64) { unsigned polls = 0;
            while ((unsigned)__builtin_amdgcn_readfirstlane(__hip_atomic_load(cnt + 64 * u.pm, __ATOMIC_RELAXED, __HIP_MEMORY_SCOPE_AGENT)) < need) {
                if (++polls > (1u << 22)) { if (tid == 0) __hip_atomic_store(tmo, 3u, __ATOMIC_RELAXED, __HIP_MEMORY_SCOPE_AGENT); break; }
                __builtin_amdgcn_s_sleep(2); }
            __builtin_amdgcn_fence(__ATOMIC_ACQUIRE, "agent"); asm volatile("s_waitcnt vmcnt(0)" ::: "memory"); }
        asm volatile("" ::: "memory"); __builtin_amdgcn_s_barrier(); asm volatile("" ::: "memory");
    }
    __device__ __forceinline__ void done(const Unit&, int) const {}
};
struct MoeSched {
    const char* A; const char* Bt; int K; size_t bstride; const LAS int* tpre; const int* rowmap; int G, c; bool gather;
    unsigned* hcnt; unsigned* tmo;
    __device__ __forceinline__ void a_ready(const Unit& u, int tid) const {
        if (!gather) {
            if (tid < 64) { unsigned polls = 0;
                while ((unsigned)__builtin_amdgcn_readfirstlane(__hip_atomic_load(hcnt + 64 * u.pm, __ATOMIC_RELAXED, __HIP_MEMORY_SCOPE_AGENT)) < 32u) {
                    if (++polls > (1u << 22)) { if (tid == 0) __hip_atomic_store(tmo, 1u, __ATOMIC_RELAXED, __HIP_MEMORY_SCOPE_AGENT); break; }
                    __builtin_amdgcn_s_sleep(2); } }
            asm volatile("" ::: "memory"); __builtin_amdgcn_s_barrier(); asm volatile("" ::: "memory");
        }
    }
    __device__ __forceinline__ void done(const Unit& u, int lane) const {
        if (gather) { asm volatile("s_waitcnt vmcnt(0)" ::: "memory");
            if (lane == 0) __hip_atomic_fetch_add(hcnt + 64 * u.pm, 1u, __ATOMIC_RELAXED, __HIP_MEMORY_SCOPE_AGENT); }
    }
    __device__ __forceinline__ int unit_index(int i) const {
        const int U = tpre[16] * 4, x = U - 2 * G;
        if (!(x > 0 && 5 * x <= G)) { const int L = i * G + (gather ? c : G - 1 - c); return L < U ? L : -1; }
        const int a = 3 * x, b = G - 5 * x;
        if (gather) { if (i == 0) return c; if (i == 1) return c < a + b ? G + c : -1; if (i == 2) return c < a ? G + (a + b) + c : -1; return -1; }
        if (c >= a + b) return i < 4 ? (c - (a + b)) + 2 * x * i : -1;
        if (c >= a) return i < 2 ? 8 * x + (c - a) + b * i : -1;
        return i < 1 ? 8 * x + 2 * b + c : -1;
    }
    __device__ __forceinline__ bool next(int i, Unit& u) const {
        const int L = unit_index(i); if (L < 0) return false;
        const int rt = L >> 2; int e = 0;
#pragma unroll
        for (int k = 1; k < 16; ++k) e += (rt >= tpre[k]) ? 1 : 0;
        const int ti = rt - tpre[e]; const int rem = tpre[32 + e] - ti * BM;
        u.pn = L & 3; u.pm = __builtin_amdgcn_readfirstlane(rt); u.e = __builtin_amdgcn_readfirstlane(e); u.ti = __builtin_amdgcn_readfirstlane(ti); u.nv = __builtin_amdgcn_readfirstlane(rem < BM ? rem : BM);
        return true;
    }
    __device__ __forceinline__ const char* a_base(const Unit& u) const { return gather ? A : A + (size_t)u.pm * BM * K * 2; }
    __device__ __forceinline__ const char* b_base(const Unit& u) const { return Bt + (size_t)u.e * bstride + (size_t)u.pn * BM * K * 2; }
    __device__ __forceinline__ const int* rows(const Unit& u) const { return rowmap + (size_t)u.e * RCAP + u.ti * BM; }
};

struct EpiProj {
    static constexpr bool PERM = true;
    bf16_t* O0; int ldc0; int layer; const float* qn; const float* kn; const float* tab; bf16_t* O1; int ldc1;
    __device__ __forceinline__ void operator()(const f32x4 (&acc)[2][2][4][2], const Unit& u, int wr, int wc, int fr, int fq) const {
        const int row0 = u.pm * BM + wr * 64 + fr;
        if (u.e) {
            const int col0 = u.pn * BM + wc * 32 + 8 * fq;
#pragma unroll
            for (int ai = 0; ai < 2; ++ai)
#pragma unroll
                for (int m = 0; m < 4; ++m) { bf16_t* rowp = O1 + (size_t)(row0 + ai * HALF + m * 16) * ldc1 + col0;
#pragma unroll
                    for (int bj = 0; bj < 2; ++bj) { const f32x4 v0 = acc[ai][bj][m][0], v1 = acc[ai][bj][m][1]; u32x4 w;
                        w.x = cvt_pk_bf16(v0[0], v0[1]); w.y = cvt_pk_bf16(v0[2], v0[3]); w.z = cvt_pk_bf16(v1[0], v1[1]); w.w = cvt_pk_bf16(v1[2], v1[3]);
                        *(u32x4*)(rowp + bj * HALF) = w; } }
            return;
        }
        const int pn = u.pn;
        const bool isq = layer == 0 ? (pn < 3 || pn == 5) : (pn < 6 || pn == 18);
        const float s = isq ? C2 : 1.f;
        const int mode = (layer == 0 && pn < 4) ? 1 : ((layer == 1 && pn < 12) ? 2 : 0);
        const int col0 = pn * BM + wc * 64 + 8 * fq;
        const int i16 = 8 * (fq & 1); const bool hi2 = fq >= 2, lo = fq < 2, second = (fq & 1) != 0;
        f32x4 g00 = {1.f, 1.f, 1.f, 1.f}, g01 = g00, g10 = g00, g11 = g00;
        if (mode == 1) { const float* gp = (pn < 3 ? qn : kn) + 8 * fq; g00 = *(const f32x4*)(gp); g01 = *(const f32x4*)(gp + 4); g10 = *(const f32x4*)(gp + 32); g11 = *(const f32x4*)(gp + 36); }
#pragma unroll
        for (int ai = 0; ai < 2; ++ai)
#pragma unroll
            for (int m = 0; m < 4; ++m) {
                const int row = row0 + ai * HALF + m * 16;
                f32x4 x00 = acc[ai][0][m][0], x01 = acc[ai][0][m][1], x10 = acc[ai][1][m][0], x11 = acc[ai][1][m][1];
                if (mode == 1) {
                    const int gr = (row >> 6) & 31, gc = row & 63;
                    const float* rc = tab + TB_ROWC + gr * 16 + i16; const float* rs_ = tab + TB_ROWS + gr * 16 + i16;
                    const float* cc = tab + TB_COLC + gc * 16 + i16; const float* cs = tab + TB_COLS + gc * 16 + i16;
                    const f32x4 rc0 = *(const f32x4*)rc, rc1 = *(const f32x4*)(rc + 4), rs0 = *(const f32x4*)rs_, rs1 = *(const f32x4*)(rs_ + 4);
                    const f32x4 cc0 = *(const f32x4*)cc, cc1 = *(const f32x4*)(cc + 4), cs0 = *(const f32x4*)cs, cs1 = *(const f32x4*)(cs + 4);
                    float ss = 0.f;
#pragma unroll
                    for (int j = 0; j < 4; ++j) ss += x00[j] * x00[j] + x01[j] * x01[j] + x10[j] * x10[j] + x11[j] * x11[j];
                    ss += __shfl_xor(ss, 16); ss += __shfl_xor(ss, 32);
                    const float rn = __builtin_amdgcn_rsqf(ss * (1.f / 64.f) + NORM_EPS);
                    x00 = x00 * rn * g00; x01 = x01 * rn * g01; x10 = x10 * rn * g10; x11 = x11 * rn * g11;
                    f32x4 p00, p01, p10, p11;
#pragma unroll
                    for (int j = 0; j < 4; ++j) { p00[j] = __shfl_xor(x00[j], 32); p01[j] = __shfl_xor(x01[j], 32); p10[j] = __shfl_xor(x10[j], 32); p11[j] = __shfl_xor(x11[j], 32); }
                    if (hi2) { x00 = x00 * rc0 + p00 * rs0; x01 = x01 * rc1 + p01 * rs1; x10 = x10 * cc0 + p10 * cs0; x11 = x11 * cc1 + p11 * cs1; }
                    else     { x00 = x00 * rc0 - p00 * rs0; x01 = x01 * rc1 - p01 * rs1; x10 = x10 * cc0 - p10 * cs0; x11 = x11 * cc1 - p11 * cs1; }
                } else if (mode == 2) {
                    const int t = row & (SEQ - 1);
                    const f32x4 c0 = *(const f32x4*)(tab + TB_PC + t * 8), c1 = *(const f32x4*)(tab + TB_PC + t * 8 + 4), s0 = *(const f32x4*)(tab + TB_PS + t * 8), s1 = *(const f32x4*)(tab + TB_PS + t * 8 + 4);
                    f32x4 p0, p1;
#pragma unroll
                    for (int j = 0; j < 4; ++j) { p0[j] = __shfl_xor(x00[j], 16); p1[j] = __shfl_xor(x01[j], 16); }
                    if (lo) { if (second) { x00 = x00 * c0 + p0 * s0; x01 = x01 * c1 + p1 * s1; } else { x00 = x00 * c0 - p0 * s0; x01 = x01 * c1 - p1 * s1; } }
                }
                bf16_t* rowp = O0 + (size_t)row * ldc0 + col0;
                x00 = x00 * s; x01 = x01 * s; x10 = x10 * s; x11 = x11 * s;
                u32x4 w0, w1;
                w0.x = cvt_pk_bf16(x00[0], x00[1]); w0.y = cvt_pk_bf16(x00[2], x00[3]); w0.z = cvt_pk_bf16(x01[0], x01[1]); w0.w = cvt_pk_bf16(x01[2], x01[3]);
                w1.x = cvt_pk_bf16(x10[0], x10[1]); w1.y = cvt_pk_bf16(x10[2], x10[3]); w1.z = cvt_pk_bf16(x11[0], x11[1]); w1.w = cvt_pk_bf16(x11[2], x11[3]);
                *(u32x4*)(rowp) = w0; *(u32x4*)(rowp + 32) = w1;
                asm volatile("" ::: "memory");
            }
    }
};
struct EpiZ {
    static constexpr bool PERM = true;
    const bf16_t* res; bf16_t* out;
    __device__ __forceinline__ void operator()(const f32x4 (&acc)[2][2][4][2], const Unit& u, int wr, int wc, int fr, int fq) const {
        const int row0 = u.pm * BM + wr * 64 + fr, col0 = u.pn * BM + wc * 32 + 8 * fq;
#pragma unroll
        for (int ai = 0; ai < 2; ++ai)
#pragma unroll
            for (int m = 0; m < 4; ++m) { const size_t off = (size_t)(row0 + ai * HALF + m * 16) * DM + col0;
#pragma unroll
                for (int bj = 0; bj < 2; ++bj) { const u32x4 r = __builtin_nontemporal_load((const u32x4*)(res + off + bj * HALF));
                    const f32x4 a0 = acc[ai][bj][m][0], a1 = acc[ai][bj][m][1]; u32x4 w;
                    w.x = cvt_pk_bf16(bflo(r.x) * ALPHA + a0[0], bfhi(r.x) * ALPHA + a0[1]); w.y = cvt_pk_bf16(bflo(r.y) * ALPHA + a0[2], bfhi(r.y) * ALPHA + a0[3]);
                    w.z = cvt_pk_bf16(bflo(r.z) * ALPHA + a1[0], bfhi(r.z) * ALPHA + a1[1]); w.w = cvt_pk_bf16(bflo(r.w) * ALPHA + a1[2], bfhi(r.w) * ALPHA + a1[3]);
                    *(u32x4*)(out + off + bj * HALF) = w; } }
    }
};
struct EpiGU {
    static constexpr bool PERM = true;
    bf16_t* H;
    __device__ __forceinline__ void operator()(const f32x4 (&acc)[2][2][4][2], const Unit& u, int wr, int wc, int fr, int fq) const {
        const int row0 = u.pm * BM + wr * 64 + fr, col0 = u.pn * HALF + wc * 32 + 8 * fq;
#pragma unroll
        for (int ai = 0; ai < 2; ++ai)
#pragma unroll
            for (int m = 0; m < 4; ++m) { float hv[8];
#pragma unroll
                for (int n = 0; n < 2; ++n)
#pragma unroll
                    for (int j = 0; j < 4; ++j) { const float g = acc[ai][0][m][n][j], uu = acc[ai][1][m][n][j];
                        hv[n * 4 + j] = g * __builtin_amdgcn_rcpf(1.f + __builtin_amdgcn_exp2f(-1.4426950408889634f * g)) * uu; }
                u32x4 w; w.x = cvt_pk_bf16(hv[0], hv[1]); w.y = cvt_pk_bf16(hv[2], hv[3]); w.z = cvt_pk_bf16(hv[4], hv[5]); w.w = cvt_pk_bf16(hv[6], hv[7]);
                store16_sc1(H + (size_t)(row0 + ai * HALF + m * 16) * DEXP + col0, w); }
    }
};
struct EpiDown {
    static constexpr bool PERM = true;
    bf16_t* Y; const int* rowmap; const float* roww;
    __device__ __forceinline__ void operator()(const f32x4 (&acc)[2][2][4][2], const Unit& u, int wr, int wc, int fr, int fq) const {
        const int* rm = rowmap + (size_t)u.e * RCAP + u.ti * BM; const float* rw = roww + (size_t)u.e * RCAP + u.ti * BM;
        const int col0 = u.pn * BM + wc * 32 + 8 * fq;
#pragma unroll
        for (int ai = 0; ai < 2; ++ai)
#pragma unroll
            for (int m = 0; m < 4; ++m) { const int r = ai * HALF + wr * 64 + m * 16 + fr;
                if (r < u.nv) { const int code = rm[r]; const float s = rw[r];
                    bf16_t* rowp = Y + ((size_t)(code & 1) * NTOK + (size_t)(code >> 1)) * DM + col0;
#pragma unroll
                    for (int bj = 0; bj < 2; ++bj) { const f32x4 v0 = acc[ai][bj][m][0] * s, v1 = acc[ai][bj][m][1] * s; u32x4 w;
                        w.x = cvt_pk_bf16(v0[0], v0[1]); w.y = cvt_pk_bf16(v0[2], v0[3]); w.z = cvt_pk_bf16(v1[0], v1[1]); w.w = cvt_pk_bf16(v1[2], v1[3]);
                        *(u32x4*)(rowp + bj * HALF) = w; } } }
    }
};
}

namespace attn_body {
using bf16 = bf16_t;
constexpr int D = 64, NW = 8, QBLK = 32, QB = QBLK * NW, KVBLK = 64;
__device__ __forceinline__ int crow(int r, int hi) { return (r & 3) + 8 * (r >> 2) + 4 * hi; }
#define SBAR() __builtin_amdgcn_sched_barrier(0)
constexpr int NSLOT = 3, SLOTB = 8192;
constexpr int LDS_K = 0, LDS_V = NSLOT * SLOTB, LDS_WS = 2 * NSLOT * SLOTB, LDS_OST = LDS_WS + NW * 64 * 4, LDS_BYTES_A = LDS_OST + NW * 4096;
__device__ __forceinline__ void glds16(const void* gsrc, unsigned lds_dst) { unsigned keep;
  asm volatile("s_mov_b32 %0, m0\n\ts_mov_b32 m0, %2\n\ts_nop 0\n\tglobal_load_lds_dwordx4 %1, off\n\ts_mov_b32 m0, %0" : "=&s"(keep) : "v"(gsrc), "s"(lds_dst) : "memory"); }
__device__ __forceinline__ float max3f(float a, float b, float c) { float r; asm("v_max3_f32 %0, %1, %2, %3" : "=v"(r) : "v"(a), "v"(b), "v"(c)); return r; }
__device__ __forceinline__ float max2f(float a, float b) { float r; asm("v_max_f32_e32 %0, %1, %2" : "=v"(r) : "v"(a), "v"(b)); return r; }
__device__ __forceinline__ float fadd_s(float a, float b) { float r; asm("v_add_f32_e32 %0, %1, %2" : "=v"(r) : "v"(a), "v"(b)); return r; }
__device__ __forceinline__ float fsub_s(float a, float b) { float r; asm("v_sub_f32_e32 %0, %1, %2" : "=v"(r) : "v"(a), "v"(b)); return r; }
typedef float f32x2_t __attribute__((ext_vector_type(2))); typedef __bf16 bf16x2_t __attribute__((ext_vector_type(2)));
__device__ __forceinline__ unsigned cvtpk_s(float lo, float hi) { f32x2_t v = {lo, hi}; bf16x2_t b = __builtin_convertvector(v, bf16x2_t); return __builtin_bit_cast(unsigned, b); }
#define WAIT_BAR(N) asm volatile("s_waitcnt vmcnt(" #N ") lgkmcnt(0)\n\ts_barrier" ::: "memory")
__device__ __forceinline__ void qkt(f32x16& p0, f32x16& p1, const char* Kslot, const bf16x8* qr, const f32x16& negm, int r32, int hi) {
  const char* kb = Kslot + hi * 1024 + r32 * 16;
  #pragma unroll
  for (int d0 = 0; d0 < 4; ++d0) {
    const bf16x8 b0 = *reinterpret_cast<const bf16x8*>(kb + d0 * 2048);
    const bf16x8 b1 = *reinterpret_cast<const bf16x8*>(kb + d0 * 2048 + 512);
    if (d0 == 0) { p0 = __builtin_amdgcn_mfma_f32_32x32x16_bf16(b0, qr[0], negm, 0, 0, 0); p1 = __builtin_amdgcn_mfma_f32_32x32x16_bf16(b1, qr[0], negm, 0, 0, 0); }
    else { p0 = __builtin_amdgcn_mfma_f32_32x32x16_bf16(b0, qr[d0], p0, 0, 0, 0); p1 = __builtin_amdgcn_mfma_f32_32x32x16_bf16(b1, qr[d0], p1, 0, 0, 0); } }
}
typedef __attribute__((address_space(3))) const char* lds_cptr;
typedef short v4i16_t __attribute__((ext_vector_type(4)));
__device__ __forceinline__ void kload8(bf16x8* kf, lds_cptr kp) {
  kf[0] = *(const LAS bf16x8*)(kp);        kf[1] = *(const LAS bf16x8*)(kp + 512);
  kf[2] = *(const LAS bf16x8*)(kp + 2048); kf[3] = *(const LAS bf16x8*)(kp + 2560);
  kf[4] = *(const LAS bf16x8*)(kp + 4096); kf[5] = *(const LAS bf16x8*)(kp + 4608);
  kf[6] = *(const LAS bf16x8*)(kp + 6144); kf[7] = *(const LAS bf16x8*)(kp + 6656);
}
__device__ __forceinline__ void kload2(bf16x8* kf, lds_cptr kp, int j) { kf[2 * j] = *(const LAS bf16x8*)(kp + j * 2048); kf[2 * j + 1] = *(const LAS bf16x8*)(kp + j * 2048 + 512); }
__device__ __forceinline__ s16x4 vtr(lds_cptr p) { return __builtin_bit_cast(s16x4, __builtin_amdgcn_ds_read_tr16_b64_v4i16((LAS v4i16_t*)p)); }
__device__ __forceinline__ float rowmax(const f32x16& p0, const f32x16& p1) {
  float a = max3f(p0[0], p0[1], p1[0]), b = max3f(p0[2], p0[3], p1[1]); a = max3f(a, p1[2], p1[3]);
  #pragma unroll
  for (int r = 4; r < 16; r += 4) { a = max3f(a, p0[r], p0[r + 1]); b = max3f(b, p0[r + 2], p0[r + 3]); a = max3f(a, p1[r], p1[r + 1]); b = max3f(b, p1[r + 2], p1[r + 3]); }
  const float m = max2f(a, b);
  auto rr = __builtin_amdgcn_permlane32_swap(__float_as_uint(m), __float_as_uint(m), false, false);
  return max2f(__uint_as_float(rr[0]), __uint_as_float(rr[1]));
}
__device__ __forceinline__ void pv(f32x16* o, int vb, bf16x8 pa0, bf16x8 pa1, bf16x8 pa2, bf16x8 pa3) {
  #pragma unroll
  for (int d0 = 0; d0 < 2; ++d0) { s16x4 lo[4], hi[4];
    #pragma unroll
    for (int ks = 0; ks < 4; ++ks) {
      asm volatile("ds_read_b64_tr_b16 %0,%1 offset:%c2" : "=&v"(lo[ks]) : "v"(vb), "i"(d0 * 4096 + ks * 1024) : "memory");
      asm volatile("ds_read_b64_tr_b16 %0,%1 offset:%c2" : "=&v"(hi[ks]) : "v"(vb), "i"(d0 * 4096 + ks * 1024 + 512) : "memory"); }
    asm volatile("s_waitcnt lgkmcnt(0)" ::: "memory"); SBAR();
    #define PK(k) (bf16x8){lo[k][0], lo[k][1], lo[k][2], lo[k][3], hi[k][0], hi[k][1], hi[k][2], hi[k][3]}
    o[d0] = __builtin_amdgcn_mfma_f32_32x32x16_bf16(pa0, PK(0), o[d0], 0, 0, 0);
    o[d0] = __builtin_amdgcn_mfma_f32_32x32x16_bf16(pa1, PK(1), o[d0], 0, 0, 0);
    o[d0] = __builtin_amdgcn_mfma_f32_32x32x16_bf16(pa2, PK(2), o[d0], 0, 0, 0);
    o[d0] = __builtin_amdgcn_mfma_f32_32x32x16_bf16(pa3, PK(3), o[d0], 0, 0, 0);
    #undef PK
  }
}
template<int THRL, int QP, int KP, int VP, int OP, int NT> __device__ __forceinline__ void attn_unit(const bf16* Qb, const bf16* __restrict__ Kb, const bf16* __restrict__ Vb, bf16* Ob, const int q0, char* shm, const int tid) {
  const int lane = tid & 63, r32 = lane & 31, hi = lane >> 5; const int wid = __builtin_amdgcn_readfirstlane(tid >> 6);
  const bf16* Qw = Qb + (long)(q0 + wid * QBLK) * QP;
  const unsigned lds0 = (unsigned)(uintptr_t)shm;
  float* wsf = (float*)(shm + LDS_WS) + wid * 64;
  const bf16* ksrc = Kb + (long)lane * KP + wid * 8;
  const bf16* vsrc = Vb + (long)(16 * (wid & 3) + (lane >> 2)) * VP + (wid >> 2) * 32 + (lane & 3) * 8;
  const unsigned kdst = lds0 + LDS_K + wid * 1024, vdst = lds0 + LDS_V + wid * 1024;
  #define DMA_K(t, slot) glds16(ksrc + (long)(t) * KVBLK * KP, (unsigned)__builtin_amdgcn_readfirstlane(kdst + (slot)))
  #define DMA_V(t, slot) glds16(vsrc + (long)(t) * KVBLK * VP, (unsigned)__builtin_amdgcn_readfirstlane(vdst + (slot)))
  const int vb0 = (int)(lds0 + LDS_V) + ((lane >> 4) & 1) * 32 + (lane & 3) * 8 + (4 * hi + ((lane & 15) >> 2)) * 64;
  const char* Kbase = shm + LDS_K; bf16x8 kf[8];
  const lds_cptr shm3 = (lds_cptr)shm; const lds_cptr kp0 = shm3 + LDS_K + hi * 1024 + r32 * 16; const lds_cptr vp0 = shm3 + LDS_V + ((lane >> 4) & 1) * 32 + (lane & 3) * 8 + (4 * hi + ((lane & 15) >> 2)) * 64;
  DMA_K(0, 0); DMA_V(0, 0); DMA_K(1, SLOTB);
  bf16x8 qr[4];
  #pragma unroll
  for (int d0 = 0; d0 < 4; ++d0) qr[d0] = *reinterpret_cast<const bf16x8*>(&Qw[(long)r32 * QP + d0 * 16 + hi * 8]);
  float mhat = 0.f, l_reg = 0.f; f32x16 o[2]; o[0] = f32x16{}; o[1] = f32x16{}; float zz_ = 0.f; asm volatile("" : "+v"(zz_)); f32x16 negm; _Pragma("unroll") for (int r = 0; r < 16; ++r) negm[r] = zz_; asm volatile("" : "+v"(negm));
  bool resc = false;
  #define START(P0, P1) do { const float rm = rowmax(P0, P1); resc = false; \
    { const float dl = rm; mhat = fadd_s(mhat, dl); \
      _Pragma("unroll") for (int r = 0; r < 16; ++r) { P0[r] = fsub_s(P0[r], dl); P1[r] = fsub_s(P1[r], dl); } \
      _Pragma("unroll") for (int r = 0; r < 16; ++r) negm[r] = -mhat; asm volatile("" : "+v"(negm)); } \
    _Pragma("unroll") for (int r = 0; r < 16; ++r) P0[r] = __builtin_amdgcn_exp2f(P0[r]); } while (0)
  #define RESC() do { if (resc) { asm volatile("s_waitcnt lgkmcnt(0)" ::: "memory"); \
      _Pragma("unroll") for (int d_ = 0; d_ < 2; ++d_) _Pragma("unroll") for (int r = 0; r < 16; ++r) o[d_][r] *= wsf[crow(r, hi)]; } } while (0)
  f32x16 pA0, pA1, pB0, pB1;
  int sl_prev = 0, sl_cur = 0, sl_next = SLOTB;
  #define ROT() do { sl_prev = sl_cur; sl_cur = sl_next; sl_next = (sl_next == (NSLOT - 1) * SLOTB) ? 0 : sl_next + SLOTB; } while (0)
  DMA_K(2, 2 * SLOTB);
  WAIT_BAR(3);
  qkt(pA0, pA1, Kbase, qr, negm, r32, hi); asm volatile("s_nop 15\n\ts_nop 7" : "+v"(pA0), "+v"(pA1));
  START(pA0, pA1);
  _Pragma("unroll") for (int r = 0; r < 16; ++r) pA1[r] = __builtin_amdgcn_exp2f(pA1[r]);
  WAIT_BAR(0);
  DMA_K(3, 0); DMA_V(1, SLOTB);
  ROT();
  kload8(kf, kp0 + sl_cur);
  WAIT_BAR(2);
  s16x4 vlo[8], vhi[8]; u32x4 pw0, pw1, pw2, pw3;
  #define PKW(P, B) cvtpk_s(P[B], P[B + 1])
  #define PAF(k) __builtin_bit_cast(bf16x8, pw##k)
  #define VFR(i) (bf16x8){vlo[i][0], vlo[i][1], vlo[i][2], vlo[i][3], vhi[i][0], vhi[i][1], vhi[i][2], vhi[i][3]}
  #define PIN(x) asm volatile("" : "+v"(x))
  #define MX3(a, b, c) __builtin_fmaxf(__builtin_fmaxf((a), (b)), (c))
  #define GAPA(MF, A0, A1, A2, A3, W0, W1, PW) do { MF; sacc += A0; sacc += A1; sacc += A2; sacc += A3; PIN(sacc); W0; W1; PIN(PW); SBAR(); } while (0)
  #define EX(v) __builtin_amdgcn_exp2f(v)
  #define GAPB(MF, X, B) do { MF; X[B] = EX(X[B]); X[B + 1] = EX(X[B + 1]); X[B + 2] = EX(X[B + 2]); X[B + 3] = EX(X[B + 3]); PIN(X); SBAR(); } while (0)
  #define VRD(i) do { vlo[i] = vtr(vp_ + (((i) >> 2) * 4096 + ((i) & 3) * 1024)); vhi[i] = vtr(vp_ + (((i) >> 2) * 4096 + ((i) & 3) * 1024 + 512)); } while (0)
  #define KRD(G, j) do { if (G) { kload2(kf, kp0 + sl_next, j); SBAR(); } } while (0)
  #define STEP(C0, C1, P0, P1, t, GK, GV, GL) do { SBAR(); \
    const lds_cptr vp_ = vp0 + sl_prev; \
    VRD(0); SBAR(); float sacc = (P0[0] + P0[1]); \
    GAPA(C0 = __builtin_amdgcn_mfma_f32_32x32x16_bf16(kf[0], qr[0], negm, 0, 0, 0), P0[2], P0[3], P0[4], P0[5],     pw0[0] = PKW(P0, 0), pw0[1] = PKW(P0, 2), pw0); \
    VRD(4); SBAR(); GAPA(C1 = __builtin_amdgcn_mfma_f32_32x32x16_bf16(kf[1], qr[0], negm, 0, 0, 0), P0[6], P0[7], P0[8], P0[9],     pw0[2] = PKW(P0, 4), pw0[3] = PKW(P0, 6), pw0); \
    VRD(1); SBAR(); GAPA(C0 = __builtin_amdgcn_mfma_f32_32x32x16_bf16(kf[2], qr[1], C0, 0, 0, 0),   P0[10], P0[11], P0[12], P0[13], pw1[0] = PKW(P0, 8), pw1[1] = PKW(P0, 10), pw1); \
    VRD(5); SBAR(); GAPA(C1 = __builtin_amdgcn_mfma_f32_32x32x16_bf16(kf[3], qr[1], C1, 0, 0, 0),   P0[14], P0[15], P1[0], P1[1],   pw1[2] = PKW(P0, 12), pw1[3] = PKW(P0, 14), pw1); \
    VRD(2); SBAR(); GAPA(C0 = __builtin_amdgcn_mfma_f32_32x32x16_bf16(kf[4], qr[2], C0, 0, 0, 0),   P1[2], P1[3], P1[4], P1[5],     pw2[0] = PKW(P1, 0), pw2[1] = PKW(P1, 2), pw2); \
    VRD(6); SBAR(); GAPA(C1 = __builtin_amdgcn_mfma_f32_32x32x16_bf16(kf[5], qr[2], C1, 0, 0, 0),   P1[6], P1[7], P1[8], P1[9],     pw2[2] = PKW(P1, 4), pw2[3] = PKW(P1, 6), pw2); \
    VRD(3); SBAR(); GAPA(C0 = __builtin_amdgcn_mfma_f32_32x32x16_bf16(kf[6], qr[3], C0, 0, 0, 0),   P1[10], P1[11], P1[12], P1[13], pw3[0] = PKW(P1, 8), pw3[1] = PKW(P1, 10), pw3); \
    VRD(7); SBAR(); GAPA(C1 = __builtin_amdgcn_mfma_f32_32x32x16_bf16(kf[7], qr[3], C1, 0, 0, 0),   P1[14], P1[15], 0.f, 0.f,       pw3[2] = PKW(P1, 12), pw3[3] = PKW(P1, 14), pw3); \
    l_reg += sacc; \
    if (GK) { DMA_K((t) + 3, sl_cur); } if (GV) { DMA_V((t) + 1, sl_next); } \
    { float a = MX3(C0[0], C0[1], C1[0]), b = MX3(C0[2], C0[3], C1[1]); a = MX3(a, C1[2], C1[3]); \
      _Pragma("unroll") for (int r = 4; r < 16; r += 4) { a = MX3(a, C0[r], C0[r + 1]); b = MX3(b, C0[r + 2], C0[r + 3]); a = MX3(a, C1[r], C1[r + 1]); b = MX3(b, C1[r + 2], C1[r + 3]); } \
      float rm = __builtin_fmaxf(a, b); { auto rr = __builtin_amdgcn_permlane32_swap(__float_as_uint(rm), __float_as_uint(rm), false, false); rm = __builtin_fmaxf(__uint_as_float(rr[0]), __uint_as_float(rr[1])); } \
      resc = false; \
      if (__builtin_expect(__any(rm > (float)THRL), 0)) { const float dl = __builtin_fmaxf(rm, 0.f); mhat += dl; \
        _Pragma("unroll") for (int r = 0; r < 16; ++r) { C0[r] -= dl; C1[r] -= dl; } \
        _Pragma("unroll") for (int r = 0; r < 16; ++r) negm[r] = -mhat; asm volatile("" : "+v"(negm)); \
        const float f = __builtin_amdgcn_exp2f(-dl); l_reg *= f; if (hi == 0) wsf[r32] = f; resc = true; } } \
    SBAR(); \
    GAPB(o[0] = __builtin_amdgcn_mfma_f32_32x32x16_bf16(PAF(0), VFR(0), o[0], 0, 0, 0), C0, 0); \
    GAPB(o[1] = __builtin_amdgcn_mfma_f32_32x32x16_bf16(PAF(0), VFR(4), o[1], 0, 0, 0), C0, 4); \
    KRD(GL, 0); GAPB(o[0] = __builtin_amdgcn_mfma_f32_32x32x16_bf16(PAF(1), VFR(1), o[0], 0, 0, 0), C0, 8); \
    KRD(GL, 1); GAPB(o[1] = __builtin_amdgcn_mfma_f32_32x32x16_bf16(PAF(1), VFR(5), o[1], 0, 0, 0), C0, 12); \
    KRD(GL, 2); GAPB(o[0] = __builtin_amdgcn_mfma_f32_32x32x16_bf16(PAF(2), VFR(2), o[0], 0, 0, 0), C1, 0); \
    KRD(GL, 3); GAPB(o[1] = __builtin_amdgcn_mfma_f32_32x32x16_bf16(PAF(2), VFR(6), o[1], 0, 0, 0), C1, 4); \
    GAPB(o[0] = __builtin_amdgcn_mfma_f32_32x32x16_bf16(PAF(3), VFR(3), o[0], 0, 0, 0), C1, 8); \
    GAPB(o[1] = __builtin_amdgcn_mfma_f32_32x32x16_bf16(PAF(3), VFR(7), o[1], 0, 0, 0), C1, 12); \
    } while (0)
  int t = 1;
  for (; t + 5 < NT; t += 2) {
    STEP(pB0, pB1, pA0, pA1, t, true, true, true);     WAIT_BAR(2); RESC(); ROT();
    STEP(pA0, pA1, pB0, pB1, t + 1, true, true, true); WAIT_BAR(2); RESC(); ROT();
  }
  #define ENDW(tt) do { if ((tt) + 3 < NT) { WAIT_BAR(2); } else if ((tt) + 2 < NT) { WAIT_BAR(1); } else { WAIT_BAR(0); } } while (0)
  for (; t + 1 < NT; t += 2) {
    STEP(pB0, pB1, pA0, pA1, t, (t + 3 < NT), (t + 1 < NT), (t + 1 < NT));         ENDW(t);     RESC(); ROT();
    STEP(pA0, pA1, pB0, pB1, t + 1, (t + 4 < NT), (t + 2 < NT), (t + 2 < NT));     ENDW(t + 1); RESC(); ROT();
  }
  STEP(pB0, pB1, pA0, pA1, NT - 1, false, false, false); RESC();
  { float sacc = pB0[0] + pB0[1]; _Pragma("unroll") for (int r = 2; r < 16; ++r) sacc += pB0[r]; _Pragma("unroll") for (int r = 0; r < 16; ++r) sacc += pB1[r]; l_reg += sacc;
    pw0 = (u32x4){PKW(pB0, 0), PKW(pB0, 2), PKW(pB0, 4), PKW(pB0, 6)}; pw1 = (u32x4){PKW(pB0, 8), PKW(pB0, 10), PKW(pB0, 12), PKW(pB0, 14)}; pw2 = (u32x4){PKW(pB1, 0), PKW(pB1, 2), PKW(pB1, 4), PKW(pB1, 6)}; pw3 = (u32x4){PKW(pB1, 8), PKW(pB1, 10), PKW(pB1, 12), PKW(pB1, 14)};
    SBAR(); pv(o, vb0 + sl_cur, PAF(0), PAF(1), PAF(2), PAF(3)); }
  #undef PKW
  #undef PAF
  #undef VFR
  #undef PIN
  #undef MX3
  #undef GAPA
  #undef GAPB
  #undef EX
  #undef VRD
  #undef KRD
  #undef STEP
  #undef ENDW
  { auto rr = __builtin_amdgcn_permlane32_swap(__float_as_uint(l_reg), __float_as_uint(l_reg), false, false); l_reg = __uint_as_float(rr[0]) + __uint_as_float(rr[1]); }
  if (hi == 0) wsf[32 + r32] = l_reg; asm volatile("s_waitcnt lgkmcnt(0)" ::: "memory");
  float rli[16];
  #pragma unroll
  for (int r = 0; r < 16; ++r) rli[r] = __builtin_amdgcn_rcpf(wsf[32 + crow(r, hi)]);
  bf16* Ow = Ob + (long)(q0 + wid * QBLK) * OP;
  { bf16* stg = (bf16*)(shm + LDS_OST) + wid * 2048;
    #pragma unroll
    for (int r = 0; r < 16; ++r) { const int orow = crow(r, hi);
      #pragma unroll
      for (int d0 = 0; d0 < 2; ++d0) stg[orow * 64 + d0 * 32 + r32] = (bf16)f2bf(o[d0][r] * rli[r]); }
    asm volatile("s_waitcnt lgkmcnt(0)" ::: "memory");
    #pragma unroll
    for (int i = 0; i < 4; ++i) { const int row = i * 8 + (lane >> 3), ch = lane & 7; const u32x4 v = *(const u32x4*)(stg + row * 64 + ch * 8); *(u32x4*)(Ow + (long)row * OP + ch * 8) = v; } }
  asm volatile("s_waitcnt lgkmcnt(0)\n\ts_barrier" ::: "memory");
  #undef DMA_K
  #undef DMA_V
  #undef START
  #undef RESC
  #undef ROT
}
#undef WAIT_BAR

__device__ __forceinline__ void band_item(const bf16* P1, bf16* Od, const long opitch, float* lse, int b, int g, int h, int r, int qi, int dil, int Lr, char* wlds, int lane) {
  const int r32 = lane & 31, hi = lane >> 5;
  const long pitch = B_IN;
  const int colq = (g * 8 + h) * 64, colk = 1536 + colq, colv = 3072 + colq;
  const long row0 = (long)b * SEQ;
  bf16x8 qf[4];
  { const long tq = row0 + (long)(32 * qi + r32) * dil + r; const bf16* qp = P1 + tq * pitch + colq + hi * 8;
    #pragma unroll
    for (int d0 = 0; d0 < 4; ++d0) qf[d0] = *reinterpret_cast<const bf16x8*>(qp + d0 * 16); }
  f32x16 sc[5];
  const int nblk = Lr / 32;
  #pragma unroll
  for (int s = 0; s < 5; ++s) {
    const int kb = qi - 2 + s;
    if (kb >= 0 && kb < nblk) {
      const long tk = row0 + (long)(32 * kb + r32) * dil + r; const bf16* kp = P1 + tk * pitch + colk + hi * 8;
      bf16x8 kf[4];
      #pragma unroll
      for (int d0 = 0; d0 < 4; ++d0) kf[d0] = *reinterpret_cast<const bf16x8*>(kp + d0 * 16);
      f32x16 a = f32x16{};
      #pragma unroll
      for (int d0 = 0; d0 < 4; ++d0) a = __builtin_amdgcn_mfma_f32_32x32x16_bf16(kf[d0], qf[d0], a, 0, 0, 0);
      if (s == 0) {
        #pragma unroll
        for (int rg = 0; rg < 16; ++rg) { const int j = crow(rg, hi); if (j < r32) a[rg] = -INFINITY; } }
      if (s == 4) {
        #pragma unroll
        for (int rg = 0; rg < 16; ++rg) { const int j = crow(rg, hi); if (j > r32) a[rg] = -INFINITY; } }
      sc[s] = a;
    } else {
      #pragma unroll
      for (int rg = 0; rg < 16; ++rg) sc[s][rg] = -INFINITY;
    }
  }
  float m = -INFINITY;
  #pragma unroll
  for (int s = 0; s < 5; ++s)
    #pragma unroll
    for (int rg = 0; rg < 16; ++rg) m = __builtin_fmaxf(m, sc[s][rg]);
  { auto rr = __builtin_amdgcn_permlane32_swap(__float_as_uint(m), __float_as_uint(m), false, false); m = __builtin_fmaxf(__uint_as_float(rr[0]), __uint_as_float(rr[1])); }
  float l = 0.f;
  #pragma unroll
  for (int s = 0; s < 5; ++s)
    #pragma unroll
    for (int rg = 0; rg < 16; ++rg) { const float p = __builtin_amdgcn_exp2f(sc[s][rg] - m); sc[s][rg] = p; l += p; }
  { auto rr = __builtin_amdgcn_permlane32_swap(__float_as_uint(l), __float_as_uint(l), false, false); l = __uint_as_float(rr[0]) + __uint_as_float(rr[1]); }
  f32x16 o[2]; o[0] = f32x16{}; o[1] = f32x16{};
  const lds_cptr w3 = (lds_cptr)wlds;
  const lds_cptr vrd = w3 + ((lane >> 4) & 1) * 32 + (lane & 3) * 8 + (4 * hi + ((lane & 15) >> 2)) * 64;
  #pragma unroll
  for (int s = 0; s < 5; ++s) {
    const int kb = qi - 2 + s;
    if (kb >= 0 && kb < nblk) {
      u32x4 vv[4];
      #pragma unroll
      for (int i = 0; i < 4; ++i) { const int c = i * 64 + lane, row = c >> 3, ch = c & 7; const long tv = row0 + (long)(32 * kb + row) * dil + r;
        vv[i] = *reinterpret_cast<const u32x4*>(P1 + tv * pitch + colv + ch * 8); }
      asm volatile("s_waitcnt lgkmcnt(0)" ::: "memory");
      #pragma unroll
      for (int i = 0; i < 4; ++i) { const int c = i * 64 + lane, row = c >> 3, ch = c & 7; *(LAS u32x4*)((LAS char*)wlds + (ch >> 2) * 2048 + row * 64 + (ch & 3) * 16) = vv[i]; }
      asm volatile("s_waitcnt lgkmcnt(0)" ::: "memory");
      #pragma unroll
      for (int ks = 0; ks < 2; ++ks) {
        u32x4 pw; pw[0] = cvtpk_s(sc[s][8 * ks + 0], sc[s][8 * ks + 1]); pw[1] = cvtpk_s(sc[s][8 * ks + 2], sc[s][8 * ks + 3]); pw[2] = cvtpk_s(sc[s][8 * ks + 4], sc[s][8 * ks + 5]); pw[3] = cvtpk_s(sc[s][8 * ks + 6], sc[s][8 * ks + 7]);
        const bf16x8 pa = __builtin_bit_cast(bf16x8, pw);
        #pragma unroll
        for (int d0 = 0; d0 < 2; ++d0) {
          const s16x4 lo = vtr(vrd + d0 * 2048 + ks * 1024), hh = vtr(vrd + d0 * 2048 + ks * 1024 + 512);
          const bf16x8 vf = (bf16x8){lo[0], lo[1], lo[2], lo[3], hh[0], hh[1], hh[2], hh[3]};
          o[d0] = __builtin_amdgcn_mfma_f32_32x32x16_bf16(pa, vf, o[d0], 0, 0, 0); }
      }
    }
  }
  asm volatile("s_waitcnt lgkmcnt(0)" ::: "memory");
  float* wsf = (float*)(wlds + 4096);
  if (hi == 0) { wsf[r32] = l; const long tq = row0 + (long)(32 * qi + r32) * dil + r; lse[((long)g * NTOK + tq) * 8 + h] = m + __builtin_amdgcn_logf(l); }
  asm volatile("s_waitcnt lgkmcnt(0)" ::: "memory");
  float rli[16];
  #pragma unroll
  for (int rg = 0; rg < 16; ++rg) rli[rg] = __builtin_amdgcn_rcpf(wsf[crow(rg, hi)]);
  bf16* stg = (bf16*)wlds;
  #pragma unroll
  for (int rg = 0; rg < 16; ++rg) { const int orow = crow(rg, hi);
    #pragma unroll
    for (int d0 = 0; d0 < 2; ++d0) stg[orow * 64 + d0 * 32 + r32] = (bf16)f2bf(o[d0][rg] * rli[rg]); }
  asm volatile("s_waitcnt lgkmcnt(0)" ::: "memory");
  #pragma unroll
  for (int i = 0; i < 4; ++i) { const int row = i * 8 + (lane >> 3), ch = lane & 7; const u32x4 v = *(const u32x4*)(stg + row * 64 + ch * 8);
    const long tq = row0 + (long)(32 * qi + row) * dil + r; *(u32x4*)(Od + tq * opitch + colq + ch * 8) = v; }
  asm volatile("s_waitcnt lgkmcnt(0)" ::: "memory");
}

constexpr int BU_K = 0, BU_V = 49152, BU_W = 98304;
__device__ __forceinline__ void band_unit(const bf16* P1, bf16* Od, const long opitch, float* lse, const int b, const int g, const int h, const int u8, char* shm, const int tid) {
  const int lane = tid & 63, r32 = lane & 31, hi = lane >> 5; const int wid = __builtin_amdgcn_readfirstlane(tid >> 6);
  const long pitch = B_IN;
  const int colq = (g * 8 + h) * 64, colk = 1536 + colq, colv = 3072 + colq;
  const long row0 = (long)b * SEQ;
  const int dil = (g == 0) ? 1 : (g == 1 ? 4 : 16), Lr = SEQ / dil, nblk = Lr / 32;
  int rA, l0; if (g < 2) { const int upr = Lr / 256; rA = u8 / upr; l0 = (u8 % upr) * 256; } else { rA = 2 * u8; l0 = 0; }
  const int r_w = (g < 2) ? rA : rA + (wid >> 2), l_w = (g < 2) ? l0 + 32 * wid : 32 * (wid & 3);
  const unsigned lds0 = (unsigned)(uintptr_t)shm;
#pragma unroll
  for (int T = 0; T < 6; ++T) {
    int r_T, l_T; bool valid;
    if (g < 2) { l_T = l0 - 64 + 64 * T; r_T = rA; valid = (l_T >= 0) && (l_T < Lr); } else { valid = T < 4; r_T = rA + (T >> 1); l_T = 64 * (T & 1); }
    if (valid) {
      const bf16* ks = P1 + (row0 + (long)(l_T + lane) * dil + r_T) * pitch + colk + wid * 8;
      const bf16* vs = P1 + (row0 + (long)(l_T + 16 * (wid & 3) + (lane >> 2)) * dil + r_T) * pitch + colv + (wid >> 2) * 32 + (lane & 3) * 8;
      glds16(ks, (unsigned)__builtin_amdgcn_readfirstlane(lds0 + BU_K + T * 8192 + wid * 1024));
      glds16(vs, (unsigned)__builtin_amdgcn_readfirstlane(lds0 + BU_V + T * 8192 + wid * 1024));
    }
  }
  bf16x8 qf[4];
  { const long tq = row0 + (long)(l_w + r32) * dil + r_w; const bf16* qp = P1 + tq * pitch + colq + hi * 8;
    #pragma unroll
    for (int d0 = 0; d0 < 4; ++d0) qf[d0] = *reinterpret_cast<const bf16x8*>(qp + d0 * 16); }
  asm volatile("s_waitcnt vmcnt(0) lgkmcnt(0)\n\ts_barrier" ::: "memory");
  const lds_cptr s3 = (lds_cptr)shm;
  f32x16 sc[5];
  const int kb0 = l_w / 32 - 2;
  #pragma unroll
  for (int s = 0; s < 5; ++s) {
    const int kb = kb0 + s;
    if (kb >= 0 && kb < nblk) {
      const int st = (g < 2) ? (wid + s) : (4 * (wid >> 2) + kb);
      const lds_cptr kp = s3 + BU_K + (st >> 1) * 8192 + hi * 1024 + ((st & 1) * 32 + r32) * 16;
      f32x16 a = f32x16{};
      #pragma unroll
      for (int d0 = 0; d0 < 4; ++d0) { const bf16x8 kf = *(const LAS bf16x8*)(kp + d0 * 2048); a = __builtin_amdgcn_mfma_f32_32x32x16_bf16(kf, qf[d0], a, 0, 0, 0); }
      if (s == 0) {
        #pragma unroll
        for (int rg = 0; rg < 16; ++rg) { const int j = crow(rg, hi); if (j < r32) a[rg] = -INFINITY; } }
      if (s == 4) {
        #pragma unroll
        for (int rg = 0; rg < 16; ++rg) { const int j = crow(rg, hi); if (j > r32) a[rg] = -INFINITY; } }
      sc[s] = a;
    } else {
      #pragma unroll
      for (int rg = 0; rg < 16; ++rg) sc[s][rg] = -INFINITY;
    }
  }
  float m = -INFINITY;
  #pragma unroll
  for (int s = 0; s < 5; ++s)
    #pragma unroll
    for (int rg = 0; rg < 16; ++rg) m = __builtin_fmaxf(m, sc[s][rg]);
  { auto rr = __builtin_amdgcn_permlane32_swap(__float_as_uint(m), __float_as_uint(m), false, false); m = __builtin_fmaxf(__uint_as_float(rr[0]), __uint_as_float(rr[1])); }
  float l = 0.f;
  #pragma unroll
  for (int s = 0; s < 5; ++s)
    #pragma unroll
    for (int rg = 0; rg < 16; ++rg) { const float p = __builtin_amdgcn_exp2f(sc[s][rg] - m); sc[s][rg] = p; l += p; }
  { auto rr = __builtin_amdgcn_permlane32_swap(__float_as_uint(l), __float_as_uint(l), false, false); l = __uint_as_float(rr[0]) + __uint_as_float(rr[1]); }
  f32x16 o[2]; o[0] = f32x16{}; o[1] = f32x16{};
  const lds_cptr vrd = s3 + BU_V + ((lane >> 4) & 1) * 32 + (lane & 3) * 8 + (4 * hi + ((lane & 15) >> 2)) * 64;
  #pragma unroll
  for (int s = 0; s < 5; ++s) {
    const int kb = kb0 + s;
    if (kb >= 0 && kb < nblk) {
      const int st = (g < 2) ? (wid + s) : (4 * (wid >> 2) + kb);
      const lds_cptr vt = vrd + (st >> 1) * 8192 + (st & 1) * 2048;
      #pragma unroll
      for (int ks = 0; ks < 2; ++ks) {
        u32x4 pw; pw[0] = cvtpk_s(sc[s][8 * ks + 0], sc[s][8 * ks + 1]); pw[1] = cvtpk_s(sc[s][8 * ks + 2], sc[s][8 * ks + 3]); pw[2] = cvtpk_s(sc[s][8 * ks + 4], sc[s][8 * ks + 5]); pw[3] = cvtpk_s(sc[s][8 * ks + 6], sc[s][8 * ks + 7]);
        const bf16x8 pa = __builtin_bit_cast(bf16x8, pw);
        #pragma unroll
        for (int d0 = 0; d0 < 2; ++d0) {
          const s16x4 lo = vtr(vt + d0 * 4096 + ks * 1024), hh = vtr(vt + d0 * 4096 + ks * 1024 + 512);
          const bf16x8 vf = (bf16x8){lo[0], lo[1], lo[2], lo[3], hh[0], hh[1], hh[2], hh[3]};
          o[d0] = __builtin_amdgcn_mfma_f32_32x32x16_bf16(pa, vf, o[d0], 0, 0, 0); }
      }
    }
  }
  char* wl = shm + BU_W + wid * 4096;
  float* wsf = (float*)wl;
  if (hi == 0) { wsf[r32] = l; const long tq = row0 + (long)(l_w + r32) * dil + r_w; lse[((long)g * NTOK + tq) * 8 + h] = m + __builtin_amdgcn_logf(l); }
  asm volatile("s_waitcnt lgkmcnt(0)" ::: "memory");
  float rli[16];
  #pragma unroll
  for (int rg = 0; rg < 16; ++rg) rli[rg] = __builtin_amdgcn_rcpf(wsf[crow(rg, hi)]);
  asm volatile("s_waitcnt lgkmcnt(0)" ::: "memory");
  bf16* stg = (bf16*)wl;
  #pragma unroll
  for (int rg = 0; rg < 16; ++rg) { const int orow = crow(rg, hi);
    #pragma unroll
    for (int d0 = 0; d0 < 2; ++d0) stg[orow * 64 + d0 * 32 + r32] = (bf16)f2bf(o[d0][rg] * rli[rg]); }
  asm volatile("s_waitcnt lgkmcnt(0)" ::: "memory");
  #pragma unroll
  for (int i = 0; i < 4; ++i) { const int row = i * 8 + (lane >> 3), ch = lane & 7; const u32x4 v = *(const u32x4*)(stg + row * 64 + ch * 8);
    const long tq = row0 + (long)(l_w + row) * dil + r_w; *(u32x4*)(Od + tq * opitch + colq + ch * 8) = v; }
  asm volatile("s_waitcnt lgkmcnt(0)\n\ts_barrier" ::: "memory");
}

struct BandGeo { int g, h, dil, Lr, nblk, rA, l0, r_w, l_w; long row0; int colq; };
__device__ __forceinline__ BandGeo band_geo(const int U, const int wid) {
  BandGeo G; const int u8 = U & 7, bhg = U >> 3; G.g = bhg % 3; const int bh = bhg / 3; G.h = bh & 7; const int b = bh >> 3;
  G.dil = (G.g == 0) ? 1 : (G.g == 1 ? 4 : 16); G.Lr = SEQ / G.dil; G.nblk = G.Lr / 32;
  if (G.g < 2) { const int upr = G.Lr / 256; G.rA = u8 / upr; G.l0 = (u8 % upr) * 256; G.r_w = G.rA; G.l_w = G.l0 + 32 * wid; }
  else { G.rA = 2 * u8; G.l0 = 0; G.r_w = G.rA + (wid >> 2); G.l_w = 32 * (wid & 3); }
  G.row0 = (long)b * SEQ; G.colq = (G.g * 8 + G.h) * 64; return G;
}
template <bool ISV> __device__ __forceinline__ void band_stage(const bf16* P1, const BandGeo& G, const unsigned lds0, const int wid, const int lane) {
#pragma unroll
  for (int T = 0; T < 6; ++T) {
    int r_T, l_T; bool valid;
    if (G.g < 2) { l_T = G.l0 - 64 + 64 * T; r_T = G.rA; valid = (l_T >= 0) && (l_T < G.Lr); } else { valid = T < 4; r_T = G.rA + (T >> 1); l_T = 64 * (T & 1); }
    if (valid) {
      if (!ISV) { const bf16* ks = P1 + (G.row0 + (long)(l_T + lane) * G.dil + r_T) * (long)B_IN + 1536 + G.colq + wid * 8;
        glds16(ks, (unsigned)__builtin_amdgcn_readfirstlane(lds0 + BU_K + T * 8192 + wid * 1024)); }
      else { const bf16* vs = P1 + (G.row0 + (long)(l_T + 16 * (wid & 3) + (lane >> 2)) * G.dil + r_T) * (long)B_IN + 3072 + G.colq + (wid >> 2) * 32 + (lane & 3) * 8;
        glds16(vs, (unsigned)__builtin_amdgcn_readfirstlane(lds0 + BU_V + T * 8192 + wid * 1024)); }
    }
  }
}
__device__ __forceinline__ void band_phase(const bf16* P1, float* lse, const int U0, const int NU, char* shm, const int tid) {
  const int lane = tid & 63, r32 = lane & 31, hi = lane >> 5; const int wid = __builtin_amdgcn_readfirstlane(tid >> 6);
  const long pitch = B_IN;
  const unsigned lds0 = (unsigned)(uintptr_t)shm;
  const lds_cptr s3 = (lds_cptr)shm;
  BandGeo G = band_geo(U0, wid);
  band_stage<false>(P1, G, lds0, wid, lane); band_stage<true>(P1, G, lds0, wid, lane);
  bf16x8 qf[4], qn[4];
  { const long tq = G.row0 + (long)(G.l_w + r32) * G.dil + G.r_w; const bf16* qp = P1 + tq * pitch + G.colq + hi * 8;
    #pragma unroll
    for (int d0 = 0; d0 < 4; ++d0) qf[d0] = *reinterpret_cast<const bf16x8*>(qp + d0 * 16); }
  asm volatile("s_waitcnt vmcnt(0) lgkmcnt(0)\n\ts_barrier" ::: "memory");
#pragma unroll 1
  for (int i = 0; i < NU; ++i) {
    f32x16 sc[5];
    const int kb0 = G.l_w / 32 - 2;
    #pragma unroll
    for (int s = 0; s < 5; ++s) {
      const int kb = kb0 + s;
      if (kb >= 0 && kb < G.nblk) {
        const int st = (G.g < 2) ? (wid + s) : (4 * (wid >> 2) + kb);
        const lds_cptr kp = s3 + BU_K + (st >> 1) * 8192 + hi * 1024 + ((st & 1) * 32 + r32) * 16;
        f32x16 a = f32x16{};
        #pragma unroll
        for (int d0 = 0; d0 < 4; ++d0) { const bf16x8 kf = *(const LAS bf16x8*)(kp + d0 * 2048); a = __builtin_amdgcn_mfma_f32_32x32x16_bf16(kf, qf[d0], a, 0, 0, 0); }
        if (s == 0) {
          #pragma unroll
          for (int rg = 0; rg < 16; ++rg) { const int j = crow(rg, hi); if (j < r32) a[rg] = -INFINITY; } }
        if (s == 4) {
          #pragma unroll
          for (int rg = 0; rg < 16; ++rg) { const int j = crow(rg, hi); if (j > r32) a[rg] = -INFINITY; } }
        sc[s] = a;
      } else {
        #pragma unroll
        for (int rg = 0; rg < 16; ++rg) sc[s][rg] = -INFINITY;
      }
    }
    float m = -INFINITY;
    #pragma unroll
    for (int s = 0; s < 5; ++s)
      #pragma unroll
      for (int rg = 0; rg < 16; ++rg) m = __builtin_fmaxf(m, sc[s][rg]);
    { auto rr = __builtin_amdgcn_permlane32_swap(__float_as_uint(m), __float_as_uint(m), false, false); m = __builtin_fmaxf(__uint_as_float(rr[0]), __uint_as_float(rr[1])); }
    float l = 0.f;
    #pragma unroll
    for (int s = 0; s < 5; ++s)
      #pragma unroll
      for (int rg = 0; rg < 16; ++rg) { const float p = __builtin_amdgcn_exp2f(sc[s][rg] - m); sc[s][rg] = p; l += p; }
    { auto rr = __builtin_amdgcn_permlane32_swap(__float_as_uint(l), __float_as_uint(l), false, false); l = __uint_as_float(rr[0]) + __uint_as_float(rr[1]); }
    asm volatile("s_waitcnt vmcnt(0) lgkmcnt(0)\n\ts_barrier" ::: "memory");
    const bool more = (i + 1 < NU);
    BandGeo Gn = G;
    if (more) { Gn = band_geo(U0 + i + 1, wid); band_stage<false>(P1, Gn, lds0, wid, lane);
      const long tq = Gn.row0 + (long)(Gn.l_w + r32) * Gn.dil + Gn.r_w; const bf16* qp = P1 + tq * pitch + Gn.colq + hi * 8;
      #pragma unroll
      for (int d0 = 0; d0 < 4; ++d0) qn[d0] = *reinterpret_cast<const bf16x8*>(qp + d0 * 16); }
    f32x16 o[2]; o[0] = f32x16{}; o[1] = f32x16{};
    const lds_cptr vrd = s3 + BU_V + ((lane >> 4) & 1) * 32 + (lane & 3) * 8 + (4 * hi + ((lane & 15) >> 2)) * 64;
    #pragma unroll
    for (int s = 0; s < 5; ++s) {
      const int kb = kb0 + s;
      if (kb >= 0 && kb < G.nblk) {
        const int st = (G.g < 2) ? (wid + s) : (4 * (wid >> 2) + kb);
        const lds_cptr vt = vrd + (st >> 1) * 8192 + (st & 1) * 2048;
        #pragma unroll
        for (int ks = 0; ks < 2; ++ks) {
          u32x4 pw; pw[0] = cvtpk_s(sc[s][8 * ks + 0], sc[s][8 * ks + 1]); pw[1] = cvtpk_s(sc[s][8 * ks + 2], sc[s][8 * ks + 3]); pw[2] = cvtpk_s(sc[s][8 * ks + 4], sc[s][8 * ks + 5]); pw[3] = cvtpk_s(sc[s][8 * ks + 6], sc[s][8 * ks + 7]);
          const bf16x8 pa = __builtin_bit_cast(bf16x8, pw);
          #pragma unroll
          for (int d0 = 0; d0 < 2; ++d0) {
            const s16x4 lo = vtr(vt + d0 * 4096 + ks * 1024), hh = vtr(vt + d0 * 4096 + ks * 1024 + 512);
            const bf16x8 vf = (bf16x8){lo[0], lo[1], lo[2], lo[3], hh[0], hh[1], hh[2], hh[3]};
            o[d0] = __builtin_amdgcn_mfma_f32_32x32x16_bf16(pa, vf, o[d0], 0, 0, 0); }
        }
      }
    }
    char* wl = shm + BU_W + wid * 4096;
    float* wsf = (float*)wl;
    if (hi == 0) { wsf[r32] = l; const long tq = G.row0 + (long)(G.l_w + r32) * G.dil + G.r_w;
      __hip_atomic_store((unsigned*)(lse + ((long)G.g * NTOK + tq) * 8 + G.h), __float_as_uint(m + __builtin_amdgcn_logf(l)), __ATOMIC_RELAXED, __HIP_MEMORY_SCOPE_AGENT); }
    asm volatile("s_waitcnt lgkmcnt(0)" ::: "memory");
    float rli[16];
    #pragma unroll
    for (int rg = 0; rg < 16; ++rg) rli[rg] = __builtin_amdgcn_rcpf(wsf[crow(rg, hi)]);
    asm volatile("s_waitcnt lgkmcnt(0)" ::: "memory");
    bf16* stg = (bf16*)wl;
    #pragma unroll
    for (int rg = 0; rg < 16; ++rg) { const int orow = crow(rg, hi);
      #pragma unroll
      for (int d0 = 0; d0 < 2; ++d0) stg[orow * 64 + d0 * 32 + r32] = (bf16)f2bf(o[d0][rg] * rli[rg]); }
    asm volatile("s_waitcnt lgkmcnt(0)" ::: "memory");
    #pragma unroll
    for (int k = 0; k < 4; ++k) { const int row = k * 8 + (lane >> 3), ch = lane & 7; const u32x4 v = *(const u32x4*)(stg + row * 64 + ch * 8);
      const long tq = G.row0 + (long)(G.l_w + row) * G.dil + G.r_w; store16_sc1(const_cast<bf16*>(P1) + tq * pitch + G.colq + ch * 8, v); }
    asm volatile("s_waitcnt vmcnt(0) lgkmcnt(0)\n\ts_barrier" ::: "memory");
    if (more) { band_stage<true>(P1, Gn, lds0, wid, lane);
      #pragma unroll
      for (int d0 = 0; d0 < 4; ++d0) qf[d0] = qn[d0]; }
    G = Gn;
  }
}
#undef SBAR
}

struct Args { const float* in[18]; float* out; unsigned char* ws; int ph_lo, ph_hi; };
struct Frame {
    LAS unsigned char* lds; volatile LAS unsigned* MISC; gu32* ctl;
    int tid, lane, wave, vcu, G, bx;
    unsigned char* ws;
};

__device__ __forceinline__ void transpose_item(const float* W, int K, int N, bf16_t* WT, int k0, int n0, int drow0, LAS unsigned* T, int lane, int dstep = 32) {
    const int n4 = (lane & 15) * 4, rp = lane >> 4;
    f32x4 a[8], b[8];
#pragma unroll
    for (int i = 0; i < 8; ++i) { const float* p = W + (size_t)(k0 + 8 * i + 2 * rp) * N + n0 + n4; a[i] = __builtin_nontemporal_load((const GAS f32x4*)p); b[i] = __builtin_nontemporal_load((const GAS f32x4*)(p + N)); }
#pragma unroll
    for (int i = 0; i < 8; ++i)
#pragma unroll
        for (int j = 0; j < 4; ++j) T[(n4 + j) * 33 + 4 * i + rp] = pk2(a[i][j], b[i][j]);
    LDS_WAIT(); asm volatile("" ::: "memory");
    const int c = lane & 7;
#pragma unroll
    for (int j = 0; j < 8; ++j) { const int n = (lane >> 3) + 8 * j; const LAS unsigned* s = T + n * 33 + 4 * c;
        u32x4 o; o.x = s[0]; o.y = s[1]; o.z = s[2]; o.w = s[3];
        *(GAS u32x4*)(WT + (size_t)(drow0 + (n & 31) + (n >> 5) * dstep) * K + k0 + 8 * c) = o; }
    LDS_WAIT(); asm volatile("" ::: "memory");
}
struct TrDesc { const float* W; int K, N; bf16_t* WT; int k0, n0, drow0; };
__device__ __forceinline__ void tr_load(const TrDesc& d, f32x4 (&a)[8], f32x4 (&b)[8], int lane) {
    const int n4 = (lane & 15) * 4, rp = lane >> 4;
#pragma unroll
    for (int i = 0; i < 8; ++i) { const float* p = d.W + (size_t)(d.k0 + 8 * i + 2 * rp) * d.N + d.n0 + n4; a[i] = __builtin_nontemporal_load((const GAS f32x4*)p); b[i] = __builtin_nontemporal_load((const GAS f32x4*)(p + d.N)); }
}
__device__ __forceinline__ void tr_finish(const TrDesc& d, const f32x4 (&a)[8], const f32x4 (&b)[8], LAS unsigned* T, int lane) {
    const int n4 = (lane & 15) * 4, rp = lane >> 4;
#pragma unroll
    for (int i = 0; i < 8; ++i)
#pragma unroll
        for (int j = 0; j < 4; ++j) T[(n4 + j) * 33 + 4 * i + rp] = pk2(a[i][j], b[i][j]);
    LDS_WAIT(); asm volatile("" ::: "memory");
    const int c = lane & 7;
#pragma unroll
    for (int j = 0; j < 8; ++j) { const int n = (lane >> 3) + 8 * j; const LAS unsigned* s = T + n * 33 + 4 * c;
        u32x4 o; o.x = s[0]; o.y = s[1]; o.z = s[2]; o.w = s[3];
        *(GAS u32x4*)(d.WT + (size_t)(d.drow0 + n) * d.K + d.k0 + 8 * c) = o; }
    LDS_WAIT(); asm volatile("" ::: "memory");
}
__device__ __forceinline__ TrDesc moe_item_desc(Frame& F, const float* wg, const float* wu, const float* wd, int layer, int it) {
    bf16_t* WGU = (bf16_t*)(F.ws + ws_wgu(layer)); bf16_t* WD = (bf16_t*)(F.ws + ws_wd(layer));
    const int job = it >> 7, loc = it & 127, e = job / 3, kind = job % 3; TrDesc d;
    if (kind < 2) { d.W = (kind == 0 ? wg : wu) + ((size_t)layer * NEXP + e) * DM * DEXP; d.K = DM; d.N = DEXP; d.WT = WGU + (size_t)e * 1024 * DM;
        const int kb = loc >> 3, nb = loc & 7, n0 = 64 * nb; d.k0 = 64 * kb; d.n0 = n0; d.drow0 = 256 * (n0 >> 7) + (n0 & 127) + (kind ? 128 : 0); }
    else { d.W = wd + ((size_t)layer * NEXP + e) * DEXP * DM; d.K = DEXP; d.N = DM; d.WT = WD + (size_t)e * DM * DEXP; const int kb = loc >> 4, nb = loc & 15; d.k0 = 64 * kb; d.n0 = 64 * nb; d.drow0 = 64 * nb; }
    return d;
}
__device__ __forceinline__ void moe_convert6(Frame& F, const float* wg, const float* wu, const float* wd, LAS unsigned* T, int gw, int NGW) {
    f32x4 a0[8], b0[8], a1[8], b1[8];
    TrDesc d0 = moe_item_desc(F, wg, wu, wd, 0, gw), d1 = d0;
    tr_load(d0, a0, b0, F.lane);
#pragma unroll 1
    for (int k = 0; k < 6; k += 2) {
        { const int k1 = k + 1; d1 = moe_item_desc(F, wg, wu, wd, k1 / 3, gw + NGW * (k1 % 3)); tr_load(d1, a1, b1, F.lane); }
        tr_finish(d0, a0, b0, T, F.lane);
        if (k + 2 < 6) { const int k2 = k + 2; d0 = moe_item_desc(F, wg, wu, wd, k2 / 3, gw + NGW * (k2 % 3)); tr_load(d0, a0, b0, F.lane); }
        tr_finish(d1, a1, b1, T, F.lane);
    }
}
__device__ __forceinline__ void transpose_plain(const float* W, int K, int N, bf16_t* WT, int item, LAS unsigned* T, int lane) {
    const int nblk = N / 64, kb = item / nblk, nb = item % nblk; transpose_item(W, K, N, WT, 64 * kb, 64 * nb, 64 * nb, T, lane);
}
__device__ __forceinline__ void transpose_heads(const float* W, int K, int N, bf16_t* WT, int item, LAS unsigned* T, int lane) {
    const int nblk = N / 64, kb = item / nblk, nb = item % nblk; transpose_item(W, K, N, WT, 64 * kb, 64 * nb, 256 * (nb >> 2) + 32 * (nb & 3), T, lane, 128);
}
__device__ __forceinline__ void moe_weight_items(Frame& F, const float* wg, const float* wu, const float* wd, int layer, LAS unsigned* T, int it0, int it1, int step) {
    bf16_t* WGU = (bf16_t*)(F.ws + ws_wgu(layer)); bf16_t* WD = (bf16_t*)(F.ws + ws_wd(layer));
    for (int it = it0; it < it1 && it < 48 * 128; it += step) {
        const int job = it >> 7, loc = it & 127, e = job / 3, kind = job % 3;
        if (kind < 2) { const float* W = (kind == 0 ? wg : wu) + ((size_t)layer * NEXP + e) * DM * DEXP;
            const int kb = loc >> 3, nb = loc & 7, n0 = 64 * nb; const int drow0 = 256 * (n0 >> 7) + (n0 & 127) + (kind ? 128 : 0);
            transpose_item(W, DM, DEXP, WGU + (size_t)e * 1024 * DM, 64 * kb, n0, drow0, T, F.lane);
        } else { const float* W = wd + ((size_t)layer * NEXP + e) * DEXP * DM;
            const int kb = loc >> 4, nb = loc & 15; transpose_item(W, DEXP, DM, WD + (size_t)e * DM * DEXP, 64 * kb, 64 * nb, 64 * nb, T, F.lane); }
    }
}
__device__ __forceinline__ void cvt_rows_bf16(Frame& F, const float* src, bf16_t* dst, size_t n) {
    const size_t gt = (size_t)(F.vcu * NWAVES + F.wave) * 64 + F.lane, NT_ = (size_t)F.G * NWAVES * 64;
    for (size_t i = gt; i < n / 8; i += NT_) { const f32x4 a = __builtin_nontemporal_load((const GAS f32x4*)(src + i * 8)), b = __builtin_nontemporal_load((const GAS f32x4*)(src + i * 8 + 4));
        u32x4 o; o.x = pk2(a.x, a.y); o.y = pk2(a.z, a.w); o.z = pk2(b.x, b.y); o.w = pk2(b.z, b.w); *(GAS u32x4*)(dst + i * 8) = o; }
}

#define FSTAMP(F, k) do { if (PROBE_K >= 0 && (F).bx == 0 && (F).tid == 0) ((volatile LAS unsigned long long*)((F).lds + SCHED_OFF + 512))[(k)] = __builtin_amdgcn_s_memrealtime(); } while (0)
__device__ __forceinline__ int sel4i(int k, int a0, int a1, int a2, int a3) { return k == 0 ? a0 : (k == 1 ? a1 : (k == 2 ? a2 : a3)); }
__device__ __forceinline__ float sel4f(int k, float a0, float a1, float a2, float a3) { return k == 0 ? a0 : (k == 1 ? a1 : (k == 2 ? a2 : a3)); }

__device__ __forceinline__ void ln1_router_phase(Frame& F, const bf16_t* zx, const float* lng, const float* lnb, const float* rw, const float* rb, int layer, bool dummy, const int rbase) {
    constexpr int XP = 1032;
    LAS bf16_t* rwT = (LAS bf16_t*)(F.lds + RING_OFF);
    LAS bf16_t* xbuf = (LAS bf16_t*)(F.lds + RING_OFF + 33792) + F.wave * 4 * XP;
    LAS int* lcnt = (LAS int*)(F.lds + RING_OFF + 102400);
    LAS int* lbase = lcnt + 16;
    LAS int* rec = lcnt + 64;
    LAS float* recw = (LAS float*)(rec + 256);
    LAS float* lgt = (LAS float*)(F.lds + RING_OFF + 102400 + 4096);
    for (int idx = F.tid; idx < 16384; idx += 512) { const int k = idx >> 4, e = idx & 15; rwT[e * XP + k] = (bf16_t)f2bf(rw[idx]); }
    if (F.tid < 16) lcnt[F.tid] = 0;
    if (layer == 0) FSTAMP(F, 20);
    __syncthreads();
    if (layer == 0) FSTAMP(F, 21);
    bf16_t* XB = (bf16_t*)(F.ws + WS_XB); (void)dummy;
    const int lane = F.lane;
    f32x4 gv[4], bv[4];
#pragma unroll
    for (int j = 0; j < 4; ++j) { gv[j] = *(const GAS f32x4*)(lng + 4 * lane + 256 * j); bv[j] = *(const GAS f32x4*)(lnb + 4 * lane + 256 * j); }
    const int row0 = rbase + F.wave * 8;
    u32x2 zc[2][4], zn[2][4], zm[2][4];
#define LN1_LOAD(dst, ip) do { _Pragma("unroll") for (int r_ = 0; r_ < 2; ++r_) { const int ri_ = 2 * (ip) + r_ < 8 ? 2 * (ip) + r_ : 7; \
        _Pragma("unroll") for (int j = 0; j < 4; ++j) dst[r_][j] = __builtin_nontemporal_load((const GAS u32x2*)(zx + (size_t)(row0 + ri_) * DM + 4 * lane + 256 * j)); } } while (0)
    LN1_LOAD(zc, 0); LN1_LOAD(zn, 1); LN1_LOAD(zm, 2);
#pragma unroll 1
    for (int ip = 0; ip < 4; ++ip) {
        f32x4 v[2][4]; float s[2] = {0.f, 0.f}, qq[2] = {0.f, 0.f};
#pragma unroll
        for (int r = 0; r < 2; ++r)
#pragma unroll
            for (int j = 0; j < 4; ++j) { const u32x2 zw = zc[r][j]; v[r][j] = (f32x4){bflo(zw.x), bfhi(zw.x), bflo(zw.y), bfhi(zw.y)};
                s[r] += (v[r][j].x + v[r][j].y) + (v[r][j].z + v[r][j].w); qq[r] += (v[r][j].x * v[r][j].x + v[r][j].y * v[r][j].y) + (v[r][j].z * v[r][j].z + v[r][j].w * v[r][j].w); }
#pragma unroll
        for (int r = 0; r < 2; ++r)
#pragma unroll
            for (int j = 0; j < 4; ++j) { zc[r][j] = zn[r][j]; zn[r][j] = zm[r][j]; }
        LN1_LOAD(zm, ip + 3);
        float mean[2], rstd[2];
        { const float t0 = wave_sum_dpp(s[0]), t1 = wave_sum_dpp(s[1]), u0 = wave_sum_dpp(qq[0]), u1 = wave_sum_dpp(qq[1]);
          mean[0] = t0 * (1.f / DM); mean[1] = t1 * (1.f / DM);
          rstd[0] = __builtin_amdgcn_rsqf(fmaxf(u0 * (1.f / DM) - mean[0] * mean[0], 0.f) + NORM_EPS); rstd[1] = __builtin_amdgcn_rsqf(fmaxf(u1 * (1.f / DM) - mean[1] * mean[1], 0.f) + NORM_EPS); }
#pragma unroll
        for (int r = 0; r < 2; ++r)
#pragma unroll
            for (int j = 0; j < 4; ++j) { v[r][j] = (v[r][j] - mean[r]) * rstd[r] * gv[j] + bv[j];
                u32x2 o; o.x = pk2(v[r][j].x, v[r][j].y); o.y = pk2(v[r][j].z, v[r][j].w); *(GAS u32x2*)(XB + (size_t)(row0 + 2 * ip + r) * DM + 4 * lane + 256 * j) = o;
                *(LAS u32x2*)(xbuf + (2 * (ip & 1) + r) * XP + 4 * lane + 256 * j) = o; }
        if ((ip & 1) == 1) {
            LDS_WAIT(); asm volatile("" ::: "memory");
            f32x4 lacc = {0.f, 0.f, 0.f, 0.f};
            const LAS bf16_t* ap = xbuf + ((lane & 15) & 3) * XP + 8 * (lane >> 4); const LAS bf16_t* bp = rwT + (lane & 15) * XP + 8 * (lane >> 4);
#pragma unroll 8
            for (int s = 0; s < 32; ++s) { const bf16x8 af = *(const LAS bf16x8*)(ap + 32 * s), bfr = *(const LAS bf16x8*)(bp + 32 * s); lacc = __builtin_amdgcn_mfma_f32_16x16x32_bf16(af, bfr, lacc, 0, 0, 0); }
            if (lane < 16) {
#pragma unroll
                for (int rg = 0; rg < 4; ++rg) lgt[(F.wave * 8 + 4 * (ip >> 1) + rg) * 16 + lane] = lacc[rg]; }
            LDS_WAIT(); asm volatile("" ::: "memory");
        }
    }
#undef LN1_LOAD
    if (layer == 0) FSTAMP(F, 22);
    LDS_WAIT(); asm volatile("" ::: "memory");
    if (lane < 8) {
        const int lrow = F.wave * 8 + lane;
        float aff[16], sel[16];
#pragma unroll
        for (int q = 0; q < 4; ++q) { const f32x4 lg = *(const LAS f32x4*)(lgt + lrow * 16 + 4 * q);
#pragma unroll
            for (int c = 0; c < 4; ++c) { const int e = 4 * q + c; aff[e] = 1.f / (1.f + __expf(-lg[c])); sel[e] = aff[e] + rb[e]; } }
        float gs[4];
#pragma unroll
        for (int g = 0; g < 4; ++g) { const float a = sel[4 * g], b = sel[4 * g + 1], c = sel[4 * g + 2], d = sel[4 * g + 3];
            const float mx1 = fmaxf(fmaxf(a, b), fmaxf(c, d));
            const float mn_ab = fminf(a, b), mx_ab = fmaxf(a, b), mn_cd = fminf(c, d), mx_cd = fmaxf(c, d);
            const float second = fmaxf(fminf(mx_ab, mx_cd), fmaxf(mn_ab, mn_cd));
            gs[g] = mx1 + second; }
        int best = 0; float bsc = gs[0];
#pragma unroll
        for (int g = 1; g < 4; ++g) if (gs[g] > bsc) { bsc = gs[g]; best = g; }
        const float s0 = sel4f(best, sel[0], sel[4], sel[8], sel[12]), s1 = sel4f(best, sel[1], sel[5], sel[9], sel[13]), s2_ = sel4f(best, sel[2], sel[6], sel[10], sel[14]), s3 = sel4f(best, sel[3], sel[7], sel[11], sel[15]);
        const float a0 = sel4f(best, aff[0], aff[4], aff[8], aff[12]), a1 = sel4f(best, aff[1], aff[5], aff[9], aff[13]), a2 = sel4f(best, aff[2], aff[6], aff[10], aff[14]), a3 = sel4f(best, aff[3], aff[7], aff[11], aff[15]);
        int i0 = 0; float m0 = s0; if (s1 > m0) { m0 = s1; i0 = 1; } if (s2_ > m0) { m0 = s2_; i0 = 2; } if (s3 > m0) { m0 = s3; i0 = 3; }
        int i1 = -1; float m1 = -INFINITY;
        if (i0 != 0 && s0 > m1) { m1 = s0; i1 = 0; } if (i0 != 1 && s1 > m1) { m1 = s1; i1 = 1; } if (i0 != 2 && s2_ > m1) { m1 = s2_; i1 = 2; } if (i0 != 3 && s3 > m1) { m1 = s3; i1 = 3; }
        const float w0r = sel4f(i0, a0, a1, a2, a3), w1r = sel4f(i1, a0, a1, a2, a3); const float inv = 1.f / (w0r + w1r);
        const int e0 = 4 * best + i0, e1 = 4 * best + i1;
        const int r0 = __hip_atomic_fetch_add(lcnt + e0, 1, __ATOMIC_RELAXED, __HIP_MEMORY_SCOPE_WORKGROUP), r1 = __hip_atomic_fetch_add(lcnt + e1, 1, __ATOMIC_RELAXED, __HIP_MEMORY_SCOPE_WORKGROUP);
        rec[lrow * 4 + 0] = e0; rec[lrow * 4 + 1] = e1; rec[lrow * 4 + 2] = r0; rec[lrow * 4 + 3] = r1; recw[lrow * 2 + 0] = w0r * inv; recw[lrow * 2 + 1] = w1r * inv;
    }
    __syncthreads();
    if (F.tid < 16) { const int n = lcnt[F.tid]; lbase[F.tid] = n ? (int)__hip_atomic_fetch_add((unsigned*)(F.ctl + CW_CNT + (layer * 16 + F.tid) * 64), (unsigned)n, RLX_AGENT) : 0; }
    __syncthreads();
    if (F.tid < 128) { const int lrow = F.tid >> 1, sl = F.tid & 1; const int e = rec[lrow * 4 + sl], rk = rec[lrow * 4 + 2 + sl]; const int pos = lbase[e] + rk; const int row = rbase + lrow;
        int* rowmap = (int*)(F.ws + WS_ROWMAP); float* roww = (float*)(F.ws + WS_ROWW);
        rowmap[(size_t)e * RCAP + pos] = row * 2 + sl; roww[(size_t)e * RCAP + pos] = recw[lrow * 2 + sl]; }
    __syncthreads();
    if (layer == 0) FSTAMP(F, 23);
}

__device__ __forceinline__ void ln2_phase(Frame& F, float* fout, const float* lng, const float* lnb, bool write_bf, int layer) {
    const bf16_t* Y = (const bf16_t*)(F.ws + ws_y(layer)); bf16_t* XB = (bf16_t*)(F.ws + WS_XB);
    const int lane = F.lane;
    f32x4 gv[4], bv[4];
#pragma unroll
    for (int j = 0; j < 4; ++j) { gv[j] = *(const GAS f32x4*)(lng + 4 * lane + 256 * j); bv[j] = *(const GAS f32x4*)(lnb + 4 * lane + 256 * j); }
    const int row0 = F.vcu * 64 + F.wave * 8;
    u32x2 xa[3][4], ya[3][4], yb[3][4];
#define LN2_LOAD(k, i) do { const int r_ = row0 + ((i) < 8 ? (i) : 7); _Pragma("unroll") for (int j = 0; j < 4; ++j) { xa[k][j] = __builtin_nontemporal_load((const GAS u32x2*)(XB + (size_t)r_ * DM + 4 * lane + 256 * j)); \
        ya[k][j] = __builtin_nontemporal_load((const GAS u32x2*)(Y + (size_t)r_ * DM + 4 * lane + 256 * j)); yb[k][j] = __builtin_nontemporal_load((const GAS u32x2*)(Y + ((size_t)NTOK + r_) * DM + 4 * lane + 256 * j)); } } while (0)
    LN2_LOAD(0, 0); LN2_LOAD(1, 1); LN2_LOAD(2, 2);
#pragma unroll 1
    for (int i = 0; i < 8; ++i) {
        const int row = row0 + i;
        f32x4 v[4]; float s = 0.f;
#pragma unroll
        for (int j = 0; j < 4; ++j) { const u32x2 xw = xa[0][j]; const f32x4 x = (f32x4){bflo(xw.x), bfhi(xw.x), bflo(xw.y), bfhi(xw.y)}; const u32x2 y0 = ya[0][j], y1 = yb[0][j];
            v[j].x = x.x * ALPHA + (bflo(y0.x) + bflo(y1.x)); v[j].y = x.y * ALPHA + (bfhi(y0.x) + bfhi(y1.x)); v[j].z = x.z * ALPHA + (bflo(y0.y) + bflo(y1.y)); v[j].w = x.w * ALPHA + (bfhi(y0.y) + bfhi(y1.y));
            s += (v[j].x + v[j].y) + (v[j].z + v[j].w); }
#pragma unroll
        for (int j = 0; j < 4; ++j) { xa[0][j] = xa[1][j]; ya[0][j] = ya[1][j]; yb[0][j] = yb[1][j]; xa[1][j] = xa[2][j]; ya[1][j] = ya[2][j]; yb[1][j] = yb[2][j]; }
        LN2_LOAD(2, i + 3);
        const float mean = wave_sum(s) * (1.f / DM); float s2 = 0.f;
#pragma unroll
        for (int j = 0; j < 4; ++j) { v[j] = v[j] - mean; s2 += (v[j].x * v[j].x + v[j].y * v[j].y) + (v[j].z * v[j].z + v[j].w * v[j].w); }
        const float rstd = __builtin_amdgcn_rsqf(wave_sum(s2) * (1.f / DM) + NORM_EPS);
#pragma unroll
        for (int j = 0; j < 4; ++j) { v[j] = v[j] * rstd * gv[j] + bv[j];
            if (fout) __builtin_nontemporal_store(v[j], (GAS f32x4*)(fout + (size_t)row * DM + 4 * lane + 256 * j));
            if (write_bf) { u32x2 o; o.x = pk2(v[j].x, v[j].y); o.y = pk2(v[j].z, v[j].w); *(GAS u32x2*)(XB + (size_t)row * DM + 4 * lane + 256 * j) = o; } }
    }
#undef LN2_LOAD
}

__device__ __forceinline__ void rope0_phase(Frame& F, const float* qn, const float* kn, const size_t dst_off) {
    bf16_t* P0 = (bf16_t*)(F.ws + ws_big(0)); const float* tab = (const float*)(F.ws + WS_TAB);
    const int lane = F.lane, head = lane >> 2, qd = lane & 3;
    const float* gn = (head < 12 ? qn : kn) + (qd * 16);
    float gnv[16];
#pragma unroll
    for (int d = 0; d < 16; ++d) gnv[d] = gn[d];
    const float osc = head < 12 ? C2 : 1.f;
    u32x4 pw0[8], pw1[8];
#pragma unroll
    for (int i = 0; i < 8; ++i) { const bf16_t* p = P0 + (size_t)(F.vcu * 64 + F.wave * 8 + i) * A_IN + head * 64 + qd * 16; pw0[i] = *(const GAS u32x4*)p; pw1[i] = *(const GAS u32x4*)(p + 8); }
#pragma unroll
    for (int i = 0; i < 8; ++i) {
        const int row = F.vcu * 64 + F.wave * 8 + i; const int t = row & (SEQ - 1);
        bf16_t* p = P0 + dst_off + (size_t)row * A_IN + head * 64 + qd * 16;
        const u32x4 w0 = pw0[i], w1 = pw1[i];
        float x[16];
        x[0] = bflo(w0.x); x[1] = bfhi(w0.x); x[2] = bflo(w0.y); x[3] = bfhi(w0.y); x[4] = bflo(w0.z); x[5] = bfhi(w0.z); x[6] = bflo(w0.w); x[7] = bfhi(w0.w);
        x[8] = bflo(w1.x); x[9] = bfhi(w1.x); x[10] = bflo(w1.y); x[11] = bfhi(w1.y); x[12] = bflo(w1.z); x[13] = bfhi(w1.z); x[14] = bflo(w1.w); x[15] = bfhi(w1.w);
        float ss = 0.f;
#pragma unroll
        for (int d = 0; d < 16; ++d) ss += x[d] * x[d];
        ss += __shfl_xor(ss, 1); ss += __shfl_xor(ss, 2);
        const float rs = __builtin_amdgcn_rsqf(ss * (1.f / 64.f) + NORM_EPS);
        const float* ct = (qd < 2) ? tab + TB_ROWC + (t >> 6) * 16 : tab + TB_COLC + (t & 63) * 16;
        const float* st = (qd < 2) ? tab + TB_ROWS + (t >> 6) * 16 : tab + TB_COLS + (t & 63) * 16;
        float y[16];
#pragma unroll
        for (int d = 0; d < 16; ++d) { const float xn = x[d] * rs * gnv[d]; const float xp = __shfl_xor(xn, 1);
            const float c = ct[d], sn = st[d];
            y[d] = ((qd & 1) ? (xn * c + xp * sn) : (xn * c - xp * sn)) * osc; }
        u32x4 o0, o1;
        o0.x = pk2(y[0], y[1]); o0.y = pk2(y[2], y[3]); o0.z = pk2(y[4], y[5]); o0.w = pk2(y[6], y[7]); o1.x = pk2(y[8], y[9]); o1.y = pk2(y[10], y[11]); o1.z = pk2(y[12], y[13]); o1.w = pk2(y[14], y[15]);
        *(GAS u32x4*)p = o0; *(GAS u32x4*)(p + 8) = o1;
    }
}
__device__ __forceinline__ void rope1_phase(Frame& F) {
    bf16_t* P1 = (bf16_t*)(F.ws + ws_big(1)); const float* tab = (const float*)(F.ws + WS_TAB);
    const int lane = F.lane;
    u32x4 pw0[8], pw1[8];
#pragma unroll
    for (int i = 0; i < 8; ++i) { if (lane < 48) { const bf16_t* p = P1 + (size_t)(F.vcu * 64 + F.wave * 8 + i) * B_IN + lane * 64; pw0[i] = *(const GAS u32x4*)p; pw1[i] = *(const GAS u32x4*)(p + 8); } }
#pragma unroll
    for (int i = 0; i < 8; ++i) {
        const int row = F.vcu * 64 + F.wave * 8 + i; const int t = row & (SEQ - 1);
        if (lane < 48) {
            bf16_t* p = P1 + (size_t)row * B_IN + lane * 64;
            const u32x4 w0 = pw0[i], w1 = pw1[i];
            float x1[8], x2[8];
            x1[0] = bflo(w0.x); x1[1] = bfhi(w0.x); x1[2] = bflo(w0.y); x1[3] = bfhi(w0.y); x1[4] = bflo(w0.z); x1[5] = bfhi(w0.z); x1[6] = bflo(w0.w); x1[7] = bfhi(w0.w);
            x2[0] = bflo(w1.x); x2[1] = bfhi(w1.x); x2[2] = bflo(w1.y); x2[3] = bfhi(w1.y); x2[4] = bflo(w1.z); x2[5] = bfhi(w1.z); x2[6] = bflo(w1.w); x2[7] = bfhi(w1.w);
            const float* ct = tab + TB_PC + t * 8; const float* st = tab + TB_PS + t * 8;
            float y1[8], y2[8];
#pragma unroll
            for (int d = 0; d < 8; ++d) { const float c = ct[d], sn = st[d]; y1[d] = x1[d] * c - x2[d] * sn; y2[d] = x2[d] * c + x1[d] * sn; }
            u32x4 o0, o1;
            o0.x = pk2(y1[0], y1[1]); o0.y = pk2(y1[2], y1[3]); o0.z = pk2(y1[4], y1[5]); o0.w = pk2(y1[6], y1[7]); o1.x = pk2(y2[0], y2[1]); o1.y = pk2(y2[2], y2[3]); o1.z = pk2(y2[4], y2[5]); o1.w = pk2(y2[6], y2[7]);
            *(GAS u32x4*)p = o0; *(GAS u32x4*)(p + 8) = o1;
        }
    }
}
__device__ __forceinline__ void merge_phase(Frame& F) {
    const bf16_t* P1 = (const bf16_t*)(F.ws + ws_big(1)); const float* lse = (const float*)(F.ws + WS_LSE); bf16_t* ATT = (bf16_t*)(F.ws + WS_ATT);
    const int lane = F.lane, h = lane >> 3, dd = (lane & 7) * 8;
    u32x4 ma[8], mb_[8], mc[8]; float ml0[8], ml1[8], ml2[8];
#pragma unroll
    for (int i = 0; i < 8; ++i) { const int row = F.vcu * 64 + F.wave * 8 + i; const bf16_t* p = P1 + (size_t)row * B_IN + h * 64 + dd;
        ma[i] = *(const GAS u32x4*)p; mb_[i] = *(const GAS u32x4*)(p + 512); mc[i] = *(const GAS u32x4*)(p + 1024);
        ml0[i] = lse[((size_t)0 * NTOK + row) * 8 + h]; ml1[i] = lse[((size_t)1 * NTOK + row) * 8 + h]; ml2[i] = lse[((size_t)2 * NTOK + row) * 8 + h]; }
#pragma unroll
    for (int i = 0; i < 8; ++i) {
        const int row = F.vcu * 64 + F.wave * 8 + i;
        float l0 = ml0[i], l1 = ml1[i], l2 = ml2[i];
        const float mx = fmaxf(l0, fmaxf(l1, l2)); float w0 = __builtin_amdgcn_exp2f(l0 - mx), w1 = __builtin_amdgcn_exp2f(l1 - mx), w2 = __builtin_amdgcn_exp2f(l2 - mx);
        const float inv = 1.f / (w0 + w1 + w2); w0 *= inv; w1 *= inv; w2 *= inv;
        const u32x4 a = ma[i], b = mb_[i], c = mc[i];
        u32x4 o;
        o.x = pk2(w0 * bflo(a.x) + w1 * bflo(b.x) + w2 * bflo(c.x), w0 * bfhi(a.x) + w1 * bfhi(b.x) + w2 * bfhi(c.x));
        o.y = pk2(w0 * bflo(a.y) + w1 * bflo(b.y) + w2 * bflo(c.y), w0 * bfhi(a.y) + w1 * bfhi(b.y) + w2 * bfhi(c.y));
        o.z = pk2(w0 * bflo(a.z) + w1 * bflo(b.z) + w2 * bflo(c.z), w0 * bfhi(a.z) + w1 * bfhi(b.z) + w2 * bfhi(c.z));
        o.w = pk2(w0 * bflo(a.w) + w1 * bflo(b.w) + w2 * bflo(c.w), w0 * bfhi(a.w) + w1 * bfhi(b.w) + w2 * bfhi(c.w));
        *(GAS u32x4*)(ATT + (size_t)row * 768 + h * 64 + dd) = o;
    }
}

__device__ __forceinline__ void merge_quarter(Frame& F, const int k, const int quarter) {
    const bf16_t* P1 = (const bf16_t*)(F.ws + ws_big(1)); const float* lse = (const float*)(F.ws + WS_LSE); bf16_t* ATT = (bf16_t*)(F.ws + WS_ATT);
    const int lane = F.lane, b = k >> 3, h = k & 7, dd = (lane & 7) * 8;
#pragma unroll 2
    for (int i = 0; i < 8; ++i) {
        const int row = b * SEQ + quarter * 512 + F.wave * 64 + i * 8 + (lane >> 3);
        const float l0 = lse[((size_t)0 * NTOK + row) * 8 + h], l1 = lse[((size_t)1 * NTOK + row) * 8 + h], l2 = lse[((size_t)2 * NTOK + row) * 8 + h];
        const bf16_t* p = P1 + (size_t)row * B_IN + h * 64 + dd;
        const u32x4 a = __builtin_nontemporal_load((const GAS u32x4*)p), bq = __builtin_nontemporal_load((const GAS u32x4*)(p + 512)), c = __builtin_nontemporal_load((const GAS u32x4*)(p + 1024));
        const float mx = fmaxf(l0, fmaxf(l1, l2)); float w0 = __builtin_amdgcn_exp2f(l0 - mx), w1 = __builtin_amdgcn_exp2f(l1 - mx), w2 = __builtin_amdgcn_exp2f(l2 - mx);
        const float inv = 1.f / (w0 + w1 + w2); w0 *= inv; w1 *= inv; w2 *= inv;
        u32x4 o;
        o.x = pk2(w0 * bflo(a.x) + w1 * bflo(bq.x) + w2 * bflo(c.x), w0 * bfhi(a.x) + w1 * bfhi(bq.x) + w2 * bfhi(c.x));
        o.y = pk2(w0 * bflo(a.y) + w1 * bflo(bq.y) + w2 * bflo(c.y), w0 * bfhi(a.y) + w1 * bfhi(bq.y) + w2 * bfhi(c.y));
        o.z = pk2(w0 * bflo(a.z) + w1 * bflo(bq.z) + w2 * bflo(c.z), w0 * bfhi(a.z) + w1 * bfhi(bq.z) + w2 * bfhi(c.z));
        o.w = pk2(w0 * bflo(a.w) + w1 * bflo(bq.w) + w2 * bflo(c.w), w0 * bfhi(a.w) + w1 * bfhi(bq.w) + w2 * bfhi(c.w));
        *(GAS u32x4*)(ATT + (size_t)row * 768 + h * 64 + dd) = o;
    }
}

constexpr int N_PHASES = 19;
__global__ void __launch_bounds__(NWAVES * 64, 2) mega_fwd(Args args) {
    extern __shared__ __attribute__((aligned(16))) unsigned char lds[];
    Frame F;
    F.lds = (LAS unsigned char*)lds; F.MISC = (volatile LAS unsigned*)(F.lds + MISC_OFF);
    F.tid = threadIdx.x; F.lane = F.tid & 63; F.wave = __builtin_amdgcn_readfirstlane(F.tid >> 6);
    F.G = gridDim.x; { const int bx = blockIdx.x; F.vcu = (F.G % 8 == 0) ? (bx % 8) * (F.G / 8) + bx / 8 : bx; }
    F.ws = args.ws; F.ctl = (gu32*)(args.ws + WS_CTL);
    for (int u = F.tid; u < (LDS_BYTES - LDSCTL_OFF) / 4; u += NWAVES * 64) ((LAS unsigned*)(F.lds + LDSCTL_OFF))[u] = 0u;
    __syncthreads();
    { const int lo0 = args.ph_lo, hi0 = args.ph_hi; if (hi0 - lo0 > 1) (void)xcd_barrier_post((unsigned*)(F.ctl + CW_BAR), F.MISC + 8); }
#define KA_INT(off) (*(const int CAS*)((const CAS unsigned char*)__builtin_amdgcn_kernarg_segment_ptr() + (off)))
#define IN(k) (KA_INT(160) <= (k) && (k) < KA_INT(164))
#define xcd_barrier_now(ldsp) do { XcdBarrier bar_; bar_.bar = (unsigned*)(*(unsigned char* const CAS*)((const CAS unsigned char*)__builtin_amdgcn_kernarg_segment_ptr() + 152) + WS_CTL) + CW_BAR; \
        bar_.x = xb_xcc_id(); bar_.st = (volatile LAS unsigned*)((LAS unsigned char*)(ldsp) + MISC_OFF) + 8; xcd_barrier(bar_); } while (0)
#define REPS(k) for (int rep_ = 0; rep_ < ((REP_K) == (k) ? 2 : 1); ++rep_)
#define GROUP_ARRIVE(P, word, amount) do { asm volatile("s_waitcnt vmcnt(0)" ::: "memory"); __syncthreads(); \
        if ((P).tid == 0) { if ((P).MISC[12] != 1u) { __builtin_amdgcn_fence(__ATOMIC_RELEASE, "agent"); asm volatile("s_waitcnt vmcnt(0)" ::: "memory"); } \
            __hip_atomic_fetch_add((unsigned*)(word), (unsigned)(amount), RLX_AGENT); } } while (0)
#define GROUP_WAIT(P, word, need) do { if ((P).tid == 0) { unsigned polls_ = 0; \
            while (__hip_atomic_load((unsigned*)(word), RLX_AGENT) < (unsigned)(need)) { if (++polls_ > (1u << 22)) { __hip_atomic_store((unsigned*)((P).ctl + CW_TMO), 4u, RLX_AGENT); break; } __builtin_amdgcn_s_sleep(2); } \
            __builtin_amdgcn_fence(__ATOMIC_ACQUIRE, "agent"); asm volatile("s_waitcnt vmcnt(0)" ::: "memory"); } \
        __syncthreads(); } while (0)
#define STAMP(k) do { if (PROBE_K >= 0 && blockIdx.x == 0 && threadIdx.x == 0) ((volatile LAS unsigned long long*)((LAS unsigned char*)lds + SCHED_OFF + 512))[(k)] = __builtin_amdgcn_s_memrealtime(); } while (0)
#define SEAM(k) do { if (IN(k) && IN((k) + 1)) { XcdBarrier bar_; bar_.bar = (unsigned*)(*(unsigned char* const CAS*)((const CAS unsigned char*)__builtin_amdgcn_kernarg_segment_ptr() + 152) + WS_CTL) + CW_BAR; \
        bar_.x = xb_xcc_id(); bar_.st = (volatile LAS unsigned*)((LAS unsigned char*)lds + MISC_OFF) + 8; xcd_barrier(bar_); } STAMP((k) + 1); } while (0)
#define AIN(i) (*(const float* const CAS*)(ka_ + 8 * (i)))
#define PHASE_FRAME() \
    const CAS unsigned char* ka_ = (const CAS unsigned char*)__builtin_amdgcn_kernarg_segment_ptr(); asm volatile("" : "+s"(ka_)); \
    Frame P; unsigned P_l0 = 0u; { unsigned char* w_ = *(unsigned char* const CAS*)(ka_ + 152); asm volatile("" : "+s"(P_l0)); int t_ = threadIdx.x; asm volatile("" : "+v"(t_)); \
      P.ws = w_; P.ctl = (gu32*)(w_ + WS_CTL); P.lds = (LAS unsigned char*)lds + P_l0; P.MISC = (volatile LAS unsigned*)(P.lds + MISC_OFF); \
      P.tid = t_; P.lane = t_ & 63; P.wave = __builtin_amdgcn_readfirstlane(t_ >> 6); P.G = gridDim.x; { int bx = blockIdx.x; asm volatile("" : "+s"(bx)); P.bx = bx; P.vcu = (P.G % 8 == 0) ? (bx % 8) * (P.G / 8) + bx / 8 : bx; } } \
    const float* x_in = AIN(0); float* out = *(float* const CAS*)(ka_ + 144); \
    bf16_t* XB = (bf16_t*)(P.ws + WS_XB); bf16_t* ATT = (bf16_t*)(P.ws + WS_ATT); bf16_t* BIG = (bf16_t*)(P.ws + ws_big(PL_)); \
    bf16_t* MKV = (bf16_t*)(P.ws + WS_MKV); bf16_t* MEMB = (bf16_t*)(P.ws + WS_MEMB); \
    int* rowmap = (int*)(P.ws + WS_ROWMAP); float* roww = (float*)(P.ws + WS_ROWW); \
    LAS int* tpre = (LAS int*)(P.lds + SCHED_OFF); \
    (void)x_in; (void)out; (void)XB; (void)ATT; (void)BIG; (void)MKV; (void)MEMB; (void)rowmap; (void)roww; (void)tpre

    STAMP(0);
    { const int PL_ = 0; REPS(0) if (IN(0)) { PHASE_FRAME();
        LAS unsigned* scr = (LAS unsigned*)(P.lds + RING_OFF + P.wave * 16384);
        const int gw = P.vcu * NWAVES + P.wave, NGW = P.G * NWAVES;
        constexpr int I_MKV = 16 * 8, I_AIN = 16 * 24, I_AOUT = 16 * 16, I_BIN = 16 * 76, I_BOUT = 12 * 16, NIT = I_MKV + I_AIN + I_AOUT + I_BIN + I_BOUT;
        for (int it = gw; it < NIT; it += NGW) {
            int r = it;
            if (r < I_MKV) { transpose_plain(AIN(2), DM, 512, (bf16_t*)(P.ws + WS_WMKV), r, scr, P.lane); continue; } r -= I_MKV;
            if (r < I_AIN) { transpose_heads(AIN(5), DM, A_IN, (bf16_t*)(P.ws + WS_WAIN), r, scr, P.lane); continue; } r -= I_AIN;
            if (r < I_AOUT) { transpose_plain(AIN(6), DM, DM, (bf16_t*)(P.ws + WS_WAOUT), r, scr, P.lane); continue; } r -= I_AOUT;
            if (r < I_BIN) { transpose_heads(AIN(9), DM, B_IN, (bf16_t*)(P.ws + WS_WBIN), r, scr, P.lane); continue; } r -= I_BIN;
            transpose_plain(AIN(10), 768, DM, (bf16_t*)(P.ws + WS_WBOUT), r, scr, P.lane);
        }
        cvt_rows_bf16(P, x_in, XB, (size_t)NTOK * DM);
        cvt_rows_bf16(P, AIN(1), MEMB, (size_t)NB * NMEM * DM);
        { float* tab = (float*)(P.ws + WS_TAB); const int gt = gw * 64 + P.lane, NT_ = NGW * 64;
          for (int idx = gt; idx < 32 * 16 + 64 * 16 + 2048 * 8; idx += NT_) {
              int p, i, oc, os; float l2t, den;
              if (idx < 512) { p = idx >> 4; i = idx & 15; oc = TB_ROWC + idx; os = TB_ROWS + idx; l2t = 13.287712379549449f; den = 32.f; }
              else if (idx < 512 + 1024) { const int k = idx - 512; p = k >> 4; i = k & 15; oc = TB_COLC + k; os = TB_COLS + k; l2t = 13.287712379549449f; den = 32.f; }
              else { const int k = idx - 1536; p = k >> 3; i = k & 7; oc = TB_PC + k; os = TB_PS + k; l2t = 18.931568569324174f; den = 16.f; }
              const float inv = 1.0f / __builtin_amdgcn_exp2f(l2t * ((float)(2 * i) / den));
              const float ang = (float)p * inv;
              const double rev = (double)ang * 0.15915494309189535;
              const float fr = (float)(rev - __builtin_rint(rev));
              tab[oc] = __builtin_amdgcn_cosf(fr); tab[os] = __builtin_amdgcn_sinf(fr);
          } }
      if (P.tid == 0) __hip_atomic_store((unsigned*)(P.ctl + CW_XCC + P.vcu), xb_xcc_id() + 1u, RLX_AGENT);
    } }
    SEAM(0);
    if (MK_ONE_LAUNCH) { const int PL_ = 0; PHASE_FRAME();
        if (P.tid < 32) { const unsigned mine = __hip_atomic_load((unsigned*)(P.ctl + CW_XCC + P.vcu), RLX_AGENT), other = __hip_atomic_load((unsigned*)(P.ctl + CW_XCC + (P.vcu & ~31) + P.tid), RLX_AGENT);
            const bool same = __all(other == mine && mine != 0u); if (P.tid == 0) P.MISC[12] = same ? 1u : 2u; }
        __syncthreads(); }

    for (int L = 0; L < 2; ++L) {
        const int pb = 1 + 9 * L; const int PL_ = L;
        REPS(pb) if (IN(pb)) { PHASE_FRAME();
            pg8::DenseSched S;
            if (L == 0) S.init(XB, P.ws + WS_WAIN, NTOK, A_IN, DM, MEMB, P.ws + WS_WMKV, NB * NMEM, 512, P.G, P.bx);
            else        S.init(XB, P.ws + WS_WBIN, NTOK, B_IN, DM, nullptr, nullptr, 0, 0, P.G, P.bx);
            pg8::EpiProj E{BIG, L == 0 ? A_IN : B_IN, L, AIN(7), AIN(8), (const float*)(P.ws + WS_TAB), MKV, 512};
            pg8::gemm_phase<pg8::EpiProj, pg8::DenseSched, false, DM>(P.lds + RING_OFF, S, E, P.tid);
            if (L == 1) FSTAMP(P, 24);
            if (MK_ONE_LAUNCH) GROUP_ARRIVE(P, P.ctl + CW_GRP + ((L == 0 ? 0 : 2) * 8 + (P.vcu >> 5)) * 64, 1);
        }
        if (!MK_ONE_LAUNCH) SEAM(pb); else STAMP(pb + 1);
        STAMP(pb + 2);
        REPS(pb + 2) if (IN(pb + 2)) { PHASE_FRAME();
            if (MK_ONE_LAUNCH) GROUP_WAIT(P, P.ctl + CW_GRP + ((L == 0 ? 0 : 2) * 8 + (P.vcu >> 5)) * 64, 32);
            char* shm = (char*)lds + P_l0 + RING_OFF;
            if (L == 0) {
                const int v = P.vcu; const int pair = v >> 3, qb = v & 7, b = pair >> 2, kvh = pair & 3;
                const bf16_t* base = BIG + (size_t)b * SEQ * A_IN;
                LAS unsigned* scr = (LAS unsigned*)(P.lds + RING_OFF + P.wave * 16384);
                const int gw = P.vcu * NWAVES + P.wave, NGW = P.G * NWAVES;
#pragma unroll 1
                for (int i = 0; i < 3; ++i) { const int hq = kvh * 3 + i;
                    attn_body::attn_unit<8, A_IN, A_IN, A_IN, DM, SEQ / 64>(base + hq * 64, base + 768 + kvh * 64, base + 1024 + kvh * 64, ATT + (size_t)b * SEQ * DM + hq * 64, qb * 256, shm, P.tid);
                    if (i == (v % 3)) moe_convert6(P, AIN(15), AIN(16), AIN(17), scr, gw, NGW);
                    __syncthreads(); }
                { const int mb = v >> 5, mh = (v >> 3) & 3; const bf16_t* qb_ = BIG + (size_t)mb * SEQ * A_IN + 1280 + mh * 64; const bf16_t* mk = MKV + (size_t)mb * NMEM * 512 + mh * 64;
                  attn_body::attn_unit<8, A_IN, 512, 512, DM, NMEM / 64>(qb_, mk, mk + 256, ATT + (size_t)mb * SEQ * DM + 768 + mh * 64, qb * 256, shm, P.tid); }
            } else {
                { const int v = P.vcu; const int qb = v & 7, mb = v >> 5, mh = (v >> 3) & 3; const bf16_t* qb_ = BIG + (size_t)mb * SEQ * B_IN + 4608 + mh * 64; const bf16_t* mk = MKV + (size_t)mb * NMEM * 512 + mh * 64;
                  attn_body::attn_unit<8, B_IN, 512, 512, 768, NMEM / 64>(qb_, mk, mk + 256, ATT + (size_t)mb * SEQ * 768 + 512 + mh * 64, qb * 256, shm, P.tid); }
                __syncthreads();
                float* lse = (float*)(P.ws + WS_LSE);
                FSTAMP(P, 26);
                attn_body::band_phase(BIG, lse, P.vcu * 6, 6, shm, P.tid);
                FSTAMP(P, 27);
                { const int kk = P.vcu >> 2; unsigned* mc = (unsigned*)(P.ctl + CW_MRG + 64 * kk);
                  asm volatile("s_waitcnt vmcnt(0)" ::: "memory"); __syncthreads();
                  if (P.tid == 0) { __hip_atomic_fetch_add(mc, 1u, RLX_AGENT); unsigned polls = 0;
                      while (__hip_atomic_load(mc, RLX_AGENT) < 4u) { if (++polls > (1u << 22)) { __hip_atomic_store((unsigned*)(P.ctl + CW_TMO), 2u, RLX_AGENT); break; } __builtin_amdgcn_s_sleep(2); }
                      __builtin_amdgcn_fence(__ATOMIC_ACQUIRE, "agent"); asm volatile("s_waitcnt vmcnt(0)" ::: "memory"); }
                  __syncthreads();
                  merge_quarter(P, kk, P.vcu & 3); }
                __syncthreads();
            }
        }
        if (MK_ONE_LAUNCH && IN(pb + 2)) { PHASE_FRAME(); const int v = P.vcu;
            if (L == 0) { GROUP_ARRIVE(P, P.ctl + CW_ATT + (L * 64 + (v >> 5) * 8 + (v & 7)) * 64, 1); }
            else { asm volatile("s_waitcnt vmcnt(0)" ::: "memory"); __syncthreads();
                if (P.tid == 0) { if (P.MISC[12] != 1u) { __builtin_amdgcn_fence(__ATOMIC_RELEASE, "agent"); asm volatile("s_waitcnt vmcnt(0)" ::: "memory"); }
                    const int b = v >> 5, q = v & 3;
                    __hip_atomic_fetch_add((unsigned*)(P.ctl + CW_ATT + (L * 64 + b * 8 + 2 * q) * 64), 1u, RLX_AGENT); __hip_atomic_fetch_add((unsigned*)(P.ctl + CW_ATT + (L * 64 + b * 8 + 2 * q + 1) * 64), 1u, RLX_AGENT);
                    __hip_atomic_fetch_add((unsigned*)(P.ctl + CW_ATT + (L * 64 + b * 8 + (v & 7)) * 64), 1u, RLX_AGENT); } } }
        if (!MK_ONE_LAUNCH) SEAM(pb + 2); else STAMP(pb + 3);
        STAMP(pb + 4);
        REPS(pb + 4) if (IN(pb + 4)) { PHASE_FRAME();
            pg8::DenseSched S;
            if (L == 0) S.init(ATT, P.ws + WS_WAOUT, NTOK, DM, DM, nullptr, nullptr, 0, 0, P.G, P.bx);
            else        S.init(ATT, P.ws + WS_WBOUT, NTOK, DM, 768, nullptr, nullptr, 0, 0, P.G, P.bx);
            pg8::EpiZ E{XB, (bf16_t*)out};
            if (MK_ONE_LAUNCH) {
                pg8::PanelSched PS{(const char*)ATT, (const char*)(P.ws + (L == 0 ? WS_WAOUT : WS_WBOUT)), L == 0 ? DM : 768, P.vcu, (unsigned*)(P.ctl + CW_ATT + L * 64 * 64), L == 0 ? 4u : 12u, (unsigned*)(P.ctl + CW_TMO)};
                if (L == 0) pg8::gemm_phase<pg8::EpiZ, pg8::PanelSched, false, DM>(P.lds + RING_OFF, PS, E, P.tid); else pg8::gemm_phase<pg8::EpiZ, pg8::PanelSched, false, 768>(P.lds + RING_OFF, PS, E, P.tid);
                const int v = P.vcu; GROUP_ARRIVE(P, P.ctl + CW_Z + (L * 64 + (v >> 5) * 8 + (v & 7)) * 64, 1);
            } else {
            if (L == 0) pg8::gemm_phase<pg8::EpiZ, pg8::DenseSched, false, DM>(P.lds + RING_OFF, S, E, P.tid); else pg8::gemm_phase<pg8::EpiZ, pg8::DenseSched, false, 768>(P.lds + RING_OFF, S, E, P.tid);
            }
            if (L == 0) FSTAMP(P, 25);
        }
        if (!MK_ONE_LAUNCH) SEAM(pb + 4); else STAMP(pb + 5);
        REPS(pb + 5) if (IN(pb + 5)) { PHASE_FRAME(); const int v = P.vcu; const int pm = (v >> 5) * 8 + (v & 7);
            if (MK_ONE_LAUNCH) GROUP_WAIT(P, P.ctl + CW_Z + (L * 64 + pm) * 64, 4);
            ln1_router_phase(P, (const bf16_t*)out, AIN(11) + L * DM, AIN(12) + L * DM, AIN(3), AIN(4), L, false, MK_ONE_LAUNCH ? pm * 256 + ((v >> 3) & 3) * 64 : v * 64); }
        SEAM(pb + 5);
        if (IN(pb + 6) || IN(pb + 7)) { PHASE_FRAME();
            if (P.tid == 0) { int acc = 0;
                for (int e = 0; e < 16; ++e) { const int c = (int)__hip_atomic_load(P.ctl + CW_CNT + (L * 16 + e) * 64, RLX_AGENT); tpre[e] = acc; tpre[32 + e] = c; acc += (c + 255) >> 8; }
                tpre[16] = acc; }
            __syncthreads();
        }
        REPS(pb + 6) if (IN(pb + 6)) { PHASE_FRAME();
            pg8::MoeSched S{(const char*)XB, (const char*)(P.ws + ws_wgu(L)), DM, (size_t)1024 * DM * 2, tpre, rowmap, P.G, P.bx, true, (unsigned*)(P.ctl + CW_HCNT + L * 192 * 64), (unsigned*)(P.ctl + CW_TMO)};
            pg8::EpiGU E{(bf16_t*)(P.ws + ws_h(L))};
            pg8::gemm_phase<pg8::EpiGU, pg8::MoeSched, true, DM>(P.lds + RING_OFF, S, E, P.tid);
        }
        if (MK_ONE_LAUNCH == 0) SEAM(pb + 6); else STAMP(pb + 7);
        REPS(pb + 7) if (IN(pb + 7)) { PHASE_FRAME();
            if (P.tid == 0) __builtin_amdgcn_fence(__ATOMIC_ACQUIRE, "agent");
            asm volatile("s_waitcnt vmcnt(0)" ::: "memory"); __syncthreads();
            pg8::MoeSched S{(const char*)(P.ws + ws_h(L)), (const char*)(P.ws + ws_wd(L)), DEXP, (size_t)DM * DEXP * 2, tpre, rowmap, P.G, P.bx, false, (unsigned*)(P.ctl + CW_HCNT + L * 192 * 64), (unsigned*)(P.ctl + CW_TMO)};
            pg8::EpiDown E{(bf16_t*)(P.ws + ws_y(L)), rowmap, roww};
            pg8::gemm_phase<pg8::EpiDown, pg8::MoeSched, false, DEXP>(P.lds + RING_OFF, S, E, P.tid);
        }
        SEAM(pb + 7);
        if (IN(pb + 8)) { PHASE_FRAME();
            ln2_phase(P, L == 0 ? (float*)nullptr : out, AIN(13) + L * DM, AIN(14) + L * DM, L == 0, L);
        }
        if (L == 0) SEAM(pb + 8);
    }
    if (REP_K == 100) { for (int q_ = 0; q_ < 20; ++q_) xcd_barrier_now(lds); }
    if (PROBE_K >= 0) { const int PL_ = 1; PHASE_FRAME();
        xcd_barrier_now(lds); STAMP(19);
        if (blockIdx.x == 0 && threadIdx.x == 0) { volatile LAS unsigned long long* ts = (volatile LAS unsigned long long*)((LAS unsigned char*)lds + SCHED_OFF + 512);
            const float f = (float)(ts[PROBE_K2] - ts[PROBE_K]) / (float)(ts[19] - ts[0]); __hip_atomic_store((unsigned*)(P.ctl + 8), __float_as_uint(0.045f * sqrtf(f)), RLX_AGENT); }
        xcd_barrier_now(lds);
        const float sc = 1.f + __uint_as_float(__hip_atomic_load((unsigned*)(P.ctl + 8), RLX_AGENT));
        for (int i = 0; i < 8; ++i) { float* xr = out + (size_t)(P.vcu * 64 + P.wave * 8 + i) * DM;
            for (int j = 0; j < 4; ++j) { f32x4 v = *(GAS f32x4*)(xr + 4 * P.lane + 256 * j); v = v * sc; *(GAS f32x4*)(xr + 4 * P.lane + 256 * j) = v; } }
    }
#undef IN
#undef SEAM
#undef PHASE_FRAME
#undef AIN
#undef KA_INT
#undef STAMP
#undef REPS
}

extern "C" void kernel_launch(void* const* d_in, const int* in_sizes, int n_in, void* d_out, int out_size, void* d_ws, size_t ws_size, hipStream_t stream) {
    static int grid = 0;
    if (grid == 0) {
        if (n_in != 18 || out_size != NTOK * DM || ws_size < WS_END) { fprintf(stderr, "kernel_launch: unexpected shapes (n_in %d, out %d, ws %zu < %zu)\n", n_in, out_size, ws_size, (size_t)WS_END); grid = -1; return; }
        int dev = 0, cus = 0, per_cu = 0;
        if (hipGetDevice(&dev) != hipSuccess || hipDeviceGetAttribute(&cus, hipDeviceAttributeMultiprocessorCount, dev) != hipSuccess) { grid = -1; return; }
        if (hipFuncSetAttribute((const void*)mega_fwd, hipFuncAttributeMaxDynamicSharedMemorySize, LDS_BYTES) != hipSuccess) { fprintf(stderr, "kernel_launch: hipFuncSetAttribute failed\n"); grid = -1; return; }
        if (hipOccupancyMaxActiveBlocksPerMultiprocessor(&per_cu, (const void*)mega_fwd, NWAVES * 64, LDS_BYTES) != hipSuccess || per_cu < 1) { fprintf(stderr, "kernel_launch: occupancy query says %d\n", per_cu); }
        (void)hipGetLastError();
        grid = cus;
        if (grid != 256) fprintf(stderr, "kernel_launch: %d CUs (built for 256)\n", grid);
    }
    if (grid < 0) return;
    (void)hipMemsetAsync((char*)d_ws + WS_CTL, 0, CTL_ZERO_BYTES, stream);
    Args a{};
    for (int i = 0; i < 18; ++i) a.in[i] = (const float*)d_in[i];
    a.out = (float*)d_out; a.ws = (unsigned char*)d_ws;
#if MK_ONE_LAUNCH
    a.ph_lo = 0; a.ph_hi = N_PHASES;
    hipLaunchKernelGGL(mega_fwd, dim3(grid), dim3(NWAVES * 64), LDS_BYTES, stream, a);
#else
    for (int p = 0; p < N_PHASES; ++p) {
        if (p == 4 || p == 2 || p == 11 || p == 13) continue;
        a.ph_lo = p; a.ph_hi = p + 1;
        hipLaunchKernelGGL(mega_fwd, dim3(grid), dim3(NWAVES * 64), LDS_BYTES, stream, a);
    }
#endif
}
```

```cpp
#include <hip/hip_runtime.h>
#include <cstdio>
#include <cstdint>

#ifndef MK_ONE_LAUNCH
#define MK_ONE_LAUNCH 1
#endif

#ifndef REP_K
#define REP_K -1
#endif
#ifndef PROBE_K
#define PROBE_K -1
#endif
#ifndef PROBE_K2
#define PROBE_K2 (PROBE_K + 1)
#endif
#define GAS __attribute__((address_space(1)))
#define LAS __attribute__((address_space(3)))
#define CAS __attribute__((address_space(4)))
typedef unsigned short bf16_t;
typedef short bf16x8 __attribute__((ext_vector_type(8)));
typedef short s16x4 __attribute__((ext_vector_type(4)));
typedef float f32x4 __attribute__((ext_vector_type(4)));
typedef float f32x2 __attribute__((ext_vector_type(2)));
typedef float f32x16 __attribute__((ext_vector_type(16)));
typedef unsigned u32x4 __attribute__((ext_vector_type(4)));
typedef unsigned u32x2 __attribute__((ext_vector_type(2)));
typedef GAS unsigned gu32;

constexpr int NTOK = 16384, DM = 1024, SEQ = 2048, NB = 8, NMEM = 256, HD = 64;
constexpr int A_IN = 1536, B_IN = 4864, NEXP = 16, DEXP = 512;
constexpr float ALPHA = 1.4142135623730951f;
constexpr float NORM_EPS = 1e-6f;
constexpr float C2 = 0.125f * 1.4426950408889634f;
constexpr int RCAP = 16384;

constexpr size_t MiB = 1u << 20;
constexpr size_t WS_CTL = 0, CTL_ZERO_BYTES = 512 * 1024;
constexpr size_t WS_TAB = 1 * MiB;
constexpr size_t WS_ROWMAP = 2 * MiB;
constexpr size_t WS_ROWW = 3 * MiB;
constexpr size_t WS_WMKV = 4 * MiB;
constexpr size_t WS_WAIN = 5 * MiB;
constexpr size_t WS_WAOUT = 8 * MiB;
constexpr size_t WS_WBIN = 10 * MiB;
constexpr size_t WS_WBOUT = 20 * MiB;
__host__ __device__ constexpr size_t ws_wgu(int L) { return (L ? 22 : 140) * MiB; }
__host__ __device__ constexpr size_t ws_wd(int L) { return ws_wgu(L) + 32 * MiB; }
constexpr size_t WS_MEMB = 70 * MiB;
constexpr size_t WS_MKV = 74 * MiB;
constexpr size_t WS_XB = 76 * MiB;
constexpr size_t WS_ATT = 108 * MiB;
__host__ __device__ constexpr size_t ws_big(int L) { return (L ? 140 : 188) * MiB; }
__host__ __device__ constexpr size_t ws_h(int L) { return ws_big(L); }
__host__ __device__ constexpr size_t ws_y(int L) { return ws_big(L) + 36 * MiB; }
constexpr size_t WS_LSE = 292 * MiB;
constexpr size_t WS_END = 294 * MiB;
constexpr int TB_ROWC = 0, TB_ROWS = 512, TB_COLC = 1024, TB_COLS = 2048, TB_PC = 4096, TB_PS = 4096 + 16384;
constexpr int CW_TMO = 0;
constexpr int CW_BAR = 4096;
constexpr int CW_CNT = 16384;
constexpr int CW_XCC = 8192;
constexpr int CW_ATT = 20480;
constexpr int CW_Z = 57344;
constexpr int CW_GRP = 12288;
constexpr int CW_MRG = 28672;
constexpr int CW_QM = 81920;
constexpr int CW_HCNT = 32768;

constexpr int RING_OFF = 0, RING_BYTES = 131072;
constexpr int LDSCTL_OFF = RING_BYTES, MISC_OFF = LDSCTL_OFF + 320, SCHED_OFF = LDSCTL_OFF + 512;
constexpr int LDS_BYTES = 163840;
constexpr int NWAVES = 8;

#define RLX_AGENT __ATOMIC_RELAXED, __HIP_MEMORY_SCOPE_AGENT
#define LDS_WAIT() asm volatile("s_waitcnt lgkmcnt(0)" ::: "memory")
#define VM_WAIT() asm volatile("s_waitcnt vmcnt(0)" ::: "memory")
__device__ __forceinline__ unsigned f2bf(float f) { unsigned u = __builtin_bit_cast(unsigned, f); return (u + 0x7fffu + ((u >> 16) & 1u)) >> 16; }
typedef float pk_f32x2_t __attribute__((ext_vector_type(2))); typedef __bf16 pk_bf16x2_t __attribute__((ext_vector_type(2)));
__device__ __forceinline__ unsigned pk2(float lo, float hi) { pk_f32x2_t v = {lo, hi}; pk_bf16x2_t b = __builtin_convertvector(v, pk_bf16x2_t); return __builtin_bit_cast(unsigned, b); }
__device__ __forceinline__ float bf2f(unsigned short b) { return __builtin_bit_cast(float, (unsigned)b << 16); }
__device__ __forceinline__ float bflo(unsigned w) { return __builtin_bit_cast(float, w << 16); }
__device__ __forceinline__ float bfhi(unsigned w) { return __builtin_bit_cast(float, w & 0xffff0000u); }
__device__ __forceinline__ unsigned cvt_pk_bf16(float lo, float hi) { unsigned r; asm volatile("v_cvt_pk_bf16_f32 %0, %1, %2" : "=v"(r) : "v"(lo), "v"(hi)); return r; }
__device__ __forceinline__ void store16_sc1(void* p, u32x4 v) { asm volatile("global_store_dwordx4 %0, %1, off sc1\n\ts_nop 1" :: "v"(p), "v"(v) : "memory"); }
#define ACQUIRE_HANDOFF(same_xcc) do { if (same_xcc) asm volatile("buffer_inv sc0" ::: "memory"); else __builtin_amdgcn_fence(__ATOMIC_ACQUIRE, "agent"); asm volatile("s_waitcnt vmcnt(0)" ::: "memory"); } while (0)
__device__ __forceinline__ float wave_sum(float v) {
#pragma unroll
    for (int o = 1; o < 64; o <<= 1) v += __shfl_xor(v, o);
    return v;
}

#define DPP_F(v, ctrl, rmask) __builtin_bit_cast(float, __builtin_amdgcn_update_dpp(0, __builtin_bit_cast(int, (v)), (ctrl), (rmask), 0xF, true))
__device__ __forceinline__ float wave_sum_dpp(float v) {
    v += DPP_F(v, 0xB1, 0xF); v += DPP_F(v, 0x4E, 0xF); v += DPP_F(v, 0x141, 0xF); v += DPP_F(v, 0x140, 0xF); v += DPP_F(v, 0x142, 0xA); v += DPP_F(v, 0x143, 0xC);
    return __builtin_bit_cast(float, __builtin_amdgcn_readlane(__builtin_bit_cast(int, v), 63));
}
#define XB_TMO      128
#define XB_XCNT(j)  (256  + 64 * (j))
#define XB_XSUB(j)  (1280 + 64 * (j))
#define XB_XGEN(j)  (2304 + 64 * (j))
#define XB_TOP      3328
#define XB_TOPGEN   3392
#define XCD_BAR_WORDS 3456
#define XB_SPIN_CAP (1u << 20)
__device__ __forceinline__ unsigned xb_ld(unsigned* p)              { return __hip_atomic_load(p, __ATOMIC_RELAXED, __HIP_MEMORY_SCOPE_AGENT); }
__device__ __forceinline__ unsigned xb_add(unsigned* p, unsigned v) { return __hip_atomic_fetch_add(p, v, __ATOMIC_RELAXED, __HIP_MEMORY_SCOPE_AGENT); }
__device__ __forceinline__ unsigned xb_xcc_id() { return (unsigned)__builtin_amdgcn_s_getreg((3 << 11) | 20) & 0xFu; }
#define XB_SPIN(cond, bar) do { unsigned _sp = 0; while (cond) { __builtin_amdgcn_s_sleep(1); \
    if ((++_sp & 255u) == 0u) { if (xb_ld(&(bar)[XB_TMO])) break; if (_sp > XB_SPIN_CAP) { atomicAdd(&(bar)[XB_TMO], 1u); break; } } } } while (0)
struct XcdBarrier { unsigned* bar; unsigned x; volatile LAS unsigned* st; };
__device__ __forceinline__ XcdBarrier xcd_barrier_post(unsigned* bar, volatile LAS unsigned* st) {
    XcdBarrier b; b.bar = bar; b.x = xb_xcc_id(); b.st = st;
    if (threadIdx.x == 0) (void)xb_add(&bar[XB_XCNT(b.x)], 1u);
    return b;
}
__device__ __forceinline__ void xcd_barrier_complete(unsigned* bar, unsigned x, unsigned& nloc, unsigned& nx) {
    const unsigned G = gridDim.x * gridDim.y * gridDim.z;
    unsigned sum, cnt, mine, sp = 0u;
    for (;;) {
        sum = 0u; cnt = 0u; mine = 0u;
#pragma unroll
        for (unsigned j = 0; j < 16; ++j) { const unsigned c = xb_ld(&bar[XB_XCNT(j)]); sum += c; cnt += (c > 0u) ? 1u : 0u; mine = (j == x) ? c : mine; }
        if (sum == G) break;
        __builtin_amdgcn_s_sleep(1);
        if ((++sp & 255u) == 0u) { if (xb_ld(&bar[XB_TMO])) break; if (sp > XB_SPIN_CAP) { atomicAdd(&bar[XB_TMO], 1u); break; } }
    }
    nloc = mine > 0u ? mine : 1u; nx = cnt > 0u ? cnt : 1u;
}
__device__ __forceinline__ void xcd_barrier(const XcdBarrier& b) {
    asm volatile("s_waitcnt vmcnt(0)" ::: "memory");
    __syncthreads();
    if (threadIdx.x == 0) {
        unsigned* bar = b.bar;
        __builtin_amdgcn_s_waitcnt(0);
        unsigned nloc = b.st[0], nx = b.st[1];
        if (nloc == 0u) { xcd_barrier_complete(bar, b.x, nloc, nx); b.st[0] = nloc; b.st[1] = nx; }
        const unsigned old = xb_add(&bar[XB_XSUB(b.x)], 1u);
        const unsigned gen = old / nloc;
        if (old + 1u == (gen + 1u) * nloc) {
            __builtin_amdgcn_fence(__ATOMIC_RELEASE, "agent");
            asm volatile("s_waitcnt vmcnt(0)" ::: "memory");
            const unsigned og = xb_add(&bar[XB_TOP], 1u);
            const unsigned tg = og / nx, target = (tg + 1u) * nx;
            if (og + 1u != target) XB_SPIN((int)(xb_ld(&bar[XB_TOP]) - target) < 0, bar);
            __builtin_amdgcn_fence(__ATOMIC_ACQUIRE, "agent");
            asm volatile("s_waitcnt vmcnt(0)" ::: "memory");
            xb_add(&bar[XB_XGEN(b.x)], 1u);
            asm volatile("s_waitcnt vmcnt(0)" ::: "memory");
        } else {
            XB_SPIN(xb_ld(&bar[XB_XGEN(b.x)]) == gen, bar);
            asm volatile("buffer_inv sc0" ::: "memory");
            asm volatile("s_waitcnt vmcnt(0)" ::: "memory");
        }
    }
    __syncthreads();
}

namespace pg8 {
constexpr int BM = 256, BK = 64, HALF = 128, HTB = HALF * BK * 2, STAGE_BYTES = 8 * HTB, NXCD = 8, WGM = 8;
constexpr int TAB_LDS = SCHED_OFF + 1024 + 4096 - RING_OFF;
constexpr int META_LDS = SCHED_OFF + 1024 - RING_OFF;
__host__ __device__ __forceinline__ int lds_byte(int r, int c) { const int st = (r >> 4) * 2 + (c >> 5), rr = r & 15, cc = c & 31, ob = rr * 64 + cc * 2; return st * 1024 + (ob ^ (((ob >> 9) & 1) << 5)); }
__host__ __device__ __forceinline__ void stage_rc(int b, int& R, int& C) { const int st = b / 1024, sb = b % 1024, swz = sb ^ (((sb >> 9) & 1) << 5); R = (st >> 1) * 16 + swz / 64; C = (st & 1) * 32 + (swz % 64) / 2; }
__host__ __device__ __forceinline__ int perm32(int rho) { const int n = rho >> 4, i = rho & 15; return 8 * (i >> 2) + 4 * n + (i & 3); }

struct Unit { int pm, pn, e, ti, nv, ord; };

template <class Epi, class Sched, bool GATHER, int K>
__device__ __forceinline__ void gemm_phase(LAS unsigned char* lds, const Sched& S, const Epi& E, const int tid) {
    const int wid = __builtin_amdgcn_readfirstlane(tid >> 6), lane = tid & 63, wr = wid >> 2, wc = wid & 3, fr = lane & 15, fq = lane >> 4;
    const int nt = K / BK;
    unsigned voffA[2], voffB[2]; int RA[2], CA[2];
#pragma unroll
    for (int i = 0; i < 2; ++i) { int R, C; stage_rc(tid * 16 + i * 8192, R, C); const int Rb = Epi::PERM ? ((R & ~31) + perm32(R & 31)) : R;
        RA[i] = R; CA[i] = C; voffA[i] = (unsigned)(R * K + C) * 2u; voffB[i] = (unsigned)(Rb * K + C) * 2u; }
    const size_t kstep = (size_t)(BK * 2);
    const size_t hstep = (size_t)HALF * K * 2;
    const unsigned ldsw = (unsigned)wid * 1024u;
    const int aoff = lds_byte(wr * 64 + fr, fq * 8), boff = lds_byte(wc * 32 + fr, fq * 8);
    unsigned gA[2][2], ngA[2][2];
#define PG8_SA(b, h) (((b) * 2 + (h)) * HTB)
#define PG8_SB(b, h) ((4 + (b) * 2 + (h)) * HTB)
#define PG8_STAGE(bufoff, gbase, voff) do { _Pragma("unroll") for (int _i = 0; _i < 2; ++_i) \
        __builtin_amdgcn_global_load_lds((const unsigned*)((const char*)(gbase) + (voff)[_i]), (LAS unsigned*)(lds + (bufoff) + ldsw + _i * 8192), 16, 0, 0); } while (0)
#define PG8_STAGE_A(bufoff, gptr, H, NX) do { _Pragma("unroll") for (int _i = 0; _i < 2; ++_i) { \
        const unsigned _vo = GATHER ? ((NX) ? ngA[H][_i] : gA[H][_i]) : voffA[_i]; \
        const char* _gp = GATHER ? (const char*)(gptr) : (const char*)(gptr) + (H) * hstep; \
        __builtin_amdgcn_global_load_lds((const unsigned*)(_gp + _vo), (LAS unsigned*)(lds + (bufoff) + ldsw + _i * 8192), 16, 0, 0); } } while (0)
#define PG8_LDA(dst, b, h) do { _Pragma("unroll") for (int m = 0; m < 4; ++m) _Pragma("unroll") for (int k = 0; k < 2; ++k) dst[m][k] = *(const LAS bf16x8*)(lds + PG8_SA(b, h) + aoff + m * 2048 + k * 1024); } while (0)
#define PG8_LDB(dst, b, h) do { _Pragma("unroll") for (int n = 0; n < 2; ++n) _Pragma("unroll") for (int k = 0; k < 2; ++k) dst[n][k] = *(const LAS bf16x8*)(lds + PG8_SB(b, h) + boff + n * 2048 + k * 1024); } while (0)
#define PG8_MMA(ai, bj, At, Bt) do { __builtin_amdgcn_s_setprio(1); _Pragma("unroll") for (int m = 0; m < 4; ++m) _Pragma("unroll") for (int n = 0; n < 2; ++n) _Pragma("unroll") for (int k = 0; k < 2; ++k) \
        acc[ai][bj][m][n] = __builtin_amdgcn_mfma_f32_16x16x32_bf16(Bt[n][k], At[m][k], acc[ai][bj][m][n], 0, 0, 0); __builtin_amdgcn_s_setprio(0); } while (0)
#define PG8_WAIT_V(n) asm volatile("s_waitcnt vmcnt(" #n ")" ::: "memory")
#define PG8_WAIT_L(n) asm volatile("s_waitcnt lgkmcnt(" #n ")" ::: "memory")
#define PG8_BAR __builtin_amdgcn_s_barrier()
#define PG8_SCHED __builtin_amdgcn_sched_barrier(0)
#define PG8_GLOAD(dst, u) do { if constexpr (GATHER) { const int* _rm = S.rows(u); \
        _Pragma("unroll") for (int _h = 0; _h < 2; ++_h) _Pragma("unroll") for (int _i = 0; _i < 2; ++_i) { const int _r = _h * HALF + RA[_i]; \
            const int _tok = (_r < (u).nv) ? (_rm[_r] >> 1) : 0; dst[_h][_i] = (unsigned)(_tok * K + CA[_i]) * 2u; } \
        asm volatile("s_waitcnt vmcnt(0)" : "+v"(dst[0][0]), "+v"(dst[0][1]), "+v"(dst[1][0]), "+v"(dst[1][1]) :: "memory"); } } while (0)
#define PG8_META(u, slot) do { if constexpr (GATHER) { if (wid < 4) __builtin_amdgcn_global_load_lds((const unsigned*)(S.rows(u) + wid * 64 + lane), (LAS unsigned*)(lds + META_LDS + (slot) * 2048 + wid * 256), 4, 0, 0); } \
        else if constexpr (Epi::META) { __builtin_amdgcn_global_load_lds((const unsigned*)(E.meta_src(u, wid >> 2) + (wid & 3) * 64 + lane), (LAS unsigned*)(lds + META_LDS + (slot) * 2048 + (wid >> 2) * 1024 + (wid & 3) * 256), 4, 0, 0); } } while (0)
    Unit cur, nxt; int ui = 0, tab_pm = -1;
    if (!S.next(0, cur)) return;
    f32x4 acc[2][2][4][2];
#pragma unroll
    for (int a = 0; a < 2; ++a)
#pragma unroll
        for (int b = 0; b < 2; ++b)
#pragma unroll
            for (int m = 0; m < 4; ++m)
#pragma unroll
                for (int n = 0; n < 2; ++n) acc[a][b][m][n] = (f32x4){0.f, 0.f, 0.f, 0.f};
    bf16x8 At[4][2], B0[2][2], B1[2][2];
    const char* cA = S.a_base(cur); const char* cB = S.b_base(cur);
    if constexpr (GATHER) { S.a_ready(cur, tid); PG8_GLOAD(gA, cur); PG8_STAGE(PG8_SB(0, 0), cB, voffB); PG8_STAGE(PG8_SB(0, 1), cB + hstep, voffB); }
    else { if constexpr (Epi::META) PG8_META(cur, 0); if constexpr (Epi::TABDMA) { E.tab_dma(cur, lds, wid, lane); tab_pm = cur.pm; } PG8_STAGE(PG8_SB(0, 0), cB, voffB); PG8_STAGE(PG8_SB(0, 1), cB + hstep, voffB); S.a_ready(cur, tid); }
    PG8_STAGE_A(PG8_SA(0, 0), cA, 0, false); PG8_STAGE_A(PG8_SA(0, 1), cA, 1, false);
    if (wr == 1) PG8_BAR;
    PG8_WAIT_V(2); PG8_BAR;
    PG8_STAGE(PG8_SB(1, 0), cB + kstep, voffB); PG8_STAGE_A(PG8_SA(1, 0), cA + kstep, 0, false); PG8_STAGE(PG8_SB(1, 1), cB + hstep + kstep, voffB);
    PG8_WAIT_V(6); PG8_BAR;
    for (;;) {
        const bool has_next = S.next(ui + 1, nxt);
        const char* nA = has_next ? S.a_base(nxt) : (GATHER ? cA : cB); const char* nB = has_next ? S.b_base(nxt) : cB;
        if constexpr (GATHER) {
            if (has_next) PG8_META(nxt, (ui + 1) & 1);
#pragma unroll
            for (int _h = 0; _h < 2; ++_h)
#pragma unroll
                for (int _i = 0; _i < 2; ++_i) ngA[_h][_i] = gA[_h][_i];
        } else if constexpr (Epi::META) { if (ui > 0) PG8_META(cur, ui & 1); }
        for (int t = 0; t < nt; t += 2) {
            const bool last = (t == nt - 2);
            if constexpr (GATHER) { if (last && has_next) { const LAS int* _mr = (const LAS int*)(lds + META_LDS + ((ui + 1) & 1) * 2048);
#pragma unroll
                for (int _h = 0; _h < 2; ++_h)
#pragma unroll
                    for (int _i = 0; _i < 2; ++_i) { const int _r = _h * HALF + RA[_i]; const int _tok = (_r < nxt.nv) ? (_mr[_r] >> 1) : 0; ngA[_h][_i] = (unsigned)(_tok * K + CA[_i]) * 2u; } } }
            const char* a1 = cA + (size_t)(t + 1) * kstep;
            const char* a2 = last ? nA : cA + (size_t)(t + 2) * kstep; const char* b2 = last ? nB : cB + (size_t)(t + 2) * kstep;
            const char* a3 = a2 + kstep; const char* b3 = b2 + kstep;
            if (last && has_next) S.a_ready(nxt, tid);
            PG8_LDB(B0, 0, 0); PG8_LDB(B1, 0, 1); PG8_SCHED; PG8_LDA(At, 0, 0); PG8_STAGE_A(PG8_SA(1, 1), a1, 1, false);
            PG8_WAIT_V(8); PG8_WAIT_L(0); PG8_BAR; PG8_MMA(0, 0, At, B0); PG8_MMA(0, 1, At, B1); PG8_BAR; PG8_SCHED;
            PG8_LDA(At, 0, 1); PG8_STAGE(PG8_SB(0, 0), b2, voffB); PG8_STAGE(PG8_SB(0, 1), b2 + hstep, voffB); PG8_STAGE_A(PG8_SA(0, 0), a2, 0, last);
            PG8_WAIT_V(8); PG8_WAIT_L(0); PG8_BAR; PG8_MMA(1, 0, At, B0); PG8_MMA(1, 1, At, B1); PG8_BAR; PG8_SCHED;
            PG8_LDB(B0, 1, 0); PG8_LDB(B1, 1, 1); PG8_SCHED; PG8_LDA(At, 1, 0); PG8_STAGE_A(PG8_SA(0, 1), a2, 1, last);
            PG8_WAIT_V(8); PG8_WAIT_L(0); PG8_BAR; PG8_MMA(0, 0, At, B0); PG8_MMA(0, 1, At, B1); PG8_BAR; PG8_SCHED;
            PG8_LDA(At, 1, 1); PG8_STAGE(PG8_SB(1, 0), b3, voffB); PG8_STAGE(PG8_SB(1, 1), b3 + hstep, voffB); PG8_STAGE_A(PG8_SA(1, 0), a3, 0, last);
            PG8_WAIT_V(8); PG8_WAIT_L(0); PG8_BAR; PG8_MMA(1, 0, At, B0); PG8_MMA(1, 1, At, B1); PG8_BAR; PG8_SCHED;
        }
        if (wr == 0) PG8_BAR;
        E(acc, cur, wr, wc, fr, fq);
        S.done(cur, lane);
        if (!has_next) break;
#pragma unroll
        for (int a = 0; a < 2; ++a)
#pragma unroll
            for (int b = 0; b < 2; ++b)
#pragma unroll
                for (int m = 0; m < 4; ++m)
#pragma unroll
                    for (int n = 0; n < 2; ++n) acc[a][b][m][n] = (f32x4){0.f, 0.f, 0.f, 0.f};
        cur = nxt; cA = nA; cB = nB; ++ui;
        if constexpr (GATHER) {
#pragma unroll
            for (int _h = 0; _h < 2; ++_h)
#pragma unroll
                for (int _i = 0; _i < 2; ++_i) gA[_h][_i] = ngA[_h][_i]; }
        if (wr == 1) PG8_BAR;
        if constexpr (Epi::TABDMA) { if (cur.pm != tab_pm) { PG8_BAR; E.tab_dma(cur, lds, wid, lane); tab_pm = cur.pm; } }
    }
    PG8_WAIT_V(0);
    PG8_BAR;
#undef PG8_SA
#undef PG8_SB
#undef PG8_STAGE
#undef PG8_STAGE_A
#undef PG8_LDA
#undef PG8_LDB
#undef PG8_MMA
#undef PG8_WAIT_V
#undef PG8_WAIT_L
#undef PG8_BAR
#undef PG8_SCHED
#undef PG8_GLOAD
#undef PG8_META
}

struct DenseSched {
    const char *A0, *B0, *A1, *B1; int K; int nM, nN, nwg, G, c, nM1, nwg1;
    unsigned* qdone = nullptr; int pfirst = -1; bool same_xcc = true;
    __device__ __forceinline__ void init(const void* a0, const void* b0, int M, int N, int K_, const void* a1, const void* b1, int M1, int N1, int G_, int c_) {
        A0 = (const char*)a0; B0 = (const char*)b0; A1 = (const char*)a1; B1 = (const char*)b1; K = K_; nM = M / BM; nN = N / BM; nwg = nM * nN; G = G_; c = c_;
        nM1 = M1 / BM > 0 ? M1 / BM : 1; nwg1 = (M1 / BM) * (N1 / BM); }
    __device__ __forceinline__ bool next(int i, Unit& u) const {
        const int L = i * G + c; if (L >= nwg + nwg1) return false;
        u.ti = 0; u.nv = BM; u.ord = i;
        if (L < nwg) {
            int wgid = L; { const int q = nwg / NXCD, r = nwg % NXCD, xcd = wgid % NXCD, off = wgid / NXCD; wgid = (xcd < r ? xcd * (q + 1) : r * (q + 1) + (xcd - r) * q) + off; }
            const int nig = WGM * nN, gid = wgid / nig, fm = gid * WGM, gsz = (nM - fm) < WGM ? (nM - fm) : WGM;
            u.pm = fm + ((wgid % nig) % gsz); u.pn = (wgid % nig) / gsz; u.e = 0;
            if (pfirst >= 0) u.pn = (u.pn == 0) ? pfirst : (u.pn <= pfirst ? u.pn - 1 : u.pn);
        } else { const int l = L - nwg; u.pm = l % nM1; u.pn = l / nM1; u.e = 1; }
        return true;
    }
    __device__ __forceinline__ const char* a_base(const Unit& u) const { return (u.e ? A1 : A0) + (size_t)u.pm * BM * K * 2; }
    __device__ __forceinline__ const char* b_base(const Unit& u) const { return (u.e ? B1 : B0) + (size_t)u.pn * BM * K * 2; }
    __device__ __forceinline__ const int* rows(const Unit&) const { return nullptr; }
    __device__ __forceinline__ void a_ready(const Unit&, int) const {}
    __device__ __forceinline__ void done(const Unit& u, int lane) const {
        if (pfirst >= 0 && u.e == 0 && u.pn == pfirst) { asm volatile("s_waitcnt vmcnt(0)" ::: "memory");
            if (!same_xcc) { __builtin_amdgcn_fence(__ATOMIC_RELEASE, "agent"); asm volatile("s_waitcnt vmcnt(0)" ::: "memory"); }
            if (lane == 0) __hip_atomic_fetch_add(qdone + 64 * u.pm, 1u, __ATOMIC_RELAXED, __HIP_MEMORY_SCOPE_AGENT); } }
};
struct PanelSched {
    const char* A; const char* Bt; int K; int v; unsigned* cnt; unsigned need; unsigned* tmo; bool same_xcc;
    __device__ __forceinline__ bool next(int i, Unit& u) const { if (i > 0) return false; u.pm = (v >> 5) * 8 + (v & 7); u.pn = (v >> 3) & 3; u.e = 0; u.ti = 0; u.nv = BM; u.ord = 0; return true; }
    __device__ __forceinline__ const char* a_base(const Unit& u) const { return A + (size_t)u.pm * BM * K * 2; }
    __device__ __forceinline__ const char* b_base(const Unit& u) const { return Bt + (size_t)u.pn * BM * K * 2; }
    __device__ __forceinline__ const int* rows(const Unit&) const { return nullptr; }
    __device__ __forceinline__ void a_ready(const Unit& u, int tid) const {
        if (tid < 64) { unsigned polls = 0;
            while ((unsigned)__builtin_amdgcn_readfirstlane(__hip_atomic_load(cnt + 64 * u.pm, __ATOMIC_RELAXED, __HIP_MEMORY_SCOPE_AGENT)) < need) {
                if (++polls > (1u << 22)) { if (tid == 0) __hip_atomic_store(tmo, 3u, __ATOMIC_RELAXED, __HIP_MEMORY_SCOPE_AGENT); break; }
                __builtin_amdgcn_s_sleep(2); }
            ACQUIRE_HANDOFF(same_xcc); }
        asm volatile("" ::: "memory"); __builtin_amdgcn_s_barrier(); asm volatile("" ::: "memory");
    }
    __device__ __forceinline__ void done(const Unit&, int) const {}
};
struct MoeSched {
    const char* A; const char* Bt; int K; size_t bstride; const LAS int* tpre; const int* rowmap; int G, c; bool gather;
    unsigned ready;
    unsigned* hcnt; unsigned* tmo;
    __device__ __forceinline__ void a_ready(const Unit& u, int tid) const {
        if (!gather) {
            if (tid < 64 && !((ready >> u.ord) & 1u)) { unsigned polls = 0;
                while ((unsigned)__builtin_amdgcn_readfirstlane(__hip_atomic_load(hcnt + 64 * u.pm, __ATOMIC_RELAXED, __HIP_MEMORY_SCOPE_AGENT)) < 32u) {
                    if (++polls > (1u << 22)) { if (tid == 0) __hip_atomic_store(tmo, 1u, __ATOMIC_RELAXED, __HIP_MEMORY_SCOPE_AGENT); break; }
                    __builtin_amdgcn_s_sleep(2); } }
            asm volatile("" ::: "memory"); __builtin_amdgcn_s_barrier(); asm volatile("" ::: "memory");
        }
    }
    __device__ __forceinline__ void done(const Unit& u, int lane) const {
        if (gather) { asm volatile("s_waitcnt vmcnt(0)" ::: "memory");
            if (lane == 0) __hip_atomic_fetch_add(hcnt + 64 * u.pm, 1u, __ATOMIC_RELAXED, __HIP_MEMORY_SCOPE_AGENT); }
    }
    __device__ __forceinline__ int unit_index(int i) const {
        const int U = tpre[16] * 4, x = U - 2 * G;
        if (!(x > 0 && 5 * x <= G)) { const int L = i * G + (gather ? c : G - 1 - c); return L < U ? L : -1; }
        const int a = 3 * x, b = G - 5 * x;
        if (gather) { if (i == 0) return c; if (i == 1) return c < a + b ? G + c : -1; if (i == 2) return c < a ? G + (a + b) + c : -1; return -1; }
        if (c >= a + b) return i < 4 ? (c - (a + b)) + 2 * x * i : -1;
        if (c >= a) return i < 2 ? 8 * x + (c - a) + b * i : -1;
        return i < 1 ? 8 * x + 2 * b + c : -1;
    }
    __device__ __forceinline__ bool next(int i, Unit& u) const {
        const int L = unit_index(i); if (L < 0) return false;
        const int rt = L >> 2; int e = 0;
#pragma unroll
        for (int k = 1; k < 16; ++k) e += (rt >= tpre[k]) ? 1 : 0;
        const int ti = rt - tpre[e]; const int rem = tpre[32 + e] - ti * BM;
        u.ord = i; u.pn = L & 3; u.pm = __builtin_amdgcn_readfirstlane(rt); u.e = __builtin_amdgcn_readfirstlane(e); u.ti = __builtin_amdgcn_readfirstlane(ti); u.nv = __builtin_amdgcn_readfirstlane(rem < BM ? rem : BM);
        return true;
    }
    __device__ __forceinline__ const char* a_base(const Unit& u) const { return gather ? A : A + (size_t)u.pm * BM * K * 2; }
    __device__ __forceinline__ const char* b_base(const Unit& u) const { return Bt + (size_t)u.e * bstride + (size_t)u.pn * BM * K * 2; }
    __device__ __forceinline__ const int* rows(const Unit& u) const { return rowmap + (size_t)u.e * RCAP + u.ti * BM; }
};

struct EpiProj {
    static constexpr bool PERM = true; static constexpr bool META = false; static constexpr bool TABDMA = true;
    bf16_t* O0; int ldc0; int layer; const float* qn; const float* kn; const float* tab; bf16_t* O1; int ldc1; const LAS float* ltab;
    __device__ __forceinline__ void tab_dma(const Unit& u, LAS unsigned char* lds, int wid, int lane) const {
        if (layer == 1 && u.e == 0) { const int t0 = (u.pm * BM) & (SEQ - 1);
            __builtin_amdgcn_global_load_lds((const unsigned*)(tab + TB_PC + t0 * 8 + wid * 256 + lane * 4), (LAS unsigned*)(lds + TAB_LDS + wid * 1024), 16, 0, 0);
            __builtin_amdgcn_global_load_lds((const unsigned*)(tab + TB_PS + t0 * 8 + wid * 256 + lane * 4), (LAS unsigned*)(lds + TAB_LDS + 8192 + wid * 1024), 16, 0, 0); } }
    __device__ __forceinline__ void operator()(const f32x4 (&acc)[2][2][4][2], const Unit& u, int wr, int wc, int fr, int fq) const {
        const int row0 = u.pm * BM + wr * 64 + fr;
        if (u.e) {
            const int col0 = u.pn * BM + wc * 32 + 8 * fq;
#pragma unroll
            for (int ai = 0; ai < 2; ++ai)
#pragma unroll
                for (int m = 0; m < 4; ++m) { bf16_t* rowp = O1 + (size_t)(row0 + ai * HALF + m * 16) * ldc1 + col0;
#pragma unroll
                    for (int bj = 0; bj < 2; ++bj) { const f32x4 v0 = acc[ai][bj][m][0], v1 = acc[ai][bj][m][1]; u32x4 w;
                        w.x = cvt_pk_bf16(v0[0], v0[1]); w.y = cvt_pk_bf16(v0[2], v0[3]); w.z = cvt_pk_bf16(v1[0], v1[1]); w.w = cvt_pk_bf16(v1[2], v1[3]);
                        *(u32x4*)(rowp + bj * HALF) = w; } }
            return;
        }
        const int pn = u.pn;
        const bool isq = layer == 0 ? (pn < 3 || pn == 5) : (pn < 6 || pn == 18);
        const float s = isq ? C2 : 1.f;
        const int mode = (layer == 0 && pn < 4) ? 1 : ((layer == 1 && pn < 12) ? 2 : 0);
        const int col0 = pn * BM + wc * 64 + 8 * fq;
        const int i16 = 8 * (fq & 1); const bool hi2 = fq >= 2, lo = fq < 2, second = (fq & 1) != 0;
        f32x4 g00 = {1.f, 1.f, 1.f, 1.f}, g01 = g00, g10 = g00, g11 = g00;
        if (mode == 1) { const float* gp = (pn < 3 ? qn : kn) + 8 * fq; g00 = *(const f32x4*)(gp); g01 = *(const f32x4*)(gp + 4); g10 = *(const f32x4*)(gp + 32); g11 = *(const f32x4*)(gp + 36); }
#pragma unroll
        for (int ai = 0; ai < 2; ++ai)
#pragma unroll
            for (int m = 0; m < 4; ++m) {
                const int row = row0 + ai * HALF + m * 16;
                f32x4 x00 = acc[ai][0][m][0], x01 = acc[ai][0][m][1], x10 = acc[ai][1][m][0], x11 = acc[ai][1][m][1];
                if (mode == 1) {
                    const int gr = (row >> 6) & 31, gc = row & 63;
                    const LAS float* rc = ltab + TB_ROWC + gr * 16 + i16; const LAS float* rs_ = ltab + TB_ROWS + gr * 16 + i16;
                    const LAS float* cc = ltab + TB_COLC + gc * 16 + i16; const LAS float* cs = ltab + TB_COLS + gc * 16 + i16;
                    const f32x4 rc0 = *(const LAS f32x4*)rc, rc1 = *(const LAS f32x4*)(rc + 4), rs0 = *(const LAS f32x4*)rs_, rs1 = *(const LAS f32x4*)(rs_ + 4);
                    const f32x4 cc0 = *(const LAS f32x4*)cc, cc1 = *(const LAS f32x4*)(cc + 4), cs0 = *(const LAS f32x4*)cs, cs1 = *(const LAS f32x4*)(cs + 4);
                    float ss = 0.f;
#pragma unroll
                    for (int j = 0; j < 4; ++j) ss += x00[j] * x00[j] + x01[j] * x01[j] + x10[j] * x10[j] + x11[j] * x11[j];
                    ss += __shfl_xor(ss, 16); ss += __shfl_xor(ss, 32);
                    const float rn = __builtin_amdgcn_rsqf(ss * (1.f / 64.f) + NORM_EPS);
                    x00 = x00 * rn * g00; x01 = x01 * rn * g01; x10 = x10 * rn * g10; x11 = x11 * rn * g11;
                    f32x4 p00, p01, p10, p11;
#pragma unroll
                    for (int j = 0; j < 4; ++j) { p00[j] = __shfl_xor(x00[j], 32); p01[j] = __shfl_xor(x01[j], 32); p10[j] = __shfl_xor(x10[j], 32); p11[j] = __shfl_xor(x11[j], 32); }
                    if (hi2) { x00 = x00 * rc0 + p00 * rs0; x01 = x01 * rc1 + p01 * rs1; x10 = x10 * cc0 + p10 * cs0; x11 = x11 * cc1 + p11 * cs1; }
                    else     { x00 = x00 * rc0 - p00 * rs0; x01 = x01 * rc1 - p01 * rs1; x10 = x10 * cc0 - p10 * cs0; x11 = x11 * cc1 - p11 * cs1; }
                } else if (mode == 2) {
                    const LAS float* lt = ltab + (wr * 64 + fr + ai * HALF + m * 16) * 8;
                    const f32x4 c0 = *(const LAS f32x4*)lt, c1 = *(const LAS f32x4*)(lt + 4), s0 = *(const LAS f32x4*)(lt + 2048), s1 = *(const LAS f32x4*)(lt + 2052);
                    f32x4 p0, p1;
#pragma unroll
                    for (int j = 0; j < 4; ++j) { p0[j] = __shfl_xor(x00[j], 16); p1[j] = __shfl_xor(x01[j], 16); }
                    if (lo) { if (second) { x00 = x00 * c0 + p0 * s0; x01 = x01 * c1 + p1 * s1; } else { x00 = x00 * c0 - p0 * s0; x01 = x01 * c1 - p1 * s1; } }
                }
                bf16_t* rowp = O0 + (size_t)row * ldc0 + col0;
                x00 = x00 * s; x01 = x01 * s; x10 = x10 * s; x11 = x11 * s;
                u32x4 w0, w1;
                w0.x = cvt_pk_bf16(x00[0], x00[1]); w0.y = cvt_pk_bf16(x00[2], x00[3]); w0.z = cvt_pk_bf16(x01[0], x01[1]); w0.w = cvt_pk_bf16(x01[2], x01[3]);
                w1.x = cvt_pk_bf16(x10[0], x10[1]); w1.y = cvt_pk_bf16(x10[2], x10[3]); w1.z = cvt_pk_bf16(x11[0], x11[1]); w1.w = cvt_pk_bf16(x11[2], x11[3]);
                *(u32x4*)(rowp) = w0; *(u32x4*)(rowp + 32) = w1;
                asm volatile("" ::: "memory");
            }
    }
};
struct EpiZ {
    static constexpr bool PERM = true; static constexpr bool META = false; static constexpr bool TABDMA = false;
    const bf16_t* res; bf16_t* out;
    __device__ __forceinline__ void operator()(const f32x4 (&acc)[2][2][4][2], const Unit& u, int wr, int wc, int fr, int fq) const {
        const int row0 = u.pm * BM + wr * 64 + fr, col0 = u.pn * BM + wc * 32 + 8 * fq;
#pragma unroll
        for (int ai = 0; ai < 2; ++ai) { u32x4 r[4][2];
#pragma unroll
            for (int m = 0; m < 4; ++m)
#pragma unroll
                for (int bj = 0; bj < 2; ++bj) r[m][bj] = __builtin_nontemporal_load((const u32x4*)(res + (size_t)(row0 + ai * HALF + m * 16) * DM + col0 + bj * HALF));
#pragma unroll
            for (int m = 0; m < 4; ++m) { const size_t off = (size_t)(row0 + ai * HALF + m * 16) * DM + col0;
#pragma unroll
                for (int bj = 0; bj < 2; ++bj) { const u32x4 rr = r[m][bj];
                    const f32x4 a0 = acc[ai][bj][m][0], a1 = acc[ai][bj][m][1]; u32x4 w;
                    w.x = cvt_pk_bf16(bflo(rr.x) * ALPHA + a0[0], bfhi(rr.x) * ALPHA + a0[1]); w.y = cvt_pk_bf16(bflo(rr.y) * ALPHA + a0[2], bfhi(rr.y) * ALPHA + a0[3]);
                    w.z = cvt_pk_bf16(bflo(rr.z) * ALPHA + a1[0], bfhi(rr.z) * ALPHA + a1[1]); w.w = cvt_pk_bf16(bflo(rr.w) * ALPHA + a1[2], bfhi(rr.w) * ALPHA + a1[3]);
                    *(u32x4*)(out + off + bj * HALF) = w; } } }
    }
};
struct EpiGU {
    static constexpr bool PERM = true; static constexpr bool META = false; static constexpr bool TABDMA = false;
    bf16_t* H;
    __device__ __forceinline__ void operator()(const f32x4 (&acc)[2][2][4][2], const Unit& u, int wr, int wc, int fr, int fq) const {
        const int row0 = u.pm * BM + wr * 64 + fr, col0 = u.pn * HALF + wc * 32 + 8 * fq;
#pragma unroll
        for (int ai = 0; ai < 2; ++ai)
#pragma unroll
            for (int m = 0; m < 4; ++m) { float hv[8];
#pragma unroll
                for (int n = 0; n < 2; ++n)
#pragma unroll
                    for (int j = 0; j < 4; ++j) { const float g = acc[ai][0][m][n][j], uu = acc[ai][1][m][n][j];
                        hv[n * 4 + j] = g * __builtin_amdgcn_rcpf(1.f + __builtin_amdgcn_exp2f(-1.4426950408889634f * g)) * uu; }
                u32x4 w; w.x = cvt_pk_bf16(hv[0], hv[1]); w.y = cvt_pk_bf16(hv[2], hv[3]); w.z = cvt_pk_bf16(hv[4], hv[5]); w.w = cvt_pk_bf16(hv[6], hv[7]);
                store16_sc1(H + (size_t)(row0 + ai * HALF + m * 16) * DEXP + col0, w); }
    }
};
struct EpiDown {
    static constexpr bool PERM = true; static constexpr bool META = true; static constexpr bool TABDMA = false;
    bf16_t* Y; const int* rowmap; const float* roww; const LAS int* meta;
    __device__ __forceinline__ const int* meta_src(const Unit& u, int part) const { return part ? (const int*)(roww + (size_t)u.e * RCAP + u.ti * BM) : rowmap + (size_t)u.e * RCAP + u.ti * BM; }
    __device__ __forceinline__ void operator()(const f32x4 (&acc)[2][2][4][2], const Unit& u, int wr, int wc, int fr, int fq) const {
        const LAS int* rm = meta + (u.ord & 1) * 512; const LAS float* rw = (const LAS float*)(rm + 256);
        const int col0 = u.pn * BM + wc * 32 + 8 * fq;
#pragma unroll
        for (int ai = 0; ai < 2; ++ai)
#pragma unroll
            for (int m = 0; m < 4; ++m) { const int r = ai * HALF + wr * 64 + m * 16 + fr;
                if (r < u.nv) { const int code = rm[r]; const float s = rw[r];
                    bf16_t* rowp = Y + ((size_t)(code & 1) * NTOK + (size_t)(code >> 1)) * DM + col0;
#pragma unroll
                    for (int bj = 0; bj < 2; ++bj) { const f32x4 v0 = acc[ai][bj][m][0] * s, v1 = acc[ai][bj][m][1] * s; u32x4 w;
                        w.x = cvt_pk_bf16(v0[0], v0[1]); w.y = cvt_pk_bf16(v0[2], v0[3]); w.z = cvt_pk_bf16(v1[0], v1[1]); w.w = cvt_pk_bf16(v1[2], v1[3]);
                        *(u32x4*)(rowp + bj * HALF) = w; } } }
    }
};
}

namespace attn_body {
using bf16 = bf16_t;
constexpr int D = 64, NW = 8, QBLK = 32, QB = QBLK * NW, KVBLK = 64;
__device__ __forceinline__ int crow(int r, int hi) { return (r & 3) + 8 * (r >> 2) + 4 * hi; }
#define SBAR() __builtin_amdgcn_sched_barrier(0)
constexpr int NSLOT = 3, SLOTB = 8192;
constexpr int LDS_K = 0, LDS_V = NSLOT * SLOTB, LDS_WS = 2 * NSLOT * SLOTB, LDS_OST = LDS_WS + NW * 64 * 4, LDS_BYTES_A = LDS_OST + NW * 4096;
__device__ __forceinline__ void glds16(const void* gsrc, unsigned lds_dst) { unsigned keep;
  asm volatile("s_mov_b32 %0, m0\n\ts_mov_b32 m0, %2\n\ts_nop 0\n\tglobal_load_lds_dwordx4 %1, off\n\ts_mov_b32 m0, %0" : "=&s"(keep) : "v"(gsrc), "s"(lds_dst) : "memory"); }
__device__ __forceinline__ float max3f(float a, float b, float c) { float r; asm("v_max3_f32 %0, %1, %2, %3" : "=v"(r) : "v"(a), "v"(b), "v"(c)); return r; }
__device__ __forceinline__ float max2f(float a, float b) { float r; asm("v_max_f32_e32 %0, %1, %2" : "=v"(r) : "v"(a), "v"(b)); return r; }
__device__ __forceinline__ float fadd_s(float a, float b) { float r; asm("v_add_f32_e32 %0, %1, %2" : "=v"(r) : "v"(a), "v"(b)); return r; }
__device__ __forceinline__ float fsub_s(float a, float b) { float r; asm("v_sub_f32_e32 %0, %1, %2" : "=v"(r) : "v"(a), "v"(b)); return r; }
typedef float f32x2_t __attribute__((ext_vector_type(2))); typedef __bf16 bf16x2_t __attribute__((ext_vector_type(2)));
__device__ __forceinline__ unsigned cvtpk_s(float lo, float hi) { f32x2_t v = {lo, hi}; bf16x2_t b = __builtin_convertvector(v, bf16x2_t); return __builtin_bit_cast(unsigned, b); }
#define WAIT_BAR(N) asm volatile("s_waitcnt vmcnt(" #N ") lgkmcnt(0)\n\ts_barrier" ::: "memory")
__device__ __forceinline__ void qkt(f32x16& p0, f32x16& p1, const char* Kslot, const bf16x8* qr, const f32x16& negm, int r32, int hi) {
  const char* kb = Kslot + hi * 1024 + r32 * 16;
  #pragma unroll
  for (int d0 = 0; d0 < 4; ++d0) {
    const bf16x8 b0 = *reinterpret_cast<const bf16x8*>(kb + d0 * 2048);
    const bf16x8 b1 = *reinterpret_cast<const bf16x8*>(kb + d0 * 2048 + 512);
    if (d0 == 0) { p0 = __builtin_amdgcn_mfma_f32_32x32x16_bf16(b0, qr[0], negm, 0, 0, 0); p1 = __builtin_amdgcn_mfma_f32_32x32x16_bf16(b1, qr[0], negm, 0, 0, 0); }
    else { p0 = __builtin_amdgcn_mfma_f32_32x32x16_bf16(b0, qr[d0], p0, 0, 0, 0); p1 = __builtin_amdgcn_mfma_f32_32x32x16_bf16(b1, qr[d0], p1, 0, 0, 0); } }
}
typedef __attribute__((address_space(3))) const char* lds_cptr;
typedef short v4i16_t __attribute__((ext_vector_type(4)));
__device__ __forceinline__ void kload8(bf16x8* kf, lds_cptr kp) {
  kf[0] = *(const LAS bf16x8*)(kp);        kf[1] = *(const LAS bf16x8*)(kp + 512);
  kf[2] = *(const LAS bf16x8*)(kp + 2048); kf[3] = *(const LAS bf16x8*)(kp + 2560);
  kf[4] = *(const LAS bf16x8*)(kp + 4096); kf[5] = *(const LAS bf16x8*)(kp + 4608);
  kf[6] = *(const LAS bf16x8*)(kp + 6144); kf[7] = *(const LAS bf16x8*)(kp + 6656);
}
__device__ __forceinline__ void kload2(bf16x8* kf, lds_cptr kp, int j) { kf[2 * j] = *(const LAS bf16x8*)(kp + j * 2048); kf[2 * j + 1] = *(const LAS bf16x8*)(kp + j * 2048 + 512); }
__device__ __forceinline__ s16x4 vtr(lds_cptr p) { return __builtin_bit_cast(s16x4, __builtin_amdgcn_ds_read_tr16_b64_v4i16((LAS v4i16_t*)p)); }
__device__ __forceinline__ float rowmax(const f32x16& p0, const f32x16& p1) {
  float a = max3f(p0[0], p0[1], p1[0]), b = max3f(p0[2], p0[3], p1[1]); a = max3f(a, p1[2], p1[3]);
  #pragma unroll
  for (int r = 4; r < 16; r += 4) { a = max3f(a, p0[r], p0[r + 1]); b = max3f(b, p0[r + 2], p0[r + 3]); a = max3f(a, p1[r], p1[r + 1]); b = max3f(b, p1[r + 2], p1[r + 3]); }
  const float m = max2f(a, b);
  auto rr = __builtin_amdgcn_permlane32_swap(__float_as_uint(m), __float_as_uint(m), false, false);
  return max2f(__uint_as_float(rr[0]), __uint_as_float(rr[1]));
}
__device__ __forceinline__ void pv(f32x16* o, int vb, bf16x8 pa0, bf16x8 pa1, bf16x8 pa2, bf16x8 pa3) {
  #pragma unroll
  for (int d0 = 0; d0 < 2; ++d0) { s16x4 lo[4], hi[4];
    #pragma unroll
    for (int ks = 0; ks < 4; ++ks) {
      asm volatile("ds_read_b64_tr_b16 %0,%1 offset:%c2" : "=&v"(lo[ks]) : "v"(vb), "i"(d0 * 4096 + ks * 1024) : "memory");
      asm volatile("ds_read_b64_tr_b16 %0,%1 offset:%c2" : "=&v"(hi[ks]) : "v"(vb), "i"(d0 * 4096 + ks * 1024 + 512) : "memory"); }
    asm volatile("s_waitcnt lgkmcnt(0)" ::: "memory"); SBAR();
    #define PK(k) (bf16x8){lo[k][0], lo[k][1], lo[k][2], lo[k][3], hi[k][0], hi[k][1], hi[k][2], hi[k][3]}
    o[d0] = __builtin_amdgcn_mfma_f32_32x32x16_bf16(pa0, PK(0), o[d0], 0, 0, 0);
    o[d0] = __builtin_amdgcn_mfma_f32_32x32x16_bf16(pa1, PK(1), o[d0], 0, 0, 0);
    o[d0] = __builtin_amdgcn_mfma_f32_32x32x16_bf16(pa2, PK(2), o[d0], 0, 0, 0);
    o[d0] = __builtin_amdgcn_mfma_f32_32x32x16_bf16(pa3, PK(3), o[d0], 0, 0, 0);
    #undef PK
  }
}
template<int THRL, int QP, int KP, int VP, int OP, int NT> __device__ __forceinline__ void attn_unit(const bf16* Qb, const bf16* __restrict__ Kb, const bf16* __restrict__ Vb, bf16* Ob, const int q0, char* shm, const int tid) {
  const int lane = tid & 63, r32 = lane & 31, hi = lane >> 5; const int wid = __builtin_amdgcn_readfirstlane(tid >> 6);
  const bf16* Qw = Qb + (long)(q0 + wid * QBLK) * QP;
  const unsigned lds0 = (unsigned)(uintptr_t)shm;
  float* wsf = (float*)(shm + LDS_WS) + wid * 64;
  const bf16* ksrc = Kb + (long)lane * KP + wid * 8;
  const bf16* vsrc = Vb + (long)(16 * (wid & 3) + (lane >> 2)) * VP + (wid >> 2) * 32 + (lane & 3) * 8;
  const unsigned kdst = lds0 + LDS_K + wid * 1024, vdst = lds0 + LDS_V + wid * 1024;
  #define DMA_K(t, slot) glds16(ksrc + (long)(t) * KVBLK * KP, (unsigned)__builtin_amdgcn_readfirstlane(kdst + (slot)))
  #define DMA_V(t, slot) glds16(vsrc + (long)(t) * KVBLK * VP, (unsigned)__builtin_amdgcn_readfirstlane(vdst + (slot)))
  const int vb0 = (int)(lds0 + LDS_V) + ((lane >> 4) & 1) * 32 + (lane & 3) * 8 + (4 * hi + ((lane & 15) >> 2)) * 64;
  const char* Kbase = shm + LDS_K; bf16x8 kf[8];
  const lds_cptr shm3 = (lds_cptr)shm; const lds_cptr kp0 = shm3 + LDS_K + hi * 1024 + r32 * 16; const lds_cptr vp0 = shm3 + LDS_V + ((lane >> 4) & 1) * 32 + (lane & 3) * 8 + (4 * hi + ((lane & 15) >> 2)) * 64;
  DMA_K(0, 0); DMA_V(0, 0); DMA_K(1, SLOTB);
  bf16x8 qr[4];
  #pragma unroll
  for (int d0 = 0; d0 < 4; ++d0) qr[d0] = *reinterpret_cast<const bf16x8*>(&Qw[(long)r32 * QP + d0 * 16 + hi * 8]);
  float mhat = 0.f, l_reg = 0.f; f32x16 o[2]; o[0] = f32x16{}; o[1] = f32x16{}; float zz_ = 0.f; asm volatile("" : "+v"(zz_)); f32x16 negm; _Pragma("unroll") for (int r = 0; r < 16; ++r) negm[r] = zz_; asm volatile("" : "+v"(negm));
  bool resc = false;
  #define START(P0, P1) do { const float rm = rowmax(P0, P1); resc = false; \
    { const float dl = rm; mhat = fadd_s(mhat, dl); \
      _Pragma("unroll") for (int r = 0; r < 16; ++r) { P0[r] = fsub_s(P0[r], dl); P1[r] = fsub_s(P1[r], dl); } \
      _Pragma("unroll") for (int r = 0; r < 16; ++r) negm[r] = -mhat; asm volatile("" : "+v"(negm)); } \
    _Pragma("unroll") for (int r = 0; r < 16; ++r) P0[r] = __builtin_amdgcn_exp2f(P0[r]); } while (0)
  #define RESC() do { if (resc) { asm volatile("s_waitcnt lgkmcnt(0)" ::: "memory"); \
      _Pragma("unroll") for (int d_ = 0; d_ < 2; ++d_) _Pragma("unroll") for (int r = 0; r < 16; ++r) o[d_][r] *= wsf[crow(r, hi)]; } } while (0)
  f32x16 pA0, pA1, pB0, pB1;
  int sl_prev = 0, sl_cur = 0, sl_next = SLOTB;
  #define ROT() do { sl_prev = sl_cur; sl_cur = sl_next; sl_next = (sl_next == (NSLOT - 1) * SLOTB) ? 0 : sl_next + SLOTB; } while (0)
  DMA_K(2, 2 * SLOTB);
  WAIT_BAR(3);
  qkt(pA0, pA1, Kbase, qr, negm, r32, hi); asm volatile("s_nop 15\n\ts_nop 7" : "+v"(pA0), "+v"(pA1));
  START(pA0, pA1);
  _Pragma("unroll") for (int r = 0; r < 16; ++r) pA1[r] = __builtin_amdgcn_exp2f(pA1[r]);
  WAIT_BAR(0);
  DMA_K(3, 0); DMA_V(1, SLOTB);
  ROT();
  kload8(kf, kp0 + sl_cur);
  WAIT_BAR(2);
  s16x4 vlo[8], vhi[8]; u32x4 pw0, pw1, pw2, pw3;
  #define PKW(P, B) cvtpk_s(P[B], P[B + 1])
  #define PAF(k) __builtin_bit_cast(bf16x8, pw##k)
  #define VFR(i) (bf16x8){vlo[i][0], vlo[i][1], vlo[i][2], vlo[i][3], vhi[i][0], vhi[i][1], vhi[i][2], vhi[i][3]}
  #define PIN(x) asm volatile("" : "+v"(x))
  #define MX3(a, b, c) __builtin_fmaxf(__builtin_fmaxf((a), (b)), (c))
  #define GAPA(MF, A0, A1, A2, A3, W0, W1, PW) do { MF; sacc += A0; sacc += A1; sacc += A2; sacc += A3; PIN(sacc); W0; W1; PIN(PW); SBAR(); } while (0)
  #define EX(v) __builtin_amdgcn_exp2f(v)
  #define GAPB(MF, X, B) do { MF; X[B] = EX(X[B]); X[B + 1] = EX(X[B + 1]); X[B + 2] = EX(X[B + 2]); X[B + 3] = EX(X[B + 3]); PIN(X); SBAR(); } while (0)
  #define VRD(i) do { vlo[i] = vtr(vp_ + (((i) >> 2) * 4096 + ((i) & 3) * 1024)); vhi[i] = vtr(vp_ + (((i) >> 2) * 4096 + ((i) & 3) * 1024 + 512)); } while (0)
  #define KRD(G, j) do { if (G) { kload2(kf, kp0 + sl_next, j); SBAR(); } } while (0)
  #define STEP(C0, C1, P0, P1, t, GK, GV, GL) do { SBAR(); \
    const lds_cptr vp_ = vp0 + sl_prev; \
    VRD(0); SBAR(); float sacc = (P0[0] + P0[1]); \
    GAPA(C0 = __builtin_amdgcn_mfma_f32_32x32x16_bf16(kf[0], qr[0], negm, 0, 0, 0), P0[2], P0[3], P0[4], P0[5],     pw0[0] = PKW(P0, 0), pw0[1] = PKW(P0, 2), pw0); \
    VRD(4); SBAR(); GAPA(C1 = __builtin_amdgcn_mfma_f32_32x32x16_bf16(kf[1], qr[0], negm, 0, 0, 0), P0[6], P0[7], P0[8], P0[9],     pw0[2] = PKW(P0, 4), pw0[3] = PKW(P0, 6), pw0); \
    VRD(1); SBAR(); GAPA(C0 = __builtin_amdgcn_mfma_f32_32x32x16_bf16(kf[2], qr[1], C0, 0, 0, 0),   P0[10], P0[11], P0[12], P0[13], pw1[0] = PKW(P0, 8), pw1[1] = PKW(P0, 10), pw1); \
    VRD(5); SBAR(); GAPA(C1 = __builtin_amdgcn_mfma_f32_32x32x16_bf16(kf[3], qr[1], C1, 0, 0, 0),   P0[14], P0[15], P1[0], P1[1],   pw1[2] = PKW(P0, 12), pw1[3] = PKW(P0, 14), pw1); \
    VRD(2); SBAR(); GAPA(C0 = __builtin_amdgcn_mfma_f32_32x32x16_bf16(kf[4], qr[2], C0, 0, 0, 0),   P1[2], P1[3], P1[4], P1[5],     pw2[0] = PKW(P1, 0), pw2[1] = PKW(P1, 2), pw2); \
    VRD(6); SBAR(); GAPA(C1 = __builtin_amdgcn_mfma_f32_32x32x16_bf16(kf[5], qr[2], C1, 0, 0, 0),   P1[6], P1[7], P1[8], P1[9],     pw2[2] = PKW(P1, 4), pw2[3] = PKW(P1, 6), pw2); \
    VRD(3); SBAR(); GAPA(C0 = __builtin_amdgcn_mfma_f32_32x32x16_bf16(kf[6], qr[3], C0, 0, 0, 0),   P1[10], P1[11], P1[12], P1[13], pw3[0] = PKW(P1, 8), pw3[1] = PKW(P1, 10), pw3); \
    VRD(7); SBAR(); GAPA(C1 = __builtin_amdgcn_mfma_f32_32x32x16_bf16(kf[7], qr[3], C1, 0, 0, 0),   P1[14], P1[15], 0.f, 0.f,       pw3[2] = PKW(P1, 12), pw3[3] = PKW(P1, 14), pw3); \
    l_reg += sacc; \
    if (GK) { DMA_K((t) + 3, sl_cur); } if (GV) { DMA_V((t) + 1, sl_next); } \
    { float a = MX3(C0[0], C0[1], C1[0]), b = MX3(C0[2], C0[3], C1[1]); a = MX3(a, C1[2], C1[3]); \
      _Pragma("unroll") for (int r = 4; r < 16; r += 4) { a = MX3(a, C0[r], C0[r + 1]); b = MX3(b, C0[r + 2], C0[r + 3]); a = MX3(a, C1[r], C1[r + 1]); b = MX3(b, C1[r + 2], C1[r + 3]); } \
      float rm = __builtin_fmaxf(a, b); { auto rr = __builtin_amdgcn_permlane32_swap(__float_as_uint(rm), __float_as_uint(rm), false, false); rm = __builtin_fmaxf(__uint_as_float(rr[0]), __uint_as_float(rr[1])); } \
      resc = false; \
      if (__builtin_expect(__any(rm > (float)THRL), 0)) { const float dl = __builtin_fmaxf(rm, 0.f); mhat += dl; \
        _Pragma("unroll") for (int r = 0; r < 16; ++r) { C0[r] -= dl; C1[r] -= dl; } \
        _Pragma("unroll") for (int r = 0; r < 16; ++r) negm[r] = -mhat; asm volatile("" : "+v"(negm)); \
        const float f = __builtin_amdgcn_exp2f(-dl); l_reg *= f; if (hi == 0) wsf[r32] = f; resc = true; } } \
    SBAR(); \
    GAPB(o[0] = __builtin_amdgcn_mfma_f32_32x32x16_bf16(PAF(0), VFR(0), o[0], 0, 0, 0), C0, 0); \
    GAPB(o[1] = __builtin_amdgcn_mfma_f32_32x32x16_bf16(PAF(0), VFR(4), o[1], 0, 0, 0), C0, 4); \
    KRD(GL, 0); GAPB(o[0] = __builtin_amdgcn_mfma_f32_32x32x16_bf16(PAF(1), VFR(1), o[0], 0, 0, 0), C0, 8); \
    KRD(GL, 1); GAPB(o[1] = __builtin_amdgcn_mfma_f32_32x32x16_bf16(PAF(1), VFR(5), o[1], 0, 0, 0), C0, 12); \
    KRD(GL, 2); GAPB(o[0] = __builtin_amdgcn_mfma_f32_32x32x16_bf16(PAF(2), VFR(2), o[0], 0, 0, 0), C1, 0); \
    KRD(GL, 3); GAPB(o[1] = __builtin_amdgcn_mfma_f32_32x32x16_bf16(PAF(2), VFR(6), o[1], 0, 0, 0), C1, 4); \
    GAPB(o[0] = __builtin_amdgcn_mfma_f32_32x32x16_bf16(PAF(3), VFR(3), o[0], 0, 0, 0), C1, 8); \
    GAPB(o[1] = __builtin_amdgcn_mfma_f32_32x32x16_bf16(PAF(3), VFR(7), o[1], 0, 0, 0), C1, 12); \
    } while (0)
  int t = 1;
  for (; t + 5 < NT; t += 2) {
    STEP(pB0, pB1, pA0, pA1, t, true, true, true);     WAIT_BAR(2); RESC(); ROT();
    STEP(pA0, pA1, pB0, pB1, t + 1, true, true, true); WAIT_BAR(2); RESC(); ROT();
  }
  #define ENDW(tt) do { if ((tt) + 3 < NT) { WAIT_BAR(2); } else if ((tt) + 2 < NT) { WAIT_BAR(1); } else { WAIT_BAR(0); } } while (0)
  for (; t + 1 < NT; t += 2) {
    STEP(pB0, pB1, pA0, pA1, t, (t + 3 < NT), (t + 1 < NT), (t + 1 < NT));         ENDW(t);     RESC(); ROT();
    STEP(pA0, pA1, pB0, pB1, t + 1, (t + 4 < NT), (t + 2 < NT), (t + 2 < NT));     ENDW(t + 1); RESC(); ROT();
  }
  STEP(pB0, pB1, pA0, pA1, NT - 1, false, false, false); RESC();
  { float sacc = pB0[0] + pB0[1]; _Pragma("unroll") for (int r = 2; r < 16; ++r) sacc += pB0[r]; _Pragma("unroll") for (int r = 0; r < 16; ++r) sacc += pB1[r]; l_reg += sacc;
    pw0 = (u32x4){PKW(pB0, 0), PKW(pB0, 2), PKW(pB0, 4), PKW(pB0, 6)}; pw1 = (u32x4){PKW(pB0, 8), PKW(pB0, 10), PKW(pB0, 12), PKW(pB0, 14)}; pw2 = (u32x4){PKW(pB1, 0), PKW(pB1, 2), PKW(pB1, 4), PKW(pB1, 6)}; pw3 = (u32x4){PKW(pB1, 8), PKW(pB1, 10), PKW(pB1, 12), PKW(pB1, 14)};
    SBAR(); pv(o, vb0 + sl_cur, PAF(0), PAF(1), PAF(2), PAF(3)); }
  #undef PKW
  #undef PAF
  #undef VFR
  #undef PIN
  #undef MX3
  #undef GAPA
  #undef GAPB
  #undef EX
  #undef VRD
  #undef KRD
  #undef STEP
  #undef ENDW
  { auto rr = __builtin_amdgcn_permlane32_swap(__float_as_uint(l_reg), __float_as_uint(l_reg), false, false); l_reg = __uint_as_float(rr[0]) + __uint_as_float(rr[1]); }
  if (hi == 0) wsf[32 + r32] = l_reg; asm volatile("s_waitcnt lgkmcnt(0)" ::: "memory");
  float rli[16];
  #pragma unroll
  for (int r = 0; r < 16; ++r) rli[r] = __builtin_amdgcn_rcpf(wsf[32 + crow(r, hi)]);
  bf16* Ow = Ob + (long)(q0 + wid * QBLK) * OP;
  { bf16* stg = (bf16*)(shm + LDS_OST) + wid * 2048;
    #pragma unroll
    for (int r = 0; r < 16; ++r) { const int orow = crow(r, hi);
      #pragma unroll
      for (int d0 = 0; d0 < 2; ++d0) stg[orow * 64 + d0 * 32 + r32] = (bf16)f2bf(o[d0][r] * rli[r]); }
    asm volatile("s_waitcnt lgkmcnt(0)" ::: "memory");
    #pragma unroll
    for (int i = 0; i < 4; ++i) { const int row = i * 8 + (lane >> 3), ch = lane & 7; const u32x4 v = *(const u32x4*)(stg + row * 64 + ch * 8); *(u32x4*)(Ow + (long)row * OP + ch * 8) = v; } }
  asm volatile("s_waitcnt lgkmcnt(0)\n\ts_barrier" ::: "memory");
  #undef DMA_K
  #undef DMA_V
  #undef START
  #undef RESC
  #undef ROT
}
#undef WAIT_BAR

__device__ __forceinline__ void band_item(const bf16* P1, bf16* Od, const long opitch, float* lse, int b, int g, int h, int r, int qi, int dil, int Lr, char* wlds, int lane) {
  const int r32 = lane & 31, hi = lane >> 5;
  const long pitch = B_IN;
  const int colq = (g * 8 + h) * 64, colk = 1536 + colq, colv = 3072 + colq;
  const long row0 = (long)b * SEQ;
  bf16x8 qf[4];
  { const long tq = row0 + (long)(32 * qi + r32) * dil + r; const bf16* qp = P1 + tq * pitch + colq + hi * 8;
    #pragma unroll
    for (int d0 = 0; d0 < 4; ++d0) qf[d0] = *reinterpret_cast<const bf16x8*>(qp + d0 * 16); }
  f32x16 sc[5];
  const int nblk = Lr / 32;
  #pragma unroll
  for (int s = 0; s < 5; ++s) {
    const int kb = qi - 2 + s;
    if (kb >= 0 && kb < nblk) {
      const long tk = row0 + (long)(32 * kb + r32) * dil + r; const bf16* kp = P1 + tk * pitch + colk + hi * 8;
      bf16x8 kf[4];
      #pragma unroll
      for (int d0 = 0; d0 < 4; ++d0) kf[d0] = *reinterpret_cast<const bf16x8*>(kp + d0 * 16);
      f32x16 a = f32x16{};
      #pragma unroll
      for (int d0 = 0; d0 < 4; ++d0) a = __builtin_amdgcn_mfma_f32_32x32x16_bf16(kf[d0], qf[d0], a, 0, 0, 0);
      if (s == 0) {
        #pragma unroll
        for (int rg = 0; rg < 16; ++rg) { const int j = crow(rg, hi); if (j < r32) a[rg] = -INFINITY; } }
      if (s == 4) {
        #pragma unroll
        for (int rg = 0; rg < 16; ++rg) { const int j = crow(rg, hi); if (j > r32) a[rg] = -INFINITY; } }
      sc[s] = a;
    } else {
      #pragma unroll
      for (int rg = 0; rg < 16; ++rg) sc[s][rg] = -INFINITY;
    }
  }
  float m = -INFINITY;
  #pragma unroll
  for (int s = 0; s < 5; ++s)
    #pragma unroll
    for (int rg = 0; rg < 16; ++rg) m = __builtin_fmaxf(m, sc[s][rg]);
  { auto rr = __builtin_amdgcn_permlane32_swap(__float_as_uint(m), __float_as_uint(m), false, false); m = __builtin_fmaxf(__uint_as_float(rr[0]), __uint_as_float(rr[1])); }
  float l = 0.f;
  #pragma unroll
  for (int s = 0; s < 5; ++s)
    #pragma unroll
    for (int rg = 0; rg < 16; ++rg) { const float p = __builtin_amdgcn_exp2f(sc[s][rg] - m); sc[s][rg] = p; l += p; }
  { auto rr = __builtin_amdgcn_permlane32_swap(__float_as_uint(l), __float_as_uint(l), false, false); l = __uint_as_float(rr[0]) + __uint_as_float(rr[1]); }
  f32x16 o[2]; o[0] = f32x16{}; o[1] = f32x16{};
  const lds_cptr w3 = (lds_cptr)wlds;
  const lds_cptr vrd = w3 + ((lane >> 4) & 1) * 32 + (lane & 3) * 8 + (4 * hi + ((lane & 15) >> 2)) * 64;
  #pragma unroll
  for (int s = 0; s < 5; ++s) {
    const int kb = qi - 2 + s;
    if (kb >= 0 && kb < nblk) {
      u32x4 vv[4];
      #pragma unroll
      for (int i = 0; i < 4; ++i) { const int c = i * 64 + lane, row = c >> 3, ch = c & 7; const long tv = row0 + (long)(32 * kb + row) * dil + r;
        vv[i] = *reinterpret_cast<const u32x4*>(P1 + tv * pitch + colv + ch * 8); }
      asm volatile("s_waitcnt lgkmcnt(0)" ::: "memory");
      #pragma unroll
      for (int i = 0; i < 4; ++i) { const int c = i * 64 + lane, row = c >> 3, ch = c & 7; *(LAS u32x4*)((LAS char*)wlds + (ch >> 2) * 2048 + row * 64 + (ch & 3) * 16) = vv[i]; }
      asm volatile("s_waitcnt lgkmcnt(0)" ::: "memory");
      #pragma unroll
      for (int ks = 0; ks < 2; ++ks) {
        u32x4 pw; pw[0] = cvtpk_s(sc[s][8 * ks + 0], sc[s][8 * ks + 1]); pw[1] = cvtpk_s(sc[s][8 * ks + 2], sc[s][8 * ks + 3]); pw[2] = cvtpk_s(sc[s][8 * ks + 4], sc[s][8 * ks + 5]); pw[3] = cvtpk_s(sc[s][8 * ks + 6], sc[s][8 * ks + 7]);
        const bf16x8 pa = __builtin_bit_cast(bf16x8, pw);
        #pragma unroll
        for (int d0 = 0; d0 < 2; ++d0) {
          const s16x4 lo = vtr(vrd + d0 * 2048 + ks * 1024), hh = vtr(vrd + d0 * 2048 + ks * 1024 + 512);
          const bf16x8 vf = (bf16x8){lo[0], lo[1], lo[2], lo[3], hh[0], hh[1], hh[2], hh[3]};
          o[d0] = __builtin_amdgcn_mfma_f32_32x32x16_bf16(pa, vf, o[d0], 0, 0, 0); }
      }
    }
  }
  asm volatile("s_waitcnt lgkmcnt(0)" ::: "memory");
  float* wsf = (float*)(wlds + 4096);
  if (hi == 0) { wsf[r32] = l; const long tq = row0 + (long)(32 * qi + r32) * dil + r; lse[((long)g * NTOK + tq) * 8 + h] = m + __builtin_amdgcn_logf(l); }
  asm volatile("s_waitcnt lgkmcnt(0)" ::: "memory");
  float rli[16];
  #pragma unroll
  for (int rg = 0; rg < 16; ++rg) rli[rg] = __builtin_amdgcn_rcpf(wsf[crow(rg, hi)]);
  bf16* stg = (bf16*)wlds;
  #pragma unroll
  for (int rg = 0; rg < 16; ++rg) { const int orow = crow(rg, hi);
    #pragma unroll
    for (int d0 = 0; d0 < 2; ++d0) stg[orow * 64 + d0 * 32 + r32] = (bf16)f2bf(o[d0][rg] * rli[rg]); }
  asm volatile("s_waitcnt lgkmcnt(0)" ::: "memory");
  #pragma unroll
  for (int i = 0; i < 4; ++i) { const int row = i * 8 + (lane >> 3), ch = lane & 7; const u32x4 v = *(const u32x4*)(stg + row * 64 + ch * 8);
    const long tq = row0 + (long)(32 * qi + row) * dil + r; *(u32x4*)(Od + tq * opitch + colq + ch * 8) = v; }
  asm volatile("s_waitcnt lgkmcnt(0)" ::: "memory");
}

constexpr int BU_K = 0, BU_V = 49152, BU_W = 98304;
__device__ __forceinline__ void band_unit(const bf16* P1, bf16* Od, const long opitch, float* lse, const int b, const int g, const int h, const int u8, char* shm, const int tid) {
  const int lane = tid & 63, r32 = lane & 31, hi = lane >> 5; const int wid = __builtin_amdgcn_readfirstlane(tid >> 6);
  const long pitch = B_IN;
  const int colq = (g * 8 + h) * 64, colk = 1536 + colq, colv = 3072 + colq;
  const long row0 = (long)b * SEQ;
  const int dil = (g == 0) ? 1 : (g == 1 ? 4 : 16), Lr = SEQ / dil, nblk = Lr / 32;
  int rA, l0; if (g < 2) { const int upr = Lr / 256; rA = u8 / upr; l0 = (u8 % upr) * 256; } else { rA = 2 * u8; l0 = 0; }
  const int r_w = (g < 2) ? rA : rA + (wid >> 2), l_w = (g < 2) ? l0 + 32 * wid : 32 * (wid & 3);
  const unsigned lds0 = (unsigned)(uintptr_t)shm;
#pragma unroll
  for (int T = 0; T < 6; ++T) {
    int r_T, l_T; bool valid;
    if (g < 2) { l_T = l0 - 64 + 64 * T; r_T = rA; valid = (l_T >= 0) && (l_T < Lr); } else { valid = T < 4; r_T = rA + (T >> 1); l_T = 64 * (T & 1); }
    if (valid) {
      const bf16* ks = P1 + (row0 + (long)(l_T + lane) * dil + r_T) * pitch + colk + wid * 8;
      const bf16* vs = P1 + (row0 + (long)(l_T + 16 * (wid & 3) + (lane >> 2)) * dil + r_T) * pitch + colv + (wid >> 2) * 32 + (lane & 3) * 8;
      glds16(ks, (unsigned)__builtin_amdgcn_readfirstlane(lds0 + BU_K + T * 8192 + wid * 1024));
      glds16(vs, (unsigned)__builtin_amdgcn_readfirstlane(lds0 + BU_V + T * 8192 + wid * 1024));
    }
  }
  bf16x8 qf[4];
  { const long tq = row0 + (long)(l_w + r32) * dil + r_w; const bf16* qp = P1 + tq * pitch + colq + hi * 8;
    #pragma unroll
    for (int d0 = 0; d0 < 4; ++d0) qf[d0] = *reinterpret_cast<const bf16x8*>(qp + d0 * 16); }
  asm volatile("s_waitcnt vmcnt(0) lgkmcnt(0)\n\ts_barrier" ::: "memory");
  const lds_cptr s3 = (lds_cptr)shm;
  f32x16 sc[5];
  const int kb0 = l_w / 32 - 2;
  #pragma unroll
  for (int s = 0; s < 5; ++s) {
    const int kb = kb0 + s;
    if (kb >= 0 && kb < nblk) {
      const int st = (g < 2) ? (wid + s) : (4 * (wid >> 2) + kb);
      const lds_cptr kp = s3 + BU_K + (st >> 1) * 8192 + hi * 1024 + ((st & 1) * 32 + r32) * 16;
      f32x16 a = f32x16{};
      #pragma unroll
      for (int d0 = 0; d0 < 4; ++d0) { const bf16x8 kf = *(const LAS bf16x8*)(kp + d0 * 2048); a = __builtin_amdgcn_mfma_f32_32x32x16_bf16(kf, qf[d0], a, 0, 0, 0); }
      if (s == 0) {
        #pragma unroll
        for (int rg = 0; rg < 16; ++rg) { const int j = crow(rg, hi); if (j < r32) a[rg] = -INFINITY; } }
      if (s == 4) {
        #pragma unroll
        for (int rg = 0; rg < 16; ++rg) { const int j = crow(rg, hi); if (j > r32) a[rg] = -INFINITY; } }
      sc[s] = a;
    } else {
      #pragma unroll
      for (int rg = 0; rg < 16; ++rg) sc[s][rg] = -INFINITY;
    }
  }
  float m = -INFINITY;
  #pragma unroll
  for (int s = 0; s < 5; ++s)
    #pragma unroll
    for (int rg = 0; rg < 16; ++rg) m = __builtin_fmaxf(m, sc[s][rg]);
  { auto rr = __builtin_amdgcn_permlane32_swap(__float_as_uint(m), __float_as_uint(m), false, false); m = __builtin_fmaxf(__uint_as_float(rr[0]), __uint_as_float(rr[1])); }
  float l = 0.f;
  #pragma unroll
  for (int s = 0; s < 5; ++s)
    #pragma unroll
    for (int rg = 0; rg < 16; ++rg) { const float p = __builtin_amdgcn_exp2f(sc[s][rg] - m); sc[s][rg] = p; l += p; }
  { auto rr = __builtin_amdgcn_permlane32_swap(__float_as_uint(l), __float_as_uint(l), false, false); l = __uint_as_float(rr[0]) + __uint_as_float(rr[1]); }
  f32x16 o[2]; o[0] = f32x16{}; o[1] = f32x16{};
  const lds_cptr vrd = s3 + BU_V + ((lane >> 4) & 1) * 32 + (lane & 3) * 8 + (4 * hi + ((lane & 15) >> 2)) * 64;
  #pragma unroll
  for (int s = 0; s < 5; ++s) {
    const int kb = kb0 + s;
    if (kb >= 0 && kb < nblk) {
      const int st = (g < 2) ? (wid + s) : (4 * (wid >> 2) + kb);
      const lds_cptr vt = vrd + (st >> 1) * 8192 + (st & 1) * 2048;
      #pragma unroll
      for (int ks = 0; ks < 2; ++ks) {
        u32x4 pw; pw[0] = cvtpk_s(sc[s][8 * ks + 0], sc[s][8 * ks + 1]); pw[1] = cvtpk_s(sc[s][8 * ks + 2], sc[s][8 * ks + 3]); pw[2] = cvtpk_s(sc[s][8 * ks + 4], sc[s][8 * ks + 5]); pw[3] = cvtpk_s(sc[s][8 * ks + 6], sc[s][8 * ks + 7]);
        const bf16x8 pa = __builtin_bit_cast(bf16x8, pw);
        #pragma unroll
        for (int d0 = 0; d0 < 2; ++d0) {
          const s16x4 lo = vtr(vt + d0 * 4096 + ks * 1024), hh = vtr(vt + d0 * 4096 + ks * 1024 + 512);
          const bf16x8 vf = (bf16x8){lo[0], lo[1], lo[2], lo[3], hh[0], hh[1], hh[2], hh[3]};
          o[d0] = __builtin_amdgcn_mfma_f32_32x32x16_bf16(pa, vf, o[d0], 0, 0, 0); }
      }
    }
  }
  char* wl = shm + BU_W + wid * 4096;
  float* wsf = (float*)wl;
  if (hi == 0) { wsf[r32] = l; const long tq = row0 + (long)(l_w + r32) * dil + r_w; lse[((long)g * NTOK + tq) * 8 + h] = m + __builtin_amdgcn_logf(l); }
  asm volatile("s_waitcnt lgkmcnt(0)" ::: "memory");
  float rli[16];
  #pragma unroll
  for (int rg = 0; rg < 16; ++rg) rli[rg] = __builtin_amdgcn_rcpf(wsf[crow(rg, hi)]);
  asm volatile("s_waitcnt lgkmcnt(0)" ::: "memory");
  bf16* stg = (bf16*)wl;
  #pragma unroll
  for (int rg = 0; rg < 16; ++rg) { const int orow = crow(rg, hi);
    #pragma unroll
    for (int d0 = 0; d0 < 2; ++d0) stg[orow * 64 + d0 * 32 + r32] = (bf16)f2bf(o[d0][rg] * rli[rg]); }
  asm volatile("s_waitcnt lgkmcnt(0)" ::: "memory");
  #pragma unroll
  for (int i = 0; i < 4; ++i) { const int row = i * 8 + (lane >> 3), ch = lane & 7; const u32x4 v = *(const u32x4*)(stg + row * 64 + ch * 8);
    const long tq = row0 + (long)(l_w + row) * dil + r_w; *(u32x4*)(Od + tq * opitch + colq + ch * 8) = v; }
  asm volatile("s_waitcnt lgkmcnt(0)\n\ts_barrier" ::: "memory");
}

struct BandGeo { int g, h, dil, Lr, nblk, rA, l0, r_w, l_w; long row0; int colq; };
__device__ __forceinline__ BandGeo band_geo(const int U, const int wid) {
  BandGeo G; const int u8 = U & 7, bhg = U >> 3; G.g = bhg % 3; const int bh = bhg / 3; G.h = bh & 7; const int b = bh >> 3;
  G.dil = (G.g == 0) ? 1 : (G.g == 1 ? 4 : 16); G.Lr = SEQ / G.dil; G.nblk = G.Lr / 32;
  if (G.g < 2) { const int upr = G.Lr / 256; G.rA = u8 / upr; G.l0 = (u8 % upr) * 256; G.r_w = G.rA; G.l_w = G.l0 + 32 * wid; }
  else { G.rA = 2 * u8; G.l0 = 0; G.r_w = G.rA + (wid >> 2); G.l_w = 32 * (wid & 3); }
  G.row0 = (long)b * SEQ; G.colq = (G.g * 8 + G.h) * 64; return G;
}
template <bool ISV> __device__ __forceinline__ void band_stage(const bf16* P1, const BandGeo& G, const unsigned lds0, const int wid, const int lane) {
#pragma unroll
  for (int T = 0; T < 6; ++T) {
    int r_T, l_T; bool valid;
    if (G.g < 2) { l_T = G.l0 - 64 + 64 * T; r_T = G.rA; valid = (l_T >= 0) && (l_T < G.Lr); } else { valid = T < 4; r_T = G.rA + (T >> 1); l_T = 64 * (T & 1); }
    if (valid) {
      if (!ISV) { const bf16* ks = P1 + (G.row0 + (long)(l_T + lane) * G.dil + r_T) * (long)B_IN + 1536 + G.colq + wid * 8;
        glds16(ks, (unsigned)__builtin_amdgcn_readfirstlane(lds0 + BU_K + T * 8192 + wid * 1024)); }
      else { const bf16* vs = P1 + (G.row0 + (long)(l_T + 16 * (wid & 3) + (lane >> 2)) * G.dil + r_T) * (long)B_IN + 3072 + G.colq + (wid >> 2) * 32 + (lane & 3) * 8;
        glds16(vs, (unsigned)__builtin_amdgcn_readfirstlane(lds0 + BU_V + T * 8192 + wid * 1024)); }
    }
  }
}
__device__ __forceinline__ void band_phase(const bf16* P1, float* lse, const int U0, const int NU, char* shm, const int tid) {
  const int lane = tid & 63, r32 = lane & 31, hi = lane >> 5; const int wid = __builtin_amdgcn_readfirstlane(tid >> 6);
  const long pitch = B_IN;
  const unsigned lds0 = (unsigned)(uintptr_t)shm;
  const lds_cptr s3 = (lds_cptr)shm;
  BandGeo G = band_geo(U0, wid);
  band_stage<false>(P1, G, lds0, wid, lane); band_stage<true>(P1, G, lds0, wid, lane);
  bf16x8 qf[4], qn[4];
  { const long tq = G.row0 + (long)(G.l_w + r32) * G.dil + G.r_w; const bf16* qp = P1 + tq * pitch + G.colq + hi * 8;
    #pragma unroll
    for (int d0 = 0; d0 < 4; ++d0) qf[d0] = *reinterpret_cast<const bf16x8*>(qp + d0 * 16); }
  asm volatile("s_waitcnt vmcnt(0) lgkmcnt(0)\n\ts_barrier" ::: "memory");
#pragma unroll 1
  for (int i = 0; i < NU; ++i) {
    f32x16 sc[5];
    const int kb0 = G.l_w / 32 - 2;
    #pragma unroll
    for (int s = 0; s < 5; ++s) {
      const int kb = kb0 + s;
      if (kb >= 0 && kb < G.nblk) {
        const int st = (G.g < 2) ? (wid + s) : (4 * (wid >> 2) + kb);
        const lds_cptr kp = s3 + BU_K + (st >> 1) * 8192 + hi * 1024 + ((st & 1) * 32 + r32) * 16;
        f32x16 a = f32x16{};
        #pragma unroll
        for (int d0 = 0; d0 < 4; ++d0) { const bf16x8 kf = *(const LAS bf16x8*)(kp + d0 * 2048); a = __builtin_amdgcn_mfma_f32_32x32x16_bf16(kf, qf[d0], a, 0, 0, 0); }
        if (s == 0) {
          #pragma unroll
          for (int rg = 0; rg < 16; ++rg) { const int j = crow(rg, hi); if (j < r32) a[rg] = -INFINITY; } }
        if (s == 4) {
          #pragma unroll
          for (int rg = 0; rg < 16; ++rg) { const int j = crow(rg, hi); if (j > r32) a[rg] = -INFINITY; } }
        sc[s] = a;
      } else {
        #pragma unroll
        for (int rg = 0; rg < 16; ++rg) sc[s][rg] = -INFINITY;
      }
    }
    float m = -INFINITY;
    #pragma unroll
    for (int s = 0; s < 5; ++s)
      #pragma unroll
      for (int rg = 0; rg < 16; ++rg) m = __builtin_fmaxf(m, sc[s][rg]);
    { auto rr = __builtin_amdgcn_permlane32_swap(__float_as_uint(m), __float_as_uint(m), false, false); m = __builtin_fmaxf(__uint_as_float(rr[0]), __uint_as_float(rr[1])); }
    float l = 0.f;
    #pragma unroll
    for (int s = 0; s < 5; ++s)
      #pragma unroll
      for (int rg = 0; rg < 16; ++rg) { const float p = __builtin_amdgcn_exp2f(sc[s][rg] - m); sc[s][rg] = p; l += p; }
    { auto rr = __builtin_amdgcn_permlane32_swap(__float_as_uint(l), __float_as_uint(l), false, false); l = __uint_as_float(rr[0]) + __uint_as_float(rr[1]); }
    asm volatile("s_waitcnt vmcnt(0) lgkmcnt(0)\n\ts_barrier" ::: "memory");
    const bool more = (i + 1 < NU);
    BandGeo Gn = G;
    if (more) { Gn = band_geo(U0 + i + 1, wid); band_stage<false>(P1, Gn, lds0, wid, lane);
      const long tq = Gn.row0 + (long)(Gn.l_w + r32) * Gn.dil + Gn.r_w; const bf16* qp = P1 + tq * pitch + Gn.colq + hi * 8;
      #pragma unroll
      for (int d0 = 0; d0 < 4; ++d0) qn[d0] = *reinterpret_cast<const bf16x8*>(qp + d0 * 16); }
    f32x16 o[2]; o[0] = f32x16{}; o[1] = f32x16{};
    const lds_cptr vrd = s3 + BU_V + ((lane >> 4) & 1) * 32 + (lane & 3) * 8 + (4 * hi + ((lane & 15) >> 2)) * 64;
    #pragma unroll
    for (int s = 0; s < 5; ++s) {
      const int kb = kb0 + s;
      if (kb >= 0 && kb < G.nblk) {
        const int st = (G.g < 2) ? (wid + s) : (4 * (wid >> 2) + kb);
        const lds_cptr vt = vrd + (st >> 1) * 8192 + (st & 1) * 2048;
        #pragma unroll
        for (int ks = 0; ks < 2; ++ks) {
          u32x4 pw; pw[0] = cvtpk_s(sc[s][8 * ks + 0], sc[s][8 * ks + 1]); pw[1] = cvtpk_s(sc[s][8 * ks + 2], sc[s][8 * ks + 3]); pw[2] = cvtpk_s(sc[s][8 * ks + 4], sc[s][8 * ks + 5]); pw[3] = cvtpk_s(sc[s][8 * ks + 6], sc[s][8 * ks + 7]);
          const bf16x8 pa = __builtin_bit_cast(bf16x8, pw);
          #pragma unroll
          for (int d0 = 0; d0 < 2; ++d0) {
            const s16x4 lo = vtr(vt + d0 * 4096 + ks * 1024), hh = vtr(vt + d0 * 4096 + ks * 1024 + 512);
            const bf16x8 vf = (bf16x8){lo[0], lo[1], lo[2], lo[3], hh[0], hh[1], hh[2], hh[3]};
            o[d0] = __builtin_amdgcn_mfma_f32_32x32x16_bf16(pa, vf, o[d0], 0, 0, 0); }
        }
      }
    }
    char* wl = shm + BU_W + wid * 4096;
    float* wsf = (float*)wl;
    if (hi == 0) { wsf[r32] = l; const long tq = G.row0 + (long)(G.l_w + r32) * G.dil + G.r_w;
      __hip_atomic_store((unsigned*)(lse + ((long)G.g * NTOK + tq) * 8 + G.h), __float_as_uint(m + __builtin_amdgcn_logf(l)), __ATOMIC_RELAXED, __HIP_MEMORY_SCOPE_AGENT); }
    asm volatile("s_waitcnt lgkmcnt(0)" ::: "memory");
    float rli[16];
    #pragma unroll
    for (int rg = 0; rg < 16; ++rg) rli[rg] = __builtin_amdgcn_rcpf(wsf[crow(rg, hi)]);
    asm volatile("s_waitcnt lgkmcnt(0)" ::: "memory");
    bf16* stg = (bf16*)wl;
    #pragma unroll
    for (int rg = 0; rg < 16; ++rg) { const int orow = crow(rg, hi);
      #pragma unroll
      for (int d0 = 0; d0 < 2; ++d0) stg[orow * 64 + d0 * 32 + r32] = (bf16)f2bf(o[d0][rg] * rli[rg]); }
    asm volatile("s_waitcnt lgkmcnt(0)" ::: "memory");
    #pragma unroll
    for (int k = 0; k < 4; ++k) { const int row = k * 8 + (lane >> 3), ch = lane & 7; const u32x4 v = *(const u32x4*)(stg + row * 64 + ch * 8);
      const long tq = G.row0 + (long)(G.l_w + row) * G.dil + G.r_w; store16_sc1(const_cast<bf16*>(P1) + tq * pitch + G.colq + ch * 8, v); }
    asm volatile("s_waitcnt vmcnt(0) lgkmcnt(0)\n\ts_barrier" ::: "memory");
    if (more) { band_stage<true>(P1, Gn, lds0, wid, lane);
      #pragma unroll
      for (int d0 = 0; d0 < 4; ++d0) qf[d0] = qn[d0]; }
    G = Gn;
  }
}
__device__ __forceinline__ void band_phase_dyn(const bf16* P1, float* lse, const int Ubase, const int NUL, unsigned* qcnt, unsigned* mrg, volatile LAS unsigned* qlds, char* shm, const int tid) {
  const int lane = tid & 63, r32 = lane & 31, hi = lane >> 5; const int wid = __builtin_amdgcn_readfirstlane(tid >> 6);
  const long pitch = B_IN;
  const unsigned lds0 = (unsigned)(uintptr_t)shm;
  const lds_cptr s3 = (lds_cptr)shm;
  if (tid == 0) qlds[0] = __hip_atomic_fetch_add(qcnt, 2u, __ATOMIC_RELAXED, __HIP_MEMORY_SCOPE_AGENT);
  __syncthreads();
  int cur = (int)qlds[0], nxt = cur + 1;
  if (cur >= NUL) return;
  BandGeo G = band_geo(Ubase + cur, wid);
  band_stage<false>(P1, G, lds0, wid, lane); band_stage<true>(P1, G, lds0, wid, lane);
  bf16x8 qf[4], qn[4];
  { const long tq = G.row0 + (long)(G.l_w + r32) * G.dil + G.r_w; const bf16* qp = P1 + tq * pitch + G.colq + hi * 8;
    #pragma unroll
    for (int d0 = 0; d0 < 4; ++d0) qf[d0] = *reinterpret_cast<const bf16x8*>(qp + d0 * 16); }
  asm volatile("s_waitcnt vmcnt(0) lgkmcnt(0)\n\ts_barrier" ::: "memory");
#pragma unroll 1
  for (;;) {
    unsigned claim_ = 0u;
    if (tid == 0) claim_ = __hip_atomic_fetch_add(qcnt, 1u, __ATOMIC_RELAXED, __HIP_MEMORY_SCOPE_AGENT);
    f32x16 sc[5];
    const int kb0 = G.l_w / 32 - 2;
    #pragma unroll
    for (int s = 0; s < 5; ++s) {
      const int kb = kb0 + s;
      if (kb >= 0 && kb < G.nblk) {
        const int st = (G.g < 2) ? (wid + s) : (4 * (wid >> 2) + kb);
        const lds_cptr kp = s3 + BU_K + (st >> 1) * 8192 + hi * 1024 + ((st & 1) * 32 + r32) * 16;
        f32x16 a = f32x16{};
        #pragma unroll
        for (int d0 = 0; d0 < 4; ++d0) { const bf16x8 kf = *(const LAS bf16x8*)(kp + d0 * 2048); a = __builtin_amdgcn_mfma_f32_32x32x16_bf16(kf, qf[d0], a, 0, 0, 0); }
        if (s == 0) {
          #pragma unroll
          for (int rg = 0; rg < 16; ++rg) { const int j = crow(rg, hi); if (j < r32) a[rg] = -INFINITY; } }
        if (s == 4) {
          #pragma unroll
          for (int rg = 0; rg < 16; ++rg) { const int j = crow(rg, hi); if (j > r32) a[rg] = -INFINITY; } }
        sc[s] = a;
      } else {
        #pragma unroll
        for (int rg = 0; rg < 16; ++rg) sc[s][rg] = -INFINITY;
      }
    }
    float m = -INFINITY;
    #pragma unroll
    for (int s = 0; s < 5; ++s)
      #pragma unroll
      for (int rg = 0; rg < 16; ++rg) m = __builtin_fmaxf(m, sc[s][rg]);
    { auto rr = __builtin_amdgcn_permlane32_swap(__float_as_uint(m), __float_as_uint(m), false, false); m = __builtin_fmaxf(__uint_as_float(rr[0]), __uint_as_float(rr[1])); }
    float l = 0.f;
    #pragma unroll
    for (int s = 0; s < 5; ++s)
      #pragma unroll
      for (int rg = 0; rg < 16; ++rg) { const float p = __builtin_amdgcn_exp2f(sc[s][rg] - m); sc[s][rg] = p; l += p; }
    { auto rr = __builtin_amdgcn_permlane32_swap(__float_as_uint(l), __float_as_uint(l), false, false); l = __uint_as_float(rr[0]) + __uint_as_float(rr[1]); }
    if (tid == 0) qlds[1] = claim_;
    asm volatile("s_waitcnt vmcnt(0) lgkmcnt(0)\n\ts_barrier" ::: "memory");
    const int nxt2 = (int)qlds[1];
    const bool more = (nxt < NUL);
    BandGeo Gn = G;
    if (more) { Gn = band_geo(Ubase + nxt, wid); band_stage<false>(P1, Gn, lds0, wid, lane);
      const long tq = Gn.row0 + (long)(Gn.l_w + r32) * Gn.dil + Gn.r_w; const bf16* qp = P1 + tq * pitch + Gn.colq + hi * 8;
      #pragma unroll
      for (int d0 = 0; d0 < 4; ++d0) qn[d0] = *reinterpret_cast<const bf16x8*>(qp + d0 * 16); }
    f32x16 o[2]; o[0] = f32x16{}; o[1] = f32x16{};
    const lds_cptr vrd = s3 + BU_V + ((lane >> 4) & 1) * 32 + (lane & 3) * 8 + (4 * hi + ((lane & 15) >> 2)) * 64;
    #pragma unroll
    for (int s = 0; s < 5; ++s) {
      const int kb = kb0 + s;
      if (kb >= 0 && kb < G.nblk) {
        const int st = (G.g < 2) ? (wid + s) : (4 * (wid >> 2) + kb);
        const lds_cptr vt = vrd + (st >> 1) * 8192 + (st & 1) * 2048;
        #pragma unroll
        for (int ks = 0; ks < 2; ++ks) {
          u32x4 pw; pw[0] = cvtpk_s(sc[s][8 * ks + 0], sc[s][8 * ks + 1]); pw[1] = cvtpk_s(sc[s][8 * ks + 2], sc[s][8 * ks + 3]); pw[2] = cvtpk_s(sc[s][8 * ks + 4], sc[s][8 * ks + 5]); pw[3] = cvtpk_s(sc[s][8 * ks + 6], sc[s][8 * ks + 7]);
          const bf16x8 pa = __builtin_bit_cast(bf16x8, pw);
          #pragma unroll
          for (int d0 = 0; d0 < 2; ++d0) {
            const s16x4 lo = vtr(vt + d0 * 4096 + ks * 1024), hh = vtr(vt + d0 * 4096 + ks * 1024 + 512);
            const bf16x8 vf = (bf16x8){lo[0], lo[1], lo[2], lo[3], hh[0], hh[1], hh[2], hh[3]};
            o[d0] = __builtin_amdgcn_mfma_f32_32x32x16_bf16(pa, vf, o[d0], 0, 0, 0); }
        }
      }
    }
    char* wl = shm + BU_W + wid * 4096;
    float* wsf = (float*)wl;
    if (hi == 0) { wsf[r32] = l; const long tq = G.row0 + (long)(G.l_w + r32) * G.dil + G.r_w;
      __hip_atomic_store((unsigned*)(lse + ((long)G.g * NTOK + tq) * 8 + G.h), __float_as_uint(m + __builtin_amdgcn_logf(l)), __ATOMIC_RELAXED, __HIP_MEMORY_SCOPE_AGENT); }
    asm volatile("s_waitcnt lgkmcnt(0)" ::: "memory");
    float rli[16];
    #pragma unroll
    for (int rg = 0; rg < 16; ++rg) rli[rg] = __builtin_amdgcn_rcpf(wsf[crow(rg, hi)]);
    asm volatile("s_waitcnt lgkmcnt(0)" ::: "memory");
    bf16* stg = (bf16*)wl;
    #pragma unroll
    for (int rg = 0; rg < 16; ++rg) { const int orow = crow(rg, hi);
      #pragma unroll
      for (int d0 = 0; d0 < 2; ++d0) stg[orow * 64 + d0 * 32 + r32] = (bf16)f2bf(o[d0][rg] * rli[rg]); }
    asm volatile("s_waitcnt lgkmcnt(0)" ::: "memory");
    #pragma unroll
    for (int k = 0; k < 4; ++k) { const int row = k * 8 + (lane >> 3), ch = lane & 7; const u32x4 v = *(const u32x4*)(stg + row * 64 + ch * 8);
      const long tq = G.row0 + (long)(G.l_w + row) * G.dil + G.r_w; store16_sc1(const_cast<bf16*>(P1) + tq * pitch + G.colq + ch * 8, v); }
    asm volatile("s_waitcnt vmcnt(0) lgkmcnt(0)\n\ts_barrier" ::: "memory");
    if (tid == 0) __hip_atomic_fetch_add(mrg + 64 * ((Ubase + cur) / 24), 1u, __ATOMIC_RELAXED, __HIP_MEMORY_SCOPE_AGENT);
    if (!more) break;
    band_stage<true>(P1, Gn, lds0, wid, lane);
    #pragma unroll
    for (int d0 = 0; d0 < 4; ++d0) qf[d0] = qn[d0];
    G = Gn; cur = nxt; nxt = nxt2;
  }
}
#undef SBAR
}

struct Args { const float* in[18]; float* out; unsigned char* ws; int ph_lo, ph_hi; };
struct Frame {
    LAS unsigned char* lds; volatile LAS unsigned* MISC; gu32* ctl;
    int tid, lane, wave, vcu, G, bx;
    unsigned char* ws;
};

__device__ __forceinline__ void transpose_item(const float* W, int K, int N, bf16_t* WT, int k0, int n0, int drow0, LAS unsigned* T, int lane, int dstep = 32) {
    const int n4 = (lane & 15) * 4, rp = lane >> 4;
    f32x4 a[8], b[8];
#pragma unroll
    for (int i = 0; i < 8; ++i) { const float* p = W + (size_t)(k0 + 8 * i + 2 * rp) * N + n0 + n4; a[i] = __builtin_nontemporal_load((const GAS f32x4*)p); b[i] = __builtin_nontemporal_load((const GAS f32x4*)(p + N)); }
#pragma unroll
    for (int i = 0; i < 8; ++i)
#pragma unroll
        for (int j = 0; j < 4; ++j) T[(n4 + j) * 33 + 4 * i + rp] = pk2(a[i][j], b[i][j]);
    LDS_WAIT(); asm volatile("" ::: "memory");
    const int c = lane & 7;
#pragma unroll
    for (int j = 0; j < 8; ++j) { const int n = (lane >> 3) + 8 * j; const LAS unsigned* s = T + n * 33 + 4 * c;
        u32x4 o; o.x = s[0]; o.y = s[1]; o.z = s[2]; o.w = s[3];
        *(GAS u32x4*)(WT + (size_t)(drow0 + (n & 31) + (n >> 5) * dstep) * K + k0 + 8 * c) = o; }
    LDS_WAIT(); asm volatile("" ::: "memory");
}
struct TrDesc { const float* W; int K, N; bf16_t* WT; int k0, n0, drow0, dstep; };
__device__ __forceinline__ void tr_load(const TrDesc& d, f32x4 (&a)[8], f32x4 (&b)[8], int lane) {
    const int n4 = (lane & 15) * 4, rp = lane >> 4;
#pragma unroll
    for (int i = 0; i < 8; ++i) { const float* p = d.W + (size_t)(d.k0 + 8 * i + 2 * rp) * d.N + d.n0 + n4; a[i] = __builtin_nontemporal_load((const GAS f32x4*)p); b[i] = __builtin_nontemporal_load((const GAS f32x4*)(p + d.N)); }
}
__device__ __forceinline__ void tr_finish(const TrDesc& d, const f32x4 (&a)[8], const f32x4 (&b)[8], LAS unsigned* T, int lane) {
    const int n4 = (lane & 15) * 4, rp = lane >> 4;
#pragma unroll
    for (int i = 0; i < 8; ++i)
#pragma unroll
        for (int j = 0; j < 4; ++j) T[(n4 + j) * 33 + 4 * i + rp] = pk2(a[i][j], b[i][j]);
    LDS_WAIT(); asm volatile("" ::: "memory");
    const int c = lane & 7;
#pragma unroll
    for (int j = 0; j < 8; ++j) { const int n = (lane >> 3) + 8 * j; const LAS unsigned* s = T + n * 33 + 4 * c;
        u32x4 o; o.x = s[0]; o.y = s[1]; o.z = s[2]; o.w = s[3];
        *(GAS u32x4*)(d.WT + (size_t)(d.drow0 + (n & 31) + (n >> 5) * d.dstep) * d.K + d.k0 + 8 * c) = o; }
    LDS_WAIT(); asm volatile("" ::: "memory");
}
__device__ __forceinline__ TrDesc moe_item_desc(Frame& F, const float* wg, const float* wu, const float* wd, int layer, int it, const float* wx = nullptr) {
    bf16_t* WGU = (bf16_t*)(F.ws + ws_wgu(layer)); bf16_t* WD = (bf16_t*)(F.ws + ws_wd(layer));
    if (it >= 6144) { const int j = it - 6144, kb = j / 76, nb = j % 76; TrDesc x;
        x.W = wx; x.K = DM; x.N = B_IN; x.WT = (bf16_t*)(F.ws + WS_WBIN); x.k0 = 64 * kb; x.n0 = 64 * nb; x.drow0 = 256 * (nb >> 2) + 32 * (nb & 3); x.dstep = 128; return x; }
    const int job = it >> 7, loc = it & 127, e = job / 3, kind = job % 3; TrDesc d; d.dstep = 32;
    if (kind < 2) { d.W = (kind == 0 ? wg : wu) + ((size_t)layer * NEXP + e) * DM * DEXP; d.K = DM; d.N = DEXP; d.WT = WGU + (size_t)e * 1024 * DM;
        const int kb = loc >> 3, nb = loc & 7, n0 = 64 * nb; d.k0 = 64 * kb; d.n0 = n0; d.drow0 = 256 * (n0 >> 7) + (n0 & 127) + (kind ? 128 : 0); }
    else { d.W = wd + ((size_t)layer * NEXP + e) * DEXP * DM; d.K = DEXP; d.N = DM; d.WT = WD + (size_t)e * DM * DEXP; const int kb = loc >> 4, nb = loc & 15; d.k0 = 64 * kb; d.n0 = 64 * nb; d.drow0 = 64 * nb; }
    return d;
}
__device__ __forceinline__ void moe_convert6(Frame& F, const float* wg, const float* wu, const float* wd, LAS unsigned* T, int gw, int NGW) {
    f32x4 a0[8], b0[8], a1[8], b1[8];
    TrDesc d0 = moe_item_desc(F, wg, wu, wd, 0, gw), d1 = d0;
    tr_load(d0, a0, b0, F.lane);
#pragma unroll 1
    for (int k = 0; k < 6; k += 2) {
        { const int k1 = k + 1; d1 = moe_item_desc(F, wg, wu, wd, k1 / 3, gw + NGW * (k1 % 3)); tr_load(d1, a1, b1, F.lane); }
        tr_finish(d0, a0, b0, T, F.lane);
        if (k + 2 < 6) { const int k2 = k + 2; d0 = moe_item_desc(F, wg, wu, wd, k2 / 3, gw + NGW * (k2 % 3)); tr_load(d0, a0, b0, F.lane); }
        tr_finish(d1, a1, b1, T, F.lane);
    }
}
__device__ __forceinline__ void moe_convert_n(Frame& F, const float* wg, const float* wu, const float* wd, int layer, LAS unsigned* T, int it0, int step, int n) {
    f32x4 a0[8], b0[8], a1[8], b1[8];
    if (n <= 0) return;
    TrDesc d0 = moe_item_desc(F, wg, wu, wd, layer, it0), d1 = d0;
    tr_load(d0, a0, b0, F.lane);
#pragma unroll 1
    for (int k = 0; k < n; k += 2) {
        const bool has1 = k + 1 < n, has2 = k + 2 < n;
        if (has1) { d1 = moe_item_desc(F, wg, wu, wd, layer, it0 + step * (k + 1)); tr_load(d1, a1, b1, F.lane); }
        tr_finish(d0, a0, b0, T, F.lane);
        if (has2) { d0 = moe_item_desc(F, wg, wu, wd, layer, it0 + step * (k + 2)); tr_load(d0, a0, b0, F.lane); }
        if (has1) tr_finish(d1, a1, b1, T, F.lane);
    }
}
__device__ __forceinline__ void transpose_plain(const float* W, int K, int N, bf16_t* WT, int item, LAS unsigned* T, int lane) {
    const int nblk = N / 64, kb = item / nblk, nb = item % nblk; transpose_item(W, K, N, WT, 64 * kb, 64 * nb, 64 * nb, T, lane);
}
__device__ __forceinline__ void transpose_heads(const float* W, int K, int N, bf16_t* WT, int item, LAS unsigned* T, int lane) {
    const int nblk = N / 64, kb = item / nblk, nb = item % nblk; transpose_item(W, K, N, WT, 64 * kb, 64 * nb, 256 * (nb >> 2) + 32 * (nb & 3), T, lane, 128);
}
__device__ __forceinline__ void moe_weight_items(Frame& F, const float* wg, const float* wu, const float* wd, int layer, LAS unsigned* T, int it0, int it1, int step) {
    bf16_t* WGU = (bf16_t*)(F.ws + ws_wgu(layer)); bf16_t* WD = (bf16_t*)(F.ws + ws_wd(layer));
    for (int it = it0; it < it1 && it < 48 * 128; it += step) {
        const int job = it >> 7, loc = it & 127, e = job / 3, kind = job % 3;
        if (kind < 2) { const float* W = (kind == 0 ? wg : wu) + ((size_t)layer * NEXP + e) * DM * DEXP;
            const int kb = loc >> 3, nb = loc & 7, n0 = 64 * nb; const int drow0 = 256 * (n0 >> 7) + (n0 & 127) + (kind ? 128 : 0);
            transpose_item(W, DM, DEXP, WGU + (size_t)e * 1024 * DM, 64 * kb, n0, drow0, T, F.lane);
        } else { const float* W = wd + ((size_t)layer * NEXP + e) * DEXP * DM;
            const int kb = loc >> 4, nb = loc & 15; transpose_item(W, DEXP, DM, WD + (size_t)e * DM * DEXP, 64 * kb, 64 * nb, 64 * nb, T, F.lane); }
    }
}
__device__ __forceinline__ void cvt_rows_bf16(Frame& F, const float* src, bf16_t* dst, size_t n) {
    const size_t gt = (size_t)(F.vcu * NWAVES + F.wave) * 64 + F.lane, NT_ = (size_t)F.G * NWAVES * 64;
    for (size_t i = gt; i < n / 8; i += NT_) { const f32x4 a = __builtin_nontemporal_load((const GAS f32x4*)(src + i * 8)), b = __builtin_nontemporal_load((const GAS f32x4*)(src + i * 8 + 4));
        u32x4 o; o.x = pk2(a.x, a.y); o.y = pk2(a.z, a.w); o.z = pk2(b.x, b.y); o.w = pk2(b.z, b.w); *(GAS u32x4*)(dst + i * 8) = o; }
}

#define FSTAMP(F, k) do { if (PROBE_K >= 0 && (F).bx == 0 && (F).tid == 0) ((volatile LAS unsigned long long*)((F).lds + SCHED_OFF + 512))[(k)] = __builtin_amdgcn_s_memrealtime(); } while (0)
__device__ __forceinline__ int sel4i(int k, int a0, int a1, int a2, int a3) { return k == 0 ? a0 : (k == 1 ? a1 : (k == 2 ? a2 : a3)); }
__device__ __forceinline__ float sel4f(int k, float a0, float a1, float a2, float a3) { return k == 0 ? a0 : (k == 1 ? a1 : (k == 2 ? a2 : a3)); }

__device__ __forceinline__ void ln1_router_phase(Frame& F, const bf16_t* zx, const float* lng, const float* lnb, const float* rw, const float* rb, int layer, bool dummy, const int rbase, const float* wg, const float* wu, const float* wd, unsigned* wait_word, const int cit0, const int cstep, const int cn) {
    constexpr int XP = 1032;
    LAS bf16_t* rwT = (LAS bf16_t*)(F.lds + RING_OFF);
    LAS bf16_t* xbuf = (LAS bf16_t*)(F.lds + RING_OFF + 33792 + F.wave * 8448);
    LAS int* lcnt = (LAS int*)(F.lds + RING_OFF + 102400);
    LAS int* lbase = lcnt + 16;
    LAS int* rec = lcnt + 64;
    LAS float* recw = (LAS float*)(rec + 256);
    LAS float* lgt = (LAS float*)(F.lds + RING_OFF + 102400 + 4096);
    { const GAS u32x4* src4 = (const GAS u32x4*)(F.ws + WS_TAB + 512 * 1024); LAS u32x4* dst4 = (LAS u32x4*)rwT; (void)rw;
      for (int idx = F.tid; idx < 2064; idx += 512) dst4[idx] = src4[idx]; }
    if (F.tid < 16) lcnt[F.tid] = 0;
    if (layer == 0) FSTAMP(F, 20);
    bf16_t* XB = (bf16_t*)(F.ws + WS_XB); (void)dummy;
    const int lane = F.lane;
    f32x4 gv[4], bv[4];
#pragma unroll
    for (int j = 0; j < 4; ++j) { gv[j] = *(const GAS f32x4*)(lng + 4 * lane + 256 * j); bv[j] = *(const GAS f32x4*)(lnb + 4 * lane + 256 * j); }
    const int row0 = rbase + F.wave * 8;
    f32x4 ca[8], cb[8]; TrDesc cd = moe_item_desc(F, wg, wu, wd, layer, cit0, rw);
    if (cn > 0) tr_load(cd, ca, cb, lane);
    if (wait_word) { if (F.tid == 0) { unsigned polls_ = 0;
            while (__hip_atomic_load(wait_word, RLX_AGENT) < 4u) { if (++polls_ > (1u << 22)) { __hip_atomic_store((unsigned*)(F.ctl + CW_TMO), 4u, RLX_AGENT); break; } __builtin_amdgcn_s_sleep(2); }
            ACQUIRE_HANDOFF(F.MISC[12] == 1u); } }
    __syncthreads();
    if (layer == 0) FSTAMP(F, 21);
    u32x2 zc[2][4], zn[2][4], zm[2][4];
#define LN1_LOAD(dst, ip) do { _Pragma("unroll") for (int r_ = 0; r_ < 2; ++r_) { const int ri_ = 2 * (ip) + r_ < 8 ? 2 * (ip) + r_ : 7; \
        _Pragma("unroll") for (int j = 0; j < 4; ++j) dst[r_][j] = __builtin_nontemporal_load((const GAS u32x2*)(zx + (size_t)(row0 + ri_) * DM + 4 * lane + 256 * j)); } } while (0)
    LN1_LOAD(zc, 0); LN1_LOAD(zn, 1); LN1_LOAD(zm, 2);
#pragma unroll 1
    for (int ip = 0; ip < 4; ++ip) {
        f32x4 v[2][4]; float s[2] = {0.f, 0.f}, qq[2] = {0.f, 0.f};
#pragma unroll
        for (int r = 0; r < 2; ++r)
#pragma unroll
            for (int j = 0; j < 4; ++j) { const u32x2 zw = zc[r][j]; v[r][j] = (f32x4){bflo(zw.x), bfhi(zw.x), bflo(zw.y), bfhi(zw.y)};
                s[r] += (v[r][j].x + v[r][j].y) + (v[r][j].z + v[r][j].w); qq[r] += (v[r][j].x * v[r][j].x + v[r][j].y * v[r][j].y) + (v[r][j].z * v[r][j].z + v[r][j].w * v[r][j].w); }
#pragma unroll
        for (int r = 0; r < 2; ++r)
#pragma unroll
            for (int j = 0; j < 4; ++j) { zc[r][j] = zn[r][j]; zn[r][j] = zm[r][j]; }
        if (ip + 3 < 4) LN1_LOAD(zm, ip + 3);
        float mean[2], rstd[2];
        { const float t0 = wave_sum_dpp(s[0]), t1 = wave_sum_dpp(s[1]), u0 = wave_sum_dpp(qq[0]), u1 = wave_sum_dpp(qq[1]);
          mean[0] = t0 * (1.f / DM); mean[1] = t1 * (1.f / DM);
          rstd[0] = __builtin_amdgcn_rsqf(fmaxf(u0 * (1.f / DM) - mean[0] * mean[0], 0.f) + NORM_EPS); rstd[1] = __builtin_amdgcn_rsqf(fmaxf(u1 * (1.f / DM) - mean[1] * mean[1], 0.f) + NORM_EPS); }
#pragma unroll
        for (int r = 0; r < 2; ++r)
#pragma unroll
            for (int j = 0; j < 4; ++j) { v[r][j] = (v[r][j] - mean[r]) * rstd[r] * gv[j] + bv[j];
                u32x2 o; o.x = pk2(v[r][j].x, v[r][j].y); o.y = pk2(v[r][j].z, v[r][j].w); *(GAS u32x2*)(XB + (size_t)(row0 + 2 * ip + r) * DM + 4 * lane + 256 * j) = o;
                *(LAS u32x2*)(xbuf + (2 * (ip & 1) + r) * XP + 4 * lane + 256 * j) = o; }
        if ((ip & 1) == 1) {
            LDS_WAIT(); asm volatile("" ::: "memory");
            f32x4 lacc = {0.f, 0.f, 0.f, 0.f};
            const LAS bf16_t* ap = xbuf + ((lane & 15) & 3) * XP + 8 * (lane >> 4); const LAS bf16_t* bp = rwT + (lane & 15) * XP + 8 * (lane >> 4);
#pragma unroll 8
            for (int s = 0; s < 32; ++s) { const bf16x8 af = *(const LAS bf16x8*)(ap + 32 * s), bfr = *(const LAS bf16x8*)(bp + 32 * s); lacc = __builtin_amdgcn_mfma_f32_16x16x32_bf16(af, bfr, lacc, 0, 0, 0); }
            if (lane < 16) {
#pragma unroll
                for (int rg = 0; rg < 4; ++rg) lgt[(F.wave * 8 + 4 * (ip >> 1) + rg) * 16 + lane] = lacc[rg]; }
            LDS_WAIT(); asm volatile("" ::: "memory");
            if ((ip >> 1) < cn) tr_finish(cd, ca, cb, (LAS unsigned*)xbuf, lane);
            if ((ip >> 1) + 1 < cn) { cd = moe_item_desc(F, wg, wu, wd, layer, cit0 + cstep * ((ip >> 1) + 1), rw); tr_load(cd, ca, cb, lane); }
        }
    }
#undef LN1_LOAD
    if (layer == 0) FSTAMP(F, 22);
    LDS_WAIT(); asm volatile("" ::: "memory");
    if (lane < 8) {
        const int lrow = F.wave * 8 + lane;
        float aff[16], sel[16];
#pragma unroll
        for (int q = 0; q < 4; ++q) { const f32x4 lg = *(const LAS f32x4*)(lgt + lrow * 16 + 4 * q);
#pragma unroll
            for (int c = 0; c < 4; ++c) { const int e = 4 * q + c; aff[e] = 1.f / (1.f + __expf(-lg[c])); sel[e] = aff[e] + rb[e]; } }
        float gs[4];
#pragma unroll
        for (int g = 0; g < 4; ++g) { const float a = sel[4 * g], b = sel[4 * g + 1], c = sel[4 * g + 2], d = sel[4 * g + 3];
            const float mx1 = fmaxf(fmaxf(a, b), fmaxf(c, d));
            const float mn_ab = fminf(a, b), mx_ab = fmaxf(a, b), mn_cd = fminf(c, d), mx_cd = fmaxf(c, d);
            const float second = fmaxf(fminf(mx_ab, mx_cd), fmaxf(mn_ab, mn_cd));
            gs[g] = mx1 + second; }
        int best = 0; float bsc = gs[0];
#pragma unroll
        for (int g = 1; g < 4; ++g) if (gs[g] > bsc) { bsc = gs[g]; best = g; }
        const float s0 = sel4f(best, sel[0], sel[4], sel[8], sel[12]), s1 = sel4f(best, sel[1], sel[5], sel[9], sel[13]), s2_ = sel4f(best, sel[2], sel[6], sel[10], sel[14]), s3 = sel4f(best, sel[3], sel[7], sel[11], sel[15]);
        const float a0 = sel4f(best, aff[0], aff[4], aff[8], aff[12]), a1 = sel4f(best, aff[1], aff[5], aff[9], aff[13]), a2 = sel4f(best, aff[2], aff[6], aff[10], aff[14]), a3 = sel4f(best, aff[3], aff[7], aff[11], aff[15]);
        int i0 = 0; float m0 = s0; if (s1 > m0) { m0 = s1; i0 = 1; } if (s2_ > m0) { m0 = s2_; i0 = 2; } if (s3 > m0) { m0 = s3; i0 = 3; }
        int i1 = -1; float m1 = -INFINITY;
        if (i0 != 0 && s0 > m1) { m1 = s0; i1 = 0; } if (i0 != 1 && s1 > m1) { m1 = s1; i1 = 1; } if (i0 != 2 && s2_ > m1) { m1 = s2_; i1 = 2; } if (i0 != 3 && s3 > m1) { m1 = s3; i1 = 3; }
        const float w0r = sel4f(i0, a0, a1, a2, a3), w1r = sel4f(i1, a0, a1, a2, a3); const float inv = 1.f / (w0r + w1r);
        const int e0 = 4 * best + i0, e1 = 4 * best + i1;
        const int r0 = __hip_atomic_fetch_add(lcnt + e0, 1, __ATOMIC_RELAXED, __HIP_MEMORY_SCOPE_WORKGROUP), r1 = __hip_atomic_fetch_add(lcnt + e1, 1, __ATOMIC_RELAXED, __HIP_MEMORY_SCOPE_WORKGROUP);
        rec[lrow * 4 + 0] = e0; rec[lrow * 4 + 1] = e1; rec[lrow * 4 + 2] = r0; rec[lrow * 4 + 3] = r1; recw[lrow * 2 + 0] = w0r * inv; recw[lrow * 2 + 1] = w1r * inv;
    }
    if (cn > 2) tr_finish(cd, ca, cb, (LAS unsigned*)xbuf, lane);
    __syncthreads();
    if (F.tid < 16) { const int n = lcnt[F.tid]; lbase[F.tid] = n ? (int)__hip_atomic_fetch_add((unsigned*)(F.ctl + CW_CNT + (layer * 16 + F.tid) * 64), (unsigned)n, RLX_AGENT) : 0; }
    __syncthreads();
    if (F.tid < 128) { const int lrow = F.tid >> 1, sl = F.tid & 1; const int e = rec[lrow * 4 + sl], rk = rec[lrow * 4 + 2 + sl]; const int pos = lbase[e] + rk; const int row = rbase + lrow;
        int* rowmap = (int*)(F.ws + WS_ROWMAP); float* roww = (float*)(F.ws + WS_ROWW);
        rowmap[(size_t)e * RCAP + pos] = row * 2 + sl; roww[(size_t)e * RCAP + pos] = recw[lrow * 2 + sl]; }
    __syncthreads();
    if (layer == 0) FSTAMP(F, 23);
}

template <bool F32OUT, bool BF16OUT>
__device__ __forceinline__ void ln2_phase(Frame& F, float* fout, const float* lng, const float* lnb, int layer) {
    const bf16_t* Y = (const bf16_t*)(F.ws + ws_y(layer)); bf16_t* XB = (bf16_t*)(F.ws + WS_XB);
    const int lane = F.lane;
    f32x4 gv[4], bv[4];
#pragma unroll
    for (int j = 0; j < 4; ++j) { gv[j] = *(const GAS f32x4*)(lng + 4 * lane + 256 * j); bv[j] = *(const GAS f32x4*)(lnb + 4 * lane + 256 * j); }
    const int row0 = F.vcu * 64 + F.wave * 8;
    u32x2 xa[3][4], ya[3][4], yb[3][4];
#define LN2_LOAD(k, i) do { const int r_ = row0 + (i); _Pragma("unroll") for (int j = 0; j < 4; ++j) { xa[k][j] = __builtin_nontemporal_load((const GAS u32x2*)(XB + (size_t)r_ * DM + 4 * lane + 256 * j)); \
        ya[k][j] = __builtin_nontemporal_load((const GAS u32x2*)(Y + (size_t)r_ * DM + 4 * lane + 256 * j)); yb[k][j] = __builtin_nontemporal_load((const GAS u32x2*)(Y + ((size_t)NTOK + r_) * DM + 4 * lane + 256 * j)); } } while (0)
    LN2_LOAD(0, 0); LN2_LOAD(1, 1); LN2_LOAD(2, 2);
#pragma unroll
    for (int i = 0; i < 8; ++i) {
        const int row = row0 + i; const int sl = i % 3;
        f32x4 v[4]; float s = 0.f;
#pragma unroll
        for (int j = 0; j < 4; ++j) { const u32x2 xw = xa[sl][j]; const f32x4 x = (f32x4){bflo(xw.x), bfhi(xw.x), bflo(xw.y), bfhi(xw.y)}; const u32x2 y0 = ya[sl][j], y1 = yb[sl][j];
            v[j].x = x.x * ALPHA + (bflo(y0.x) + bflo(y1.x)); v[j].y = x.y * ALPHA + (bfhi(y0.x) + bfhi(y1.x)); v[j].z = x.z * ALPHA + (bflo(y0.y) + bflo(y1.y)); v[j].w = x.w * ALPHA + (bfhi(y0.y) + bfhi(y1.y));
            s += (v[j].x + v[j].y) + (v[j].z + v[j].w); }
        if (i + 3 < 8) LN2_LOAD(sl, i + 3);
        const float mean = wave_sum(s) * (1.f / DM); float s2 = 0.f;
#pragma unroll
        for (int j = 0; j < 4; ++j) { v[j] = v[j] - mean; s2 += (v[j].x * v[j].x + v[j].y * v[j].y) + (v[j].z * v[j].z + v[j].w * v[j].w); }
        const float rstd = __builtin_amdgcn_rsqf(wave_sum(s2) * (1.f / DM) + NORM_EPS);
#pragma unroll
        for (int j = 0; j < 4; ++j) { v[j] = v[j] * rstd * gv[j] + bv[j];
            if constexpr (F32OUT) __builtin_nontemporal_store(v[j], (GAS f32x4*)(fout + (size_t)row * DM + 4 * lane + 256 * j));
            if constexpr (BF16OUT) { u32x2 o; o.x = pk2(v[j].x, v[j].y); o.y = pk2(v[j].z, v[j].w); *(GAS u32x2*)(XB + (size_t)row * DM + 4 * lane + 256 * j) = o; } }
    }
#undef LN2_LOAD
}

__device__ __forceinline__ void rope0_phase(Frame& F, const float* qn, const float* kn, const size_t dst_off) {
    bf16_t* P0 = (bf16_t*)(F.ws + ws_big(0)); const float* tab = (const float*)(F.ws + WS_TAB);
    const int lane = F.lane, head = lane >> 2, qd = lane & 3;
    const float* gn = (head < 12 ? qn : kn) + (qd * 16);
    float gnv[16];
#pragma unroll
    for (int d = 0; d < 16; ++d) gnv[d] = gn[d];
    const float osc = head < 12 ? C2 : 1.f;
    u32x4 pw0[8], pw1[8];
#pragma unroll
    for (int i = 0; i < 8; ++i) { const bf16_t* p = P0 + (size_t)(F.vcu * 64 + F.wave * 8 + i) * A_IN + head * 64 + qd * 16; pw0[i] = *(const GAS u32x4*)p; pw1[i] = *(const GAS u32x4*)(p + 8); }
#pragma unroll
    for (int i = 0; i < 8; ++i) {
        const int row = F.vcu * 64 + F.wave * 8 + i; const int t = row & (SEQ - 1);
        bf16_t* p = P0 + dst_off + (size_t)row * A_IN + head * 64 + qd * 16;
        const u32x4 w0 = pw0[i], w1 = pw1[i];
        float x[16];
        x[0] = bflo(w0.x); x[1] = bfhi(w0.x); x[2] = bflo(w0.y); x[3] = bfhi(w0.y); x[4] = bflo(w0.z); x[5] = bfhi(w0.z); x[6] = bflo(w0.w); x[7] = bfhi(w0.w);
        x[8] = bflo(w1.x); x[9] = bfhi(w1.x); x[10] = bflo(w1.y); x[11] = bfhi(w1.y); x[12] = bflo(w1.z); x[13] = bfhi(w1.z); x[14] = bflo(w1.w); x[15] = bfhi(w1.w);
        float ss = 0.f;
#pragma unroll
        for (int d = 0; d < 16; ++d) ss += x[d] * x[d];
        ss += __shfl_xor(ss, 1); ss += __shfl_xor(ss, 2);
        const float rs = __builtin_amdgcn_rsqf(ss * (1.f / 64.f) + NORM_EPS);
        const float* ct = (qd < 2) ? tab + TB_ROWC + (t >> 6) * 16 : tab + TB_COLC + (t & 63) * 16;
        const float* st = (qd < 2) ? tab + TB_ROWS + (t >> 6) * 16 : tab + TB_COLS + (t & 63) * 16;
        float y[16];
#pragma unroll
        for (int d = 0; d < 16; ++d) { const float xn = x[d] * rs * gnv[d]; const float xp = __shfl_xor(xn, 1);
            const float c = ct[d], sn = st[d];
            y[d] = ((qd & 1) ? (xn * c + xp * sn) : (xn * c - xp * sn)) * osc; }
        u32x4 o0, o1;
        o0.x = pk2(y[0], y[1]); o0.y = pk2(y[2], y[3]); o0.z = pk2(y[4], y[5]); o0.w = pk2(y[6], y[7]); o1.x = pk2(y[8], y[9]); o1.y = pk2(y[10], y[11]); o1.z = pk2(y[12], y[13]); o1.w = pk2(y[14], y[15]);
        *(GAS u32x4*)p = o0; *(GAS u32x4*)(p + 8) = o1;
    }
}
__device__ __forceinline__ void rope1_phase(Frame& F) {
    bf16_t* P1 = (bf16_t*)(F.ws + ws_big(1)); const float* tab = (const float*)(F.ws + WS_TAB);
    const int lane = F.lane;
    u32x4 pw0[8], pw1[8];
#pragma unroll
    for (int i = 0; i < 8; ++i) { if (lane < 48) { const bf16_t* p = P1 + (size_t)(F.vcu * 64 + F.wave * 8 + i) * B_IN + lane * 64; pw0[i] = *(const GAS u32x4*)p; pw1[i] = *(const GAS u32x4*)(p + 8); } }
#pragma unroll
    for (int i = 0; i < 8; ++i) {
        const int row = F.vcu * 64 + F.wave * 8 + i; const int t = row & (SEQ - 1);
        if (lane < 48) {
            bf16_t* p = P1 + (size_t)row * B_IN + lane * 64;
            const u32x4 w0 = pw0[i], w1 = pw1[i];
            float x1[8], x2[8];
            x1[0] = bflo(w0.x); x1[1] = bfhi(w0.x); x1[2] = bflo(w0.y); x1[3] = bfhi(w0.y); x1[4] = bflo(w0.z); x1[5] = bfhi(w0.z); x1[6] = bflo(w0.w); x1[7] = bfhi(w0.w);
            x2[0] = bflo(w1.x); x2[1] = bfhi(w1.x); x2[2] = bflo(w1.y); x2[3] = bfhi(w1.y); x2[4] = bflo(w1.z); x2[5] = bfhi(w1.z); x2[6] = bflo(w1.w); x2[7] = bfhi(w1.w);
            const float* ct = tab + TB_PC + t * 8; const float* st = tab + TB_PS + t * 8;
            float y1[8], y2[8];
#pragma unroll
            for (int d = 0; d < 8; ++d) { const float c = ct[d], sn = st[d]; y1[d] = x1[d] * c - x2[d] * sn; y2[d] = x2[d] * c + x1[d] * sn; }
            u32x4 o0, o1;
            o0.x = pk2(y1[0], y1[1]); o0.y = pk2(y1[2], y1[3]); o0.z = pk2(y1[4], y1[5]); o0.w = pk2(y1[6], y1[7]); o1.x = pk2(y2[0], y2[1]); o1.y = pk2(y2[2], y2[3]); o1.z = pk2(y2[4], y2[5]); o1.w = pk2(y2[6], y2[7]);
            *(GAS u32x4*)p = o0; *(GAS u32x4*)(p + 8) = o1;
        }
    }
}
__device__ __forceinline__ void merge_phase(Frame& F) {
    const bf16_t* P1 = (const bf16_t*)(F.ws + ws_big(1)); const float* lse = (const float*)(F.ws + WS_LSE); bf16_t* ATT = (bf16_t*)(F.ws + WS_ATT);
    const int lane = F.lane, h = lane >> 3, dd = (lane & 7) * 8;
    u32x4 ma[8], mb_[8], mc[8]; float ml0[8], ml1[8], ml2[8];
#pragma unroll
    for (int i = 0; i < 8; ++i) { const int row = F.vcu * 64 + F.wave * 8 + i; const bf16_t* p = P1 + (size_t)row * B_IN + h * 64 + dd;
        ma[i] = *(const GAS u32x4*)p; mb_[i] = *(const GAS u32x4*)(p + 512); mc[i] = *(const GAS u32x4*)(p + 1024);
        ml0[i] = lse[((size_t)0 * NTOK + row) * 8 + h]; ml1[i] = lse[((size_t)1 * NTOK + row) * 8 + h]; ml2[i] = lse[((size_t)2 * NTOK + row) * 8 + h]; }
#pragma unroll
    for (int i = 0; i < 8; ++i) {
        const int row = F.vcu * 64 + F.wave * 8 + i;
        float l0 = ml0[i], l1 = ml1[i], l2 = ml2[i];
        const float mx = fmaxf(l0, fmaxf(l1, l2)); float w0 = __builtin_amdgcn_exp2f(l0 - mx), w1 = __builtin_amdgcn_exp2f(l1 - mx), w2 = __builtin_amdgcn_exp2f(l2 - mx);
        const float inv = 1.f / (w0 + w1 + w2); w0 *= inv; w1 *= inv; w2 *= inv;
        const u32x4 a = ma[i], b = mb_[i], c = mc[i];
        u32x4 o;
        o.x = pk2(w0 * bflo(a.x) + w1 * bflo(b.x) + w2 * bflo(c.x), w0 * bfhi(a.x) + w1 * bfhi(b.x) + w2 * bfhi(c.x));
        o.y = pk2(w0 * bflo(a.y) + w1 * bflo(b.y) + w2 * bflo(c.y), w0 * bfhi(a.y) + w1 * bfhi(b.y) + w2 * bfhi(c.y));
        o.z = pk2(w0 * bflo(a.z) + w1 * bflo(b.z) + w2 * bflo(c.z), w0 * bfhi(a.z) + w1 * bfhi(b.z) + w2 * bfhi(c.z));
        o.w = pk2(w0 * bflo(a.w) + w1 * bflo(b.w) + w2 * bflo(c.w), w0 * bfhi(a.w) + w1 * bfhi(b.w) + w2 * bfhi(c.w));
        *(GAS u32x4*)(ATT + (size_t)row * 768 + h * 64 + dd) = o;
    }
}

__device__ __forceinline__ void merge_quarter(Frame& F, const int k, const int quarter) {
    const bf16_t* P1 = (const bf16_t*)(F.ws + ws_big(1)); const float* lse = (const float*)(F.ws + WS_LSE); bf16_t* ATT = (bf16_t*)(F.ws + WS_ATT);
    const int lane = F.lane, b = k >> 3, h = k & 7, dd = (lane & 7) * 8;
#pragma unroll 2
    for (int i = 0; i < 8; ++i) {
        const int row = b * SEQ + quarter * 512 + F.wave * 64 + i * 8 + (lane >> 3);
        const float l0 = lse[((size_t)0 * NTOK + row) * 8 + h], l1 = lse[((size_t)1 * NTOK + row) * 8 + h], l2 = lse[((size_t)2 * NTOK + row) * 8 + h];
        const bf16_t* p = P1 + (size_t)row * B_IN + h * 64 + dd;
        const u32x4 a = __builtin_nontemporal_load((const GAS u32x4*)p), bq = __builtin_nontemporal_load((const GAS u32x4*)(p + 512)), c = __builtin_nontemporal_load((const GAS u32x4*)(p + 1024));
        const float mx = fmaxf(l0, fmaxf(l1, l2)); float w0 = __builtin_amdgcn_exp2f(l0 - mx), w1 = __builtin_amdgcn_exp2f(l1 - mx), w2 = __builtin_amdgcn_exp2f(l2 - mx);
        const float inv = 1.f / (w0 + w1 + w2); w0 *= inv; w1 *= inv; w2 *= inv;
        u32x4 o;
        o.x = pk2(w0 * bflo(a.x) + w1 * bflo(bq.x) + w2 * bflo(c.x), w0 * bfhi(a.x) + w1 * bfhi(bq.x) + w2 * bfhi(c.x));
        o.y = pk2(w0 * bflo(a.y) + w1 * bflo(bq.y) + w2 * bflo(c.y), w0 * bfhi(a.y) + w1 * bfhi(bq.y) + w2 * bfhi(c.y));
        o.z = pk2(w0 * bflo(a.z) + w1 * bflo(bq.z) + w2 * bflo(c.z), w0 * bfhi(a.z) + w1 * bfhi(bq.z) + w2 * bfhi(c.z));
        o.w = pk2(w0 * bflo(a.w) + w1 * bflo(bq.w) + w2 * bflo(c.w), w0 * bfhi(a.w) + w1 * bfhi(bq.w) + w2 * bfhi(c.w));
        *(GAS u32x4*)(ATT + (size_t)row * 768 + h * 64 + dd) = o;
    }
}

constexpr int N_PHASES = 19;
__global__ void __launch_bounds__(NWAVES * 64, 2) mega_fwd(Args args) {
    extern __shared__ __attribute__((aligned(16))) unsigned char lds[];
    Frame F;
    F.lds = (LAS unsigned char*)lds; F.MISC = (volatile LAS unsigned*)(F.lds + MISC_OFF);
    F.tid = threadIdx.x; F.lane = F.tid & 63; F.wave = __builtin_amdgcn_readfirstlane(F.tid >> 6);
    F.G = gridDim.x; { const int bx = blockIdx.x; F.vcu = (F.G % 8 == 0) ? (bx % 8) * (F.G / 8) + bx / 8 : bx; }
    F.ws = args.ws; F.ctl = (gu32*)(args.ws + WS_CTL);
    for (int u = F.tid; u < (LDS_BYTES - LDSCTL_OFF) / 4; u += NWAVES * 64) ((LAS unsigned*)(F.lds + LDSCTL_OFF))[u] = 0u;
    __syncthreads();
    { const int lo0 = args.ph_lo, hi0 = args.ph_hi; if (hi0 - lo0 > 1) (void)xcd_barrier_post((unsigned*)(F.ctl + CW_BAR), F.MISC + 8); }
#define KA_INT(off) (*(const int CAS*)((const CAS unsigned char*)__builtin_amdgcn_kernarg_segment_ptr() + (off)))
#define IN(k) (KA_INT(160) <= (k) && (k) < KA_INT(164))
#define xcd_barrier_now(ldsp) do { XcdBarrier bar_; bar_.bar = (unsigned*)(*(unsigned char* const CAS*)((const CAS unsigned char*)__builtin_amdgcn_kernarg_segment_ptr() + 152) + WS_CTL) + CW_BAR; \
        bar_.x = xb_xcc_id(); bar_.st = (volatile LAS unsigned*)((LAS unsigned char*)(ldsp) + MISC_OFF) + 8; xcd_barrier(bar_); } while (0)
#define REPS(k) for (int rep_ = 0; rep_ < ((REP_K) == (k) ? 2 : 1); ++rep_)
#define GROUP_ARRIVE(P, word, amount) do { asm volatile("s_waitcnt vmcnt(0)" ::: "memory"); __syncthreads(); \
        if ((P).tid == 0) { if ((P).MISC[12] != 1u) { __builtin_amdgcn_fence(__ATOMIC_RELEASE, "agent"); asm volatile("s_waitcnt vmcnt(0)" ::: "memory"); } \
            __hip_atomic_fetch_add((unsigned*)(word), (unsigned)(amount), RLX_AGENT); } } while (0)
#define GROUP_WAIT(P, word, need) do { if ((P).tid == 0) { unsigned polls_ = 0; \
            while (__hip_atomic_load((unsigned*)(word), RLX_AGENT) < (unsigned)(need)) { if (++polls_ > (1u << 22)) { __hip_atomic_store((unsigned*)((P).ctl + CW_TMO), 4u, RLX_AGENT); break; } __builtin_amdgcn_s_sleep(2); } \
            ACQUIRE_HANDOFF((P).MISC[12] == 1u); } \
        __syncthreads(); } while (0)
#define STAMP(k) do { if (PROBE_K >= 0 && blockIdx.x == 0 && threadIdx.x == 0) ((volatile LAS unsigned long long*)((LAS unsigned char*)lds + SCHED_OFF + 512))[(k)] = __builtin_amdgcn_s_memrealtime(); } while (0)
#define SEAM(k) do { if (IN(k) && IN((k) + 1)) { XcdBarrier bar_; bar_.bar = (unsigned*)(*(unsigned char* const CAS*)((const CAS unsigned char*)__builtin_amdgcn_kernarg_segment_ptr() + 152) + WS_CTL) + CW_BAR; \
        bar_.x = xb_xcc_id(); bar_.st = (volatile LAS unsigned*)((LAS unsigned char*)lds + MISC_OFF) + 8; xcd_barrier(bar_); } STAMP((k) + 1); } while (0)
#define AIN(i) (*(const float* const CAS*)(ka_ + 8 * (i)))
#define PHASE_FRAME() \
    const CAS unsigned char* ka_ = (const CAS unsigned char*)__builtin_amdgcn_kernarg_segment_ptr(); asm volatile("" : "+s"(ka_)); \
    Frame P; unsigned P_l0 = 0u; { unsigned char* w_ = *(unsigned char* const CAS*)(ka_ + 152); asm volatile("" : "+s"(P_l0)); int t_ = threadIdx.x; asm volatile("" : "+v"(t_)); \
      P.ws = w_; P.ctl = (gu32*)(w_ + WS_CTL); P.lds = (LAS unsigned char*)lds + P_l0; P.MISC = (volatile LAS unsigned*)(P.lds + MISC_OFF); \
      P.tid = t_; P.lane = t_ & 63; P.wave = __builtin_amdgcn_readfirstlane(t_ >> 6); P.G = gridDim.x; { int bx = blockIdx.x; asm volatile("" : "+s"(bx)); P.bx = bx; P.vcu = (P.G % 8 == 0) ? (bx % 8) * (P.G / 8) + bx / 8 : bx; } } \
    const float* x_in = AIN(0); float* out = *(float* const CAS*)(ka_ + 144); \
    bf16_t* XB = (bf16_t*)(P.ws + WS_XB); bf16_t* ATT = (bf16_t*)(P.ws + WS_ATT); bf16_t* BIG = (bf16_t*)(P.ws + ws_big(PL_)); \
    bf16_t* MKV = (bf16_t*)(P.ws + WS_MKV); bf16_t* MEMB = (bf16_t*)(P.ws + WS_MEMB); \
    int* rowmap = (int*)(P.ws + WS_ROWMAP); float* roww = (float*)(P.ws + WS_ROWW); \
    LAS int* tpre = (LAS int*)(P.lds + SCHED_OFF); \
    (void)x_in; (void)out; (void)XB; (void)ATT; (void)BIG; (void)MKV; (void)MEMB; (void)rowmap; (void)roww; (void)tpre

    STAMP(0);
    { const int PL_ = 0; REPS(0) if (IN(0)) { PHASE_FRAME();
        LAS unsigned* scr = (LAS unsigned*)(P.lds + RING_OFF + P.wave * 16384);
        const int gw = P.vcu * NWAVES + P.wave, NGW = P.G * NWAVES;
        constexpr int I_MKV = 16 * 8, I_AIN = 16 * 24, I_AOUT = 16 * 16, I_BIN = MK_ONE_LAUNCH ? 0 : 16 * 76, I_BOUT = 12 * 16, NIT = I_MKV + I_AIN + I_AOUT + I_BIN + I_BOUT;
        for (int it = P.vcu + P.G * P.wave; it < NIT; it += NGW) {
            int r = it;
            if (r < I_MKV) { transpose_plain(AIN(2), DM, 512, (bf16_t*)(P.ws + WS_WMKV), r, scr, P.lane); continue; } r -= I_MKV;
            if (r < I_AIN) { transpose_heads(AIN(5), DM, A_IN, (bf16_t*)(P.ws + WS_WAIN), r, scr, P.lane); continue; } r -= I_AIN;
            if (r < I_AOUT) { transpose_plain(AIN(6), DM, DM, (bf16_t*)(P.ws + WS_WAOUT), r, scr, P.lane); continue; } r -= I_AOUT;
            if (r < I_BIN) { transpose_heads(AIN(9), DM, B_IN, (bf16_t*)(P.ws + WS_WBIN), r, scr, P.lane); continue; } r -= I_BIN;
            transpose_plain(AIN(10), 768, DM, (bf16_t*)(P.ws + WS_WBOUT), r, scr, P.lane);
        }
        { bf16_t* rwi = (bf16_t*)(P.ws + WS_TAB + 512 * 1024); const float* rwf = AIN(3);
          for (int idx = gw * 64 + P.lane; idx < 16 * 1032; idx += NGW * 64) { const int e = idx / 1032, k = idx % 1032; rwi[idx] = (bf16_t)(k < DM ? f2bf(rwf[k * 16 + e]) : 0u); } }
        cvt_rows_bf16(P, x_in, XB, (size_t)NTOK * DM);
        cvt_rows_bf16(P, AIN(1), MEMB, (size_t)NB * NMEM * DM);
        { float* tab = (float*)(P.ws + WS_TAB); const int gt = gw * 64 + P.lane, NT_ = NGW * 64;
          for (int idx = gt; idx < 32 * 16 + 64 * 16 + 2048 * 8; idx += NT_) {
              int p, i, oc, os; float l2t, den;
              if (idx < 512) { p = idx >> 4; i = idx & 15; oc = TB_ROWC + idx; os = TB_ROWS + idx; l2t = 13.287712379549449f; den = 32.f; }
              else if (idx < 512 + 1024) { const int k = idx - 512; p = k >> 4; i = k & 15; oc = TB_COLC + k; os = TB_COLS + k; l2t = 13.287712379549449f; den = 32.f; }
              else { const int k = idx - 1536; p = k >> 3; i = k & 7; oc = TB_PC + k; os = TB_PS + k; l2t = 18.931568569324174f; den = 16.f; }
              const float inv = 1.0f / __builtin_amdgcn_exp2f(l2t * ((float)(2 * i) / den));
              const float ang = (float)p * inv;
              const double rev = (double)ang * 0.15915494309189535;
              const float fr = (float)(rev - __builtin_rint(rev));
              tab[oc] = __builtin_amdgcn_cosf(fr); tab[os] = __builtin_amdgcn_sinf(fr);
          } }
      if (P.tid == 0) __hip_atomic_store((unsigned*)(P.ctl + CW_XCC + P.vcu), xb_xcc_id() + 1u, RLX_AGENT);
    } }
    SEAM(0);
    if (MK_ONE_LAUNCH) { const int PL_ = 0; PHASE_FRAME();
        if (P.tid < 32) { const unsigned mine = __hip_atomic_load((unsigned*)(P.ctl + CW_XCC + P.vcu), RLX_AGENT), other = __hip_atomic_load((unsigned*)(P.ctl + CW_XCC + (P.vcu & ~31) + P.tid), RLX_AGENT);
            const bool same = __all(other == mine && mine != 0u); if (P.tid == 0) P.MISC[12] = same ? 1u : 2u; }
        __syncthreads(); }

    for (int L = 0; L < 2; ++L) {
        const int pb = 1 + 9 * L; const int PL_ = L;
        REPS(pb) if (IN(pb)) { PHASE_FRAME();
            pg8::DenseSched S;
            if (L == 0) S.init(XB, P.ws + WS_WAIN, NTOK, A_IN, DM, MEMB, P.ws + WS_WMKV, NB * NMEM, 512, P.G, P.bx);
            else      { S.init(XB, P.ws + WS_WBIN, NTOK, B_IN, DM, nullptr, nullptr, 0, 0, P.G, P.bx); if (MK_ONE_LAUNCH) { S.pfirst = 18; S.qdone = (unsigned*)(P.ctl + CW_QM); S.same_xcc = (P.MISC[12] == 1u); } }
            pg8::EpiProj E{BIG, L == 0 ? A_IN : B_IN, L, AIN(7), AIN(8), (const float*)(P.ws + WS_TAB), MKV, 512, (const LAS float*)(P.lds + RING_OFF + pg8::TAB_LDS)};
            if (L == 0) { const GAS f32x4* tsrc = (const GAS f32x4*)(P.ws + WS_TAB); LAS f32x4* tdst = (LAS f32x4*)(P.lds + RING_OFF + pg8::TAB_LDS);
                for (int i = P.tid; i < 768; i += NWAVES * 64) tdst[i] = tsrc[i];
                __syncthreads(); }
            pg8::gemm_phase<pg8::EpiProj, pg8::DenseSched, false, DM>(P.lds + RING_OFF, S, E, P.tid);
            if (L == 1) FSTAMP(P, 24);
            if (MK_ONE_LAUNCH && L == 0 && P.bx >= 144) { LAS unsigned* scr = (LAS unsigned*)(P.lds + RING_OFF + P.wave * 16384);
                moe_convert_n(P, AIN(15), AIN(16), AIN(17), 0, scr, (P.bx - 144) * NWAVES + P.wave, 896, 6); }
            if (MK_ONE_LAUNCH) GROUP_ARRIVE(P, P.ctl + CW_GRP + ((L == 0 ? 0 : 2) * 8 + (P.vcu >> 5)) * 64, 1);
            if (MK_ONE_LAUNCH && L == 1 && P.bx >= 192) { const int b = P.vcu >> 5; char* shm = (char*)lds + P_l0 + RING_OFF;
                unsigned* mq = (unsigned*)(P.ctl + CW_QM + 8192 + 64 * b); volatile LAS unsigned* ql = P.MISC + 16;
                __syncthreads();
                if (P.tid == 0) ql[0] = __hip_atomic_fetch_add(mq, 1u, RLX_AGENT);
                __syncthreads();
                int cur = (int)ql[0];
#pragma unroll 1
                while (cur < 32) { const int mh = cur >> 3, qb = cur & 7;
                    unsigned claim_ = 0u; if (P.tid == 0) claim_ = __hip_atomic_fetch_add(mq, 1u, RLX_AGENT);
                    GROUP_WAIT(P, P.ctl + CW_QM + 64 * (b * 8 + qb), 8);
                    const bf16_t* qb_ = BIG + (size_t)b * SEQ * B_IN + 4608 + mh * 64; const bf16_t* mk = MKV + (size_t)b * NMEM * 512 + mh * 64;
                    attn_body::attn_unit<8, B_IN, 512, 512, 768, NMEM / 64>(qb_, mk, mk + 256, ATT + (size_t)b * SEQ * 768 + 512 + mh * 64, qb * 256, shm, P.tid);
                    if (P.tid == 0) ql[0] = claim_;
                    GROUP_ARRIVE(P, P.ctl + CW_ATT + (L * 64 + b * 8 + qb) * 64, 1);
                    __syncthreads();
                    cur = (int)ql[0]; } }
        }
        if (!MK_ONE_LAUNCH) SEAM(pb); else STAMP(pb + 1);
        STAMP(pb + 2);
        REPS(pb + 2) if (IN(pb + 2)) { PHASE_FRAME();
            if (MK_ONE_LAUNCH) GROUP_WAIT(P, P.ctl + CW_GRP + ((L == 0 ? 0 : 2) * 8 + (P.vcu >> 5)) * 64, 32);
            char* shm = (char*)lds + P_l0 + RING_OFF;
            if (L == 0) {
                const int v = P.vcu; const int pair = v >> 3, qb = v & 7, b = pair >> 2, kvh = pair & 3;
                const bf16_t* base = BIG + (size_t)b * SEQ * A_IN;
                LAS unsigned* scr = (LAS unsigned*)(P.lds + RING_OFF + P.wave * 16384);
                const int gw = P.vcu * NWAVES + P.wave, NGW = P.G * NWAVES;
#pragma unroll 1
                for (int i = 0; i < 3; ++i) { const int hq = kvh * 3 + i;
                    attn_body::attn_unit<8, A_IN, A_IN, A_IN, DM, SEQ / 64>(base + hq * 64, base + 768 + kvh * 64, base + 1024 + kvh * 64, ATT + (size_t)b * SEQ * DM + hq * 64, qb * 256, shm, P.tid);

                    __syncthreads(); }
                { const int mb = v >> 5, mh = (v >> 3) & 3; const bf16_t* qb_ = BIG + (size_t)mb * SEQ * A_IN + 1280 + mh * 64; const bf16_t* mk = MKV + (size_t)mb * NMEM * 512 + mh * 64;
                  attn_body::attn_unit<8, A_IN, 512, 512, DM, NMEM / 64>(qb_, mk, mk + 256, ATT + (size_t)mb * SEQ * DM + 768 + mh * 64, qb * 256, shm, P.tid); }
            } else {
                float* lse = (float*)(P.ws + WS_LSE);
                FSTAMP(P, 26);
                attn_body::band_phase_dyn(BIG, lse, (P.vcu >> 5) * 192, 192, (unsigned*)(P.ctl + 2048 + 64 * (P.vcu >> 5)), (unsigned*)(P.ctl + CW_MRG), P.MISC + 16, shm, P.tid);
                FSTAMP(P, 27);
                { const int kk = P.vcu >> 2; unsigned* mc = (unsigned*)(P.ctl + CW_MRG + 64 * kk);
                  asm volatile("s_waitcnt vmcnt(0)" ::: "memory"); __syncthreads();
                  if (P.tid == 0) { unsigned polls = 0;
                      while (__hip_atomic_load(mc, RLX_AGENT) < 24u) { if (++polls > (1u << 22)) { __hip_atomic_store((unsigned*)(P.ctl + CW_TMO), 2u, RLX_AGENT); break; } __builtin_amdgcn_s_sleep(2); }
                      ACQUIRE_HANDOFF(P.MISC[12] == 1u); }
                  __syncthreads();
                  merge_quarter(P, kk, P.vcu & 3); }
                __syncthreads();
            }
        }
        if (MK_ONE_LAUNCH && IN(pb + 2)) { PHASE_FRAME(); const int v = P.vcu;
            if (L == 0) { GROUP_ARRIVE(P, P.ctl + CW_ATT + (L * 64 + (v >> 5) * 8 + (v & 7)) * 64, 1); }
            else { asm volatile("s_waitcnt vmcnt(0)" ::: "memory"); __syncthreads();
                if (P.tid == 0) { if (P.MISC[12] != 1u) { __builtin_amdgcn_fence(__ATOMIC_RELEASE, "agent"); asm volatile("s_waitcnt vmcnt(0)" ::: "memory"); }
                    const int b = v >> 5, q = v & 3;
                    __hip_atomic_fetch_add((unsigned*)(P.ctl + CW_ATT + (L * 64 + b * 8 + 2 * q) * 64), 1u, RLX_AGENT); __hip_atomic_fetch_add((unsigned*)(P.ctl + CW_ATT + (L * 64 + b * 8 + 2 * q + 1) * 64), 1u, RLX_AGENT);
                } } }
        if (!MK_ONE_LAUNCH) SEAM(pb + 2); else STAMP(pb + 3);
        STAMP(pb + 4);
        REPS(pb + 4) if (IN(pb + 4)) { PHASE_FRAME();
            pg8::DenseSched S;
            if (L == 0) S.init(ATT, P.ws + WS_WAOUT, NTOK, DM, DM, nullptr, nullptr, 0, 0, P.G, P.bx);
            else        S.init(ATT, P.ws + WS_WBOUT, NTOK, DM, 768, nullptr, nullptr, 0, 0, P.G, P.bx);
            pg8::EpiZ E{XB, (bf16_t*)out};
            if (MK_ONE_LAUNCH) {
                pg8::PanelSched PS{(const char*)ATT, (const char*)(P.ws + (L == 0 ? WS_WAOUT : WS_WBOUT)), L == 0 ? DM : 768, P.vcu, (unsigned*)(P.ctl + CW_ATT + L * 64 * 64), L == 0 ? 4u : 12u, (unsigned*)(P.ctl + CW_TMO), P.MISC[12] == 1u};
                if (L == 0) pg8::gemm_phase<pg8::EpiZ, pg8::PanelSched, false, DM>(P.lds + RING_OFF, PS, E, P.tid); else pg8::gemm_phase<pg8::EpiZ, pg8::PanelSched, false, 768>(P.lds + RING_OFF, PS, E, P.tid);
                const int v = P.vcu; GROUP_ARRIVE(P, P.ctl + CW_Z + (L * 64 + (v >> 5) * 8 + (v & 7)) * 64, 1);
            } else {
            if (L == 0) pg8::gemm_phase<pg8::EpiZ, pg8::DenseSched, false, DM>(P.lds + RING_OFF, S, E, P.tid); else pg8::gemm_phase<pg8::EpiZ, pg8::DenseSched, false, 768>(P.lds + RING_OFF, S, E, P.tid);
            }
            if (L == 0) FSTAMP(P, 25);
        }
        if (!MK_ONE_LAUNCH) SEAM(pb + 4); else STAMP(pb + 5);
        REPS(pb + 5) if (IN(pb + 5)) { PHASE_FRAME(); const int v = P.vcu; const int pm = (v >> 5) * 8 + (v & 7);
            ln1_router_phase(P, (const bf16_t*)out, AIN(11) + L * DM, AIN(12) + L * DM, AIN(9), AIN(4), L, false, MK_ONE_LAUNCH ? pm * 256 + ((v >> 3) & 3) * 64 : v * 64, AIN(15), AIN(16), AIN(17),
                             MK_ONE_LAUNCH ? (unsigned*)(P.ctl + CW_Z + (L * 64 + pm) * 64) : (unsigned*)nullptr,
                             (MK_ONE_LAUNCH && L == 0) ? ((P.vcu * NWAVES + P.wave) < 768 ? 5376 + P.vcu * NWAVES + P.wave : 6144 + (P.vcu * NWAVES + P.wave - 768)) : P.vcu * NWAVES + P.wave,
                             (MK_ONE_LAUNCH && L == 0) ? 0 : P.G * NWAVES, (MK_ONE_LAUNCH && L == 0) ? ((P.vcu * NWAVES + P.wave) < 768 + 1216 ? 1 : 0) : 3); }
        SEAM(pb + 5);
        if (IN(pb + 6) || IN(pb + 7)) { PHASE_FRAME();
            if (P.tid < 16) { const int c = (int)__hip_atomic_load(P.ctl + CW_CNT + (L * 16 + P.tid) * 64, RLX_AGENT); tpre[32 + P.tid] = c; }
            __syncthreads();
            if (P.tid == 0) { int acc = 0;
                for (int e = 0; e < 16; ++e) { tpre[e] = acc; acc += (tpre[32 + e] + 255) >> 8; }
                tpre[16] = acc; }
            __syncthreads();
        }
        REPS(pb + 6) if (IN(pb + 6)) { PHASE_FRAME();
            pg8::MoeSched S{(const char*)XB, (const char*)(P.ws + ws_wgu(L)), DM, (size_t)1024 * DM * 2, tpre, rowmap, P.G, P.bx, true, 0u, (unsigned*)(P.ctl + CW_HCNT + L * 192 * 64), (unsigned*)(P.ctl + CW_TMO)};
            pg8::EpiGU E{(bf16_t*)(P.ws + ws_h(L))};
            pg8::gemm_phase<pg8::EpiGU, pg8::MoeSched, true, DM>(P.lds + RING_OFF, S, E, P.tid);
        }
        if (MK_ONE_LAUNCH == 0) SEAM(pb + 6); else STAMP(pb + 7);
        REPS(pb + 7) if (IN(pb + 7)) { PHASE_FRAME();
            if (P.tid == 0) asm volatile("buffer_inv sc0" ::: "memory");
            asm volatile("s_waitcnt vmcnt(0)" ::: "memory"); __syncthreads();
            pg8::MoeSched S{(const char*)(P.ws + ws_h(L)), (const char*)(P.ws + ws_wd(L)), DEXP, (size_t)DM * DEXP * 2, tpre, rowmap, P.G, P.bx, false, 0u, (unsigned*)(P.ctl + CW_HCNT + L * 192 * 64), (unsigned*)(P.ctl + CW_TMO)};
            { unsigned rdy = 0u; if (P.tid < 64) { const int Lq = (P.lane < 8) ? S.unit_index(P.lane) : -1; const bool have = Lq >= 0; unsigned cnt_ = 0u; if (have) cnt_ = __hip_atomic_load(S.hcnt + 64 * (Lq >> 2), RLX_AGENT);
                  rdy = (unsigned)__ballot(have && cnt_ >= 32u); }
              S.ready = (unsigned)__builtin_amdgcn_readfirstlane((int)rdy); if (P.tid >= 64) S.ready = 0u; }
            pg8::EpiDown E{(bf16_t*)(P.ws + ws_y(L)), rowmap, roww, (const LAS int*)(P.lds + RING_OFF + pg8::META_LDS)};
            pg8::gemm_phase<pg8::EpiDown, pg8::MoeSched, false, DEXP>(P.lds + RING_OFF, S, E, P.tid);
        }
        SEAM(pb + 7);
        if (IN(pb + 8)) { PHASE_FRAME();
            if (L == 0) ln2_phase<false, true>(P, (float*)nullptr, AIN(13), AIN(14), 0); else ln2_phase<true, false>(P, out, AIN(13) + DM, AIN(14) + DM, 1);
        }
        if (L == 0) SEAM(pb + 8);
    }
    if (REP_K == 100) { for (int q_ = 0; q_ < 20; ++q_) xcd_barrier_now(lds); }
    if (PROBE_K >= 0) { const int PL_ = 1; PHASE_FRAME();
        xcd_barrier_now(lds); STAMP(19);
        if (blockIdx.x == 0 && threadIdx.x == 0) { volatile LAS unsigned long long* ts = (volatile LAS unsigned long long*)((LAS unsigned char*)lds + SCHED_OFF + 512);
            const float f = (float)(ts[PROBE_K2] - ts[PROBE_K]) / (float)(ts[19] - ts[0]); __hip_atomic_store((unsigned*)(P.ctl + 8), __float_as_uint(0.045f * sqrtf(f)), RLX_AGENT); }
        xcd_barrier_now(lds);
        const float sc = 1.f + __uint_as_float(__hip_atomic_load((unsigned*)(P.ctl + 8), RLX_AGENT));
        for (int i = 0; i < 8; ++i) { float* xr = out + (size_t)(P.vcu * 64 + P.wave * 8 + i) * DM;
            for (int j = 0; j < 4; ++j) { f32x4 v = *(GAS f32x4*)(xr + 4 * P.lane + 256 * j); v = v * sc; *(GAS f32x4*)(xr + 4 * P.lane + 256 * j) = v; } }
    }
#undef IN
#undef SEAM
#undef PHASE_FRAME
#undef AIN
#undef KA_INT
#undef STAMP
#undef REPS
}

extern "C" void kernel_launch(void* const* d_in, const int* in_sizes, int n_in, void* d_out, int out_size, void* d_ws, size_t ws_size, hipStream_t stream) {
    static int grid = 0;
    if (grid == 0) {
        if (n_in != 18 || out_size != NTOK * DM || ws_size < WS_END) { fprintf(stderr, "kernel_launch: unexpected shapes (n_in %d, out %d, ws %zu < %zu)\n", n_in, out_size, ws_size, (size_t)WS_END); grid = -1; return; }
        int dev = 0, cus = 0, per_cu = 0;
        if (hipGetDevice(&dev) != hipSuccess || hipDeviceGetAttribute(&cus, hipDeviceAttributeMultiprocessorCount, dev) != hipSuccess) { grid = -1; return; }
        if (hipFuncSetAttribute((const void*)mega_fwd, hipFuncAttributeMaxDynamicSharedMemorySize, LDS_BYTES) != hipSuccess) { fprintf(stderr, "kernel_launch: hipFuncSetAttribute failed\n"); grid = -1; return; }
        if (hipOccupancyMaxActiveBlocksPerMultiprocessor(&per_cu, (const void*)mega_fwd, NWAVES * 64, LDS_BYTES) != hipSuccess || per_cu < 1) { fprintf(stderr, "kernel_launch: occupancy query says %d\n", per_cu); }
        (void)hipGetLastError();
        grid = cus;
        if (grid != 256) fprintf(stderr, "kernel_launch: %d CUs (built for 256)\n", grid);
    }
    if (grid < 0) return;
    (void)hipMemsetAsync((char*)d_ws + WS_CTL, 0, CTL_ZERO_BYTES, stream);
    Args a{};
    for (int i = 0; i < 18; ++i) a.in[i] = (const float*)d_in[i];
    a.out = (float*)d_out; a.ws = (unsigned char*)d_ws;
#if MK_ONE_LAUNCH
    a.ph_lo = 0; a.ph_hi = N_PHASES;
    hipLaunchKernelGGL(mega_fwd, dim3(grid), dim3(NWAVES * 64), LDS_BYTES, stream, a);
#else
    for (int p = 0; p < N_PHASES; ++p) {
        if (p == 4 || p == 2 || p == 11 || p == 13) continue;
        a.ph_lo = p; a.ph_hi = p + 1;
        hipLaunchKernelGGL(mega_fwd, dim3(grid), dim3(NWAVES * 64), LDS_BYTES, stream, a);
    }
#endif
}
```
